# Optimizing an MI355X kernel written in HIP

```python
import math
import jax, jax.numpy as jnp
from jax import lax
import numpy as np

D_MODEL = 2048
BATCH = 4
SEQ = 4096
DEPTH = 2
DEC_BATCH = 8
DEC_SEQ = 64
PAST_LEN = 4096

CHUNK = 64
N_AB = (DEPTH + 1) // 2
N_C = DEPTH // 2
D_A = D_MODEL // 2
G_A = 4
C_A = D_A // G_A
MLP_CHUNK = 128
D_B = D_MODEL // 2
HEAD_B = 64
H_B = D_B // HEAD_B
R_W = 64
R_A = 64
D_B_SHIFT = 3 * D_B + R_W + R_A
HEAD_C = 128
H_C = D_MODEL // (2 * HEAD_C)
D_C = H_C * 2 * HEAD_C
Q_BLOCK = 128
P_AB = 3 * D_A + D_B_SHIFT + D_B
P_C = 4 * D_C
DEEPNORM_ALPHA = (2 * DEPTH) ** 0.25
DEEPNORM_BETA = (8 * DEPTH) ** -0.25
LN_EPS = 1e-5
GN_EPS_B = 64e-5
SUBLN_EPS = 1e-5

kernel_name = "hybrid_streaming_gmlp_rwkv7_diffattn_step"


def layer_norm(x, g, b, eps=LN_EPS):
    xf = x.astype(jnp.float32)
    mu = jnp.mean(xf, -1, keepdims=True)
    var = jnp.mean(jnp.square(xf - mu), -1, keepdims=True)
    return ((xf - mu) * lax.rsqrt(var + eps) * g + b).astype(x.dtype)


def spatial_gate(v_n, ws, bs):
    b, t, _ = v_n.shape
    L = min(t, MLP_CHUNK)
    n = t // L
    mask = jnp.tril(jnp.ones((L, L), dtype=bool))
    w = jnp.where(mask, ws[:, :L, :L], 0)
    vg = v_n.reshape(b, n, L, G_A, C_A)
    bias = jnp.swapaxes(bs[:, :L], 0, 1)[None, None, :, :, None]
    out = jnp.einsum('gts,bnsgc->bntgc', w, vg) + bias
    return out.reshape(b, t, D_A)


def rwkv7_scan(s0, r, decay, k, v, kk, a):
    def step(s, inp):
        r_t, w_t, k_t, v_t, kk_t, a_t = inp
        s_kk = jnp.einsum('bhvk,bhk->bhv', s, kk_t)
        s = (s * w_t[:, :, None, :] - s_kk[..., None] * (kk_t * a_t)[:, :, None, :]
             + v_t[..., None] * k_t[:, :, None, :])
        return s, jnp.einsum('bhvk,bhk->bhv', s, r_t)
    xs = tuple(jnp.swapaxes(z.astype(jnp.float32), 0, 1) for z in (r, decay, k, v, kk, a))
    s_fin, y = lax.scan(step, s0.astype(jnp.float32), xs)
    return s_fin, jnp.swapaxes(y, 0, 1)


def ab_layer(x, shift_prev, wkv0, w_in, a_ln_g, a_ln_b, a_ws, a_bs, b_mu, b_w0, b_w2,
             b_a0, b_a2, b_kk, b_ka, b_rk, b_lnx_g, b_lnx_b, w_out, ln_g, ln_b):
    f32 = jnp.float32
    bsz, t, _ = x.shape
    proj = x @ w_in
    u, v_a, g_a, h_b, g_b = jnp.split(proj, [D_A, 2 * D_A, 3 * D_A, 3 * D_A + D_B_SHIFT], axis=-1)
    v_n = layer_norm(v_a, a_ln_g, a_ln_b)
    out_a = u * spatial_gate(v_n, a_ws, a_bs) * jax.nn.silu(g_a)
    prev = jnp.concatenate([shift_prev[:, None].astype(h_b.dtype), h_b[:, :-1]], axis=1)
    hs = h_b + (prev - h_b) * b_mu
    r, k, v, wl, al = jnp.split(hs, [D_B, 2 * D_B, 3 * D_B, 3 * D_B + R_W], axis=-1)
    w = -jax.nn.softplus(-(b_w0 + jnp.tanh(wl) @ b_w2).astype(f32)) - 0.5
    decay = jnp.exp(-jnp.exp(w))
    a = jax.nn.sigmoid((b_a0 + al @ b_a2).astype(f32))
    heads = lambda z: z.astype(f32).reshape(bsz, t, H_B, HEAD_B)
    kk = heads(k * b_kk)
    kk = kk / jnp.maximum(jnp.sqrt(jnp.sum(jnp.square(kk), -1, keepdims=True)), 1e-12)
    k_mod = k.astype(f32) * (1.0 + (a - 1.0) * b_ka)
    r_h, k_h, v_h, a_h, w_h = heads(r), heads(k_mod), heads(v), heads(a), heads(decay)
    wkv_new, y = rwkv7_scan(wkv0, r_h, w_h, k_h, v_h, kk, a_h)
    mu_y = jnp.mean(y, -1, keepdims=True)
    var_y = jnp.mean(jnp.square(y - mu_y), -1, keepdims=True)
    y = ((y - mu_y) * lax.rsqrt(var_y + GN_EPS_B)).reshape(bsz, t, D_B) * b_lnx_g + b_lnx_b
    bonus = (jnp.sum(r_h * k_h * b_rk, -1, keepdims=True) * v_h).reshape(bsz, t, D_B)
    out_b = ((y + bonus) * jax.nn.silu(g_b.astype(f32))).astype(x.dtype)
    out = jnp.concatenate([out_a, out_b], axis=-1) @ w_out
    x_new = layer_norm(DEEPNORM_ALPHA * x + out, ln_g, ln_b)
    return x_new, h_b[:, -1], wkv_new, v_n


def diff_attend(q, k, v, mask, lam):
    s = jnp.einsum('bqhjd,bkhjd->jbhqk', q, k).astype(jnp.float32) * (HEAD_C ** -0.5)
    if mask is not None:
        s = jnp.where(mask, s, -jnp.inf)
    p = jax.nn.softmax(s, axis=-1)
    attn = p[0] - lam * p[1]
    return jnp.einsum('bhqk,bkhe->bqhe', attn.astype(v.dtype), v)


def c_layer(x, k_cache, v_cache, lam_init, w_in, lq1, lk1, lq2, lk2, subln_g, w_out, ln_g, ln_b):
    f32 = jnp.float32
    bsz, t, _ = x.shape
    q, k, v, g = jnp.split(x @ w_in, 4, axis=-1)
    q = q.reshape(bsz, t, H_C, 2, HEAD_C)
    k = k.reshape(bsz, t, H_C, 2, HEAD_C)
    v = v.reshape(bsz, t, H_C, 2 * HEAD_C)
    lam = (jnp.exp(jnp.sum((lq1 * lk1).astype(f32))) - jnp.exp(jnp.sum((lq2 * lk2).astype(f32)))
           + lam_init)
    if k_cache is None:
        nb = t // Q_BLOCK
        qb = jnp.moveaxis(q.reshape(bsz, nb, Q_BLOCK, H_C, 2, HEAD_C), 1, 0)
        key_pos = jnp.arange(t)
        def block(args):
            q_blk, i = args
            q_pos = i * Q_BLOCK + jnp.arange(Q_BLOCK)
            limit = (q_pos // CHUNK + 1) * CHUNK
            return diff_attend(q_blk, k, v, key_pos[None, :] < limit[:, None], lam)
        o = lax.map(block, (qb, jnp.arange(nb)))
        o = jnp.moveaxis(o, 0, 1).reshape(bsz, t, H_C, 2 * HEAD_C)
    else:
        k_all = jnp.concatenate([k_cache.astype(k.dtype), k], axis=1)
        v_all = jnp.concatenate([v_cache.astype(v.dtype), v], axis=1)
        o = diff_attend(q, k_all, v_all, None, lam)
    of = o.astype(f32)
    of = of * lax.rsqrt(jnp.mean(jnp.square(of), -1, keepdims=True) + SUBLN_EPS) * subln_g
    of = of * (1.0 - lam_init)
    o = (of.reshape(bsz, t, D_C) * jax.nn.silu(g.astype(f32))).astype(x.dtype)
    out = o @ w_out
    return layer_norm(DEEPNORM_ALPHA * x + out, ln_g, ln_b), k, v


def setup_inputs(seed: int = 0) -> dict:
    key = jax.random.key(seed)
    ks = iter(jax.random.split(key, 48))
    f32 = jnp.float32
    nrm = lambda shape, scale: jax.random.normal(next(ks), shape, f32) * scale
    return {
        "x_prompt": nrm((BATCH, SEQ, D_MODEL), 1.0),
        "x_sample": nrm((DEC_BATCH, DEC_SEQ, D_MODEL), 1.0),
        "state_b_shift": nrm((N_AB, DEC_BATCH, D_B_SHIFT), 1.0),
        "state_b_wkv": nrm((N_AB, DEC_BATCH, H_B, HEAD_B, HEAD_B), 0.3),
        "cache_c_k": nrm((N_C, DEC_BATCH, PAST_LEN, H_C, 2, HEAD_C), 1.0),
        "cache_c_v": nrm((N_C, DEC_BATCH, PAST_LEN, H_C, 2 * HEAD_C), 1.0),
        "ab_w_in": nrm((N_AB, D_MODEL, P_AB), D_MODEL ** -0.5),
        "ab_a_ln_g": 1.0 + nrm((N_AB, D_A), 0.02),
        "ab_a_ln_b": nrm((N_AB, D_A), 0.02),
        "ab_a_ws": nrm((N_AB, G_A, MLP_CHUNK, MLP_CHUNK), MLP_CHUNK ** -0.5),
        "ab_a_bs": 1.0 + nrm((N_AB, G_A, MLP_CHUNK), 0.1),
        "ab_b_mu": jax.random.uniform(next(ks), (N_AB, D_B_SHIFT), f32),
        "ab_b_w0": -3.0 + nrm((N_AB, D_B), 1.0),
        "ab_b_w2": nrm((N_AB, R_W, D_B), 0.1 * R_W ** -0.5),
        "ab_b_a0": nrm((N_AB, D_B), 0.1),
        "ab_b_a2": nrm((N_AB, R_A, D_B), 0.1 * R_A ** -0.5),
        "ab_b_kk": 0.85 + nrm((N_AB, D_B), 0.02),
        "ab_b_ka": 1.0 + nrm((N_AB, D_B), 0.02),
        "ab_b_rk": nrm((N_AB, H_B, HEAD_B), 0.1),
        "ab_b_lnx_g": 1.0 + nrm((N_AB, D_B), 0.02),
        "ab_b_lnx_b": nrm((N_AB, D_B), 0.02),
        "ab_w_out": nrm((N_AB, D_A + D_B, D_MODEL), (D_A + D_B) ** -0.5 * DEEPNORM_BETA),
        "ab_ln_g": 1.0 + nrm((N_AB, D_MODEL), 0.02),
        "ab_ln_b": nrm((N_AB, D_MODEL), 0.02),
        "c_w_in": nrm((N_C, D_MODEL, P_C), D_MODEL ** -0.5),
        "c_lam_q1": nrm((N_C, HEAD_C), 0.1),
        "c_lam_k1": nrm((N_C, HEAD_C), 0.1),
        "c_lam_q2": nrm((N_C, HEAD_C), 0.1),
        "c_lam_k2": nrm((N_C, HEAD_C), 0.1),
        "c_subln_g": 1.0 + nrm((N_C, 2 * HEAD_C), 0.02),
        "c_w_out": nrm((N_C, D_C, D_MODEL), D_C ** -0.5 * DEEPNORM_BETA),
        "c_ln_g": 1.0 + nrm((N_C, D_MODEL), 0.02),
        "c_ln_b": nrm((N_C, D_MODEL), 0.02),
    }


def reference(x_prompt, x_sample, state_b_shift, state_b_wkv, cache_c_k, cache_c_v,
              ab_w_in, ab_a_ln_g, ab_a_ln_b, ab_a_ws, ab_a_bs, ab_b_mu, ab_b_w0, ab_b_w2,
              ab_b_a0, ab_b_a2, ab_b_kk, ab_b_ka, ab_b_rk, ab_b_lnx_g, ab_b_lnx_b, ab_w_out,
              ab_ln_g, ab_ln_b, c_w_in, c_lam_q1, c_lam_k1, c_lam_q2, c_lam_k2, c_subln_g,
              c_w_out, c_ln_g, c_ln_b):
    x_p, x_s = x_prompt, x_sample
    sh_p_l, wkv_p_l, sh_s_l, wkv_s_l, va_s_l = [], [], [], [], []
    kp_l, vp_l, ks_l, vs_l = [], [], [], []
    for li in range(DEPTH):
        j = li // 2
        if li % 2 == 0:
            prm = (ab_w_in[j], ab_a_ln_g[j], ab_a_ln_b[j], ab_a_ws[j], ab_a_bs[j], ab_b_mu[j],
                   ab_b_w0[j], ab_b_w2[j], ab_b_a0[j], ab_b_a2[j], ab_b_kk[j], ab_b_ka[j],
                   ab_b_rk[j], ab_b_lnx_g[j], ab_b_lnx_b[j], ab_w_out[j], ab_ln_g[j], ab_ln_b[j])
            shift0 = jnp.zeros((x_p.shape[0], D_B_SHIFT), x_p.dtype)
            wkv0 = jnp.zeros((x_p.shape[0], H_B, HEAD_B, HEAD_B), jnp.float32)
            x_p, sh_p, wkv_p, _ = ab_layer(x_p, shift0, wkv0, *prm)
            x_s, sh_s, wkv_s, va_s = ab_layer(x_s, state_b_shift[j], state_b_wkv[j], *prm)
            sh_p_l.append(sh_p.astype(state_b_shift.dtype))
            wkv_p_l.append(wkv_p.astype(state_b_wkv.dtype))
            sh_s_l.append(sh_s.astype(state_b_shift.dtype))
            wkv_s_l.append(wkv_s.astype(state_b_wkv.dtype))
            va_s_l.append(va_s)
        else:
            lam_init = 0.8 - 0.6 * math.exp(-0.3 * li)
            prm = (c_w_in[j], c_lam_q1[j], c_lam_k1[j], c_lam_q2[j], c_lam_k2[j], c_subln_g[j],
                   c_w_out[j], c_ln_g[j], c_ln_b[j])
            x_p, k_p, v_p = c_layer(x_p, None, None, lam_init, *prm)
            x_s, k_s, v_s = c_layer(x_s, cache_c_k[j], cache_c_v[j], lam_init, *prm)
            kp_l.append(k_p.astype(cache_c_k.dtype))
            vp_l.append(v_p.astype(cache_c_v.dtype))
            ks_l.append(k_s.astype(cache_c_k.dtype))
            vs_l.append(v_s.astype(cache_c_v.dtype))
    return (x_p, x_s, jnp.stack(sh_p_l), jnp.stack(wkv_p_l), jnp.stack(sh_s_l), jnp.stack(wkv_s_l),
            jnp.stack(va_s_l), jnp.stack(kp_l), jnp.stack(vp_l), jnp.stack(ks_l), jnp.stack(vs_l))
```

```cpp
#include <hip/hip_runtime.h>
#include <cstdio>
#include <cstdint>
#ifndef STAGE
#define STAGE 9
#endif
namespace pg8 {
#define PG8_LAS __attribute__((address_space(3)))
typedef unsigned short bf16_t;
typedef short bf16x8 __attribute__((ext_vector_type(8)));
typedef float f32x4 __attribute__((ext_vector_type(4)));
typedef unsigned u32x4 __attribute__((ext_vector_type(4)));
constexpr int BM = 256, BK = 64, HALF = 128, HTB = HALF * BK * 2  , STAGE_BYTES = 8 * HTB, NXCD = 8, WGM = 8;

__host__ __device__ __forceinline__ int lds_byte(int r, int c) { const int st = (r >> 4) * 2 + (c >> 5), rr = r & 15, cc = c & 31, ob = rr * 64 + cc * 2; return st * 1024 + (ob ^ (((ob >> 9) & 1) << 5)); }
__host__ __device__ __forceinline__ void stage_rc(int b, int& R, int& C) { const int st = b / 1024, sb = b % 1024, swz = sb ^ (((sb >> 9) & 1) << 5); R = (st >> 1) * 16 + swz / 64; C = (st & 1) * 32 + (swz % 64) / 2; }
__host__ __device__ __forceinline__ int perm32(int rho) { const int n = rho >> 4, i = rho & 15; return 8 * (i >> 2) + 4 * n + (i & 3); }

struct Unit { int pm, pn; };
struct Gemm { const bf16_t* A; const bf16_t* Bt; int M, N, K; };

struct StaticOrder {
    int nM, nN, nwg, G, c;
    __host__ __device__ void init(int M, int N, int G_, int c_) { nM = M / BM; nN = N / BM; nwg = nM * nN; G = G_; c = c_; }
    __host__ __device__ bool next(int i, Unit& u) const {
        const long L = (long)i * G + c; if (L >= nwg) return false;
        int wgid = (int)L; { const int q = nwg / NXCD, r = nwg % NXCD, xcd = wgid % NXCD, off = wgid / NXCD; wgid = (xcd < r ? xcd * (q + 1) : r * (q + 1) + (xcd - r) * q) + off; }
        const int nig = WGM * nN, gid = wgid / nig, fm = gid * WGM, gsz = (nM - fm) < WGM ? (nM - fm) : WGM;
        u.pm = fm + ((wgid % nig) % gsz); u.pn = (wgid % nig) / gsz; return true;
    }
    __device__ __forceinline__ void a_ready(const Unit&) const {}
    __device__ __forceinline__ void done(const Unit&) const {}
};

__device__ __forceinline__ unsigned cvt_pk_bf16(float lo, float hi) { unsigned r; asm volatile("v_cvt_pk_bf16_f32 %0, %1, %2" : "=v"(r) : "v"(lo), "v"(hi)); return r; }
typedef float f32x2 __attribute__((ext_vector_type(2)));
template <class Epi, class Sched, bool ALIGN_EPI = false, bool SP2 = false>
__device__ __forceinline__ void gemm_phase(PG8_LAS unsigned char* lds, const Gemm g, const Sched& S, const Epi& E) {
    const int tid = threadIdx.x, wid = __builtin_amdgcn_readfirstlane(tid >> 6), lane = tid & 63, wr = wid >> 2, wc = wid & 3, fr = lane & 15, fq = lane >> 4;
    const int K = g.K, nt = K / BK;
    unsigned voffA[2], voffB[2];
#pragma unroll
    for (int i = 0; i < 2; ++i) { int R, C; stage_rc(tid * 16 + i * 8192, R, C); const int Rb = Epi::PERM ? ((R & ~31) + perm32(R & 31)) : R;
        voffA[i] = (unsigned)(R * K + C) * 2u; voffB[i] = (unsigned)(Rb * K + C) * 2u; }
    const size_t kstep = (size_t)(BK * 2);
    const size_t hstep = (size_t)HALF * K * 2;
    const size_t tstep = 2 * hstep;
    const unsigned ldsw = (unsigned)wid * 1024u;
    const int aoff = lds_byte(wr * 64 + fr, fq * 8), boff = lds_byte(wc * 32 + fr, fq * 8);
#define PG8_SA(b, h) (((b) * 2 + (h)) * HTB)
#define PG8_SB(b, h) ((4 + (b) * 2 + (h)) * HTB)
#define PG8_STAGE(bufoff, gbase, voff) do { _Pragma("unroll") for (int _i = 0; _i < 2; ++_i) \
        __builtin_amdgcn_global_load_lds((const unsigned*)((const char*)(gbase) + (voff)[_i]), (PG8_LAS unsigned*)(lds + (bufoff) + ldsw + _i * 8192), 16, 0, 0); } while (0)
#define PG8_LDA(dst, b, h) do { _Pragma("unroll") for (int m = 0; m < 4; ++m) _Pragma("unroll") for (int k = 0; k < 2; ++k) dst[m][k] = *(const PG8_LAS bf16x8*)(lds + PG8_SA(b, h) + aoff + m * 2048 + k * 1024); } while (0)
#define PG8_LDB(dst, b, h) do { _Pragma("unroll") for (int n = 0; n < 2; ++n) _Pragma("unroll") for (int k = 0; k < 2; ++k) dst[n][k] = *(const PG8_LAS bf16x8*)(lds + PG8_SB(b, h) + boff + n * 2048 + k * 1024); } while (0)
#define PG8_MMA(ai, bj, At, Bt) do { __builtin_amdgcn_s_setprio(1); _Pragma("unroll") for (int m = 0; m < 4; ++m) _Pragma("unroll") for (int n = 0; n < 2; ++n) _Pragma("unroll") for (int k = 0; k < 2; ++k) \
        acc[ai][bj][m][n] = __builtin_amdgcn_mfma_f32_16x16x32_bf16(Bt[n][k], At[m][k], acc[ai][bj][m][n], 0, 0, 0); __builtin_amdgcn_s_setprio(0); } while (0)
#define PG8_WAIT_V(n) asm volatile("s_waitcnt vmcnt(" #n ")" ::: "memory")
#define PG8_WAIT_L(n) asm volatile("s_waitcnt lgkmcnt(" #n ")" ::: "memory")
#define PG8_BAR __builtin_amdgcn_s_barrier()
#define PG8_SCHED __builtin_amdgcn_sched_barrier(0)
    Unit cur, nxt; int ui = 0;
    if (!S.next(0, cur)) return;
    f32x4 acc[2][2][4][2];
#pragma unroll
    for (int a = 0; a < 2; ++a)
#pragma unroll
        for (int b = 0; b < 2; ++b)
#pragma unroll
            for (int m = 0; m < 4; ++m)
#pragma unroll
                for (int n = 0; n < 2; ++n) acc[a][b][m][n] = (f32x4){0.f, 0.f, 0.f, 0.f};
    bf16x8 At[4][2], B0[2][2], B1[2][2];
    const char* cA = (const char*)g.A + (size_t)cur.pm * tstep; const char* cB = (const char*)g.Bt + (size_t)cur.pn * tstep;
    S.a_ready(cur);
    if constexpr (SP2) {
        PG8_STAGE(PG8_SB(0, 0), cB, voffB); PG8_STAGE(PG8_SB(0, 1), cB + hstep, voffB); PG8_STAGE(PG8_SA(0, 0), cA, voffA); PG8_STAGE(PG8_SA(0, 1), cA + hstep, voffA);
        if (wr == 1) PG8_BAR;
        PG8_WAIT_V(2); PG8_BAR;
        PG8_STAGE(PG8_SB(1, 0), cB + kstep, voffB); PG8_STAGE(PG8_SA(1, 0), cA + kstep, voffA); PG8_STAGE(PG8_SB(1, 1), cB + hstep + kstep, voffB);
        PG8_WAIT_V(6); PG8_BAR;
    } else {
        PG8_STAGE(PG8_SB(0, 0), cB, voffB); PG8_STAGE(PG8_SA(0, 0), cA, voffA); PG8_STAGE(PG8_SB(0, 1), cB + hstep, voffB); PG8_STAGE(PG8_SA(0, 1), cA + hstep, voffA);
        if (wr == 1) PG8_BAR;
        PG8_WAIT_V(4); PG8_BAR;
        PG8_STAGE(PG8_SB(1, 0), cB + kstep, voffB); PG8_STAGE(PG8_SA(1, 0), cA + kstep, voffA); PG8_STAGE(PG8_SB(1, 1), cB + hstep + kstep, voffB);
        PG8_WAIT_V(6); PG8_BAR;
    }
    for (;;) {
        const bool has_next = S.next(ui + 1, nxt);
        const char* nA = has_next ? (const char*)g.A + (size_t)nxt.pm * tstep : cA; const char* nB = has_next ? (const char*)g.Bt + (size_t)nxt.pn * tstep : cB;
        for (int t = 0; t < nt; t += 2) {
            const bool last = (t == nt - 2);
            const char* a1 = cA + (size_t)(t + 1) * kstep;
            const char* a2 = last ? nA : cA + (size_t)(t + 2) * kstep; const char* b2 = last ? nB : cB + (size_t)(t + 2) * kstep;
            const char* a3 = a2 + kstep; const char* b3 = b2 + kstep;
            if (last && has_next) S.a_ready(nxt);
            if constexpr (SP2) {
            PG8_LDB(B0, 0, 0); PG8_LDB(B1, 0, 1); PG8_SCHED; PG8_LDA(At, 0, 0); PG8_STAGE(PG8_SA(1, 1), a1 + hstep, voffA);
            PG8_WAIT_V(8); PG8_WAIT_L(0); PG8_BAR; PG8_MMA(0, 0, At, B0); PG8_MMA(0, 1, At, B1); PG8_BAR; PG8_SCHED;
            PG8_LDA(At, 0, 1); PG8_STAGE(PG8_SB(0, 0), b2, voffB); PG8_STAGE(PG8_SB(0, 1), b2 + hstep, voffB); PG8_STAGE(PG8_SA(0, 0), a2, voffA);
            PG8_WAIT_V(8); PG8_WAIT_L(0); PG8_BAR; PG8_MMA(1, 0, At, B0); PG8_MMA(1, 1, At, B1); PG8_BAR; PG8_SCHED;
            PG8_LDB(B0, 1, 0); PG8_LDB(B1, 1, 1); PG8_SCHED; PG8_LDA(At, 1, 0); PG8_STAGE(PG8_SA(0, 1), a2 + hstep, voffA);
            PG8_WAIT_V(8); PG8_WAIT_L(0); PG8_BAR; PG8_MMA(0, 0, At, B0); PG8_MMA(0, 1, At, B1); PG8_BAR; PG8_SCHED;
            PG8_LDA(At, 1, 1); PG8_STAGE(PG8_SB(1, 0), b3, voffB); PG8_STAGE(PG8_SB(1, 1), b3 + hstep, voffB); PG8_STAGE(PG8_SA(1, 0), a3, voffA);
            PG8_WAIT_V(8); PG8_WAIT_L(0); PG8_BAR; PG8_MMA(1, 0, At, B0); PG8_MMA(1, 1, At, B1); PG8_BAR; PG8_SCHED;
            } else {
            PG8_LDB(B0, 0, 0); PG8_SCHED; PG8_LDA(At, 0, 0); PG8_STAGE(PG8_SA(1, 1), a1 + hstep, voffA);
            PG8_WAIT_L(8); PG8_BAR; PG8_WAIT_L(0); PG8_MMA(0, 0, At, B0); PG8_BAR; PG8_SCHED;
            PG8_LDB(B1, 0, 1); PG8_STAGE(PG8_SB(0, 0), b2, voffB);
            PG8_BAR; PG8_WAIT_L(0); PG8_MMA(0, 1, At, B1); PG8_BAR;
            PG8_LDA(At, 0, 1); PG8_STAGE(PG8_SA(0, 0), a2, voffA);
            PG8_BAR; PG8_WAIT_L(0); PG8_MMA(1, 0, At, B0); PG8_BAR; PG8_SCHED;
            PG8_STAGE(PG8_SB(0, 1), b2 + hstep, voffB);
            PG8_WAIT_V(6); PG8_BAR; PG8_MMA(1, 1, At, B1); PG8_BAR;
            PG8_LDB(B0, 1, 0); PG8_SCHED; PG8_LDA(At, 1, 0); PG8_STAGE(PG8_SA(0, 1), a2 + hstep, voffA);
            PG8_WAIT_L(8); PG8_BAR; PG8_WAIT_L(0); PG8_MMA(0, 0, At, B0); PG8_BAR; PG8_SCHED;
            PG8_LDB(B1, 1, 1); PG8_STAGE(PG8_SB(1, 0), b3, voffB);
            PG8_BAR; PG8_WAIT_L(0); PG8_MMA(0, 1, At, B1); PG8_BAR;
            PG8_LDA(At, 1, 1); PG8_STAGE(PG8_SA(1, 0), a3, voffA);
            PG8_BAR; PG8_WAIT_L(0); PG8_MMA(1, 0, At, B0); PG8_BAR; PG8_SCHED;
            PG8_STAGE(PG8_SB(1, 1), b3 + hstep, voffB);
            PG8_WAIT_V(6); PG8_BAR; PG8_MMA(1, 1, At, B1); PG8_BAR;
            }
        }
        if constexpr (ALIGN_EPI) { if (wr == 0) PG8_BAR; }
        if constexpr (!Epi::AFTER_DRAIN) { E(acc, cur, wr, wc, fr, fq); S.done(cur); }
        if (!has_next) break;
#pragma unroll
        for (int a = 0; a < 2; ++a)
#pragma unroll
            for (int b = 0; b < 2; ++b)
#pragma unroll
                for (int m = 0; m < 4; ++m)
#pragma unroll
                    for (int n = 0; n < 2; ++n) acc[a][b][m][n] = (f32x4){0.f, 0.f, 0.f, 0.f};
        cur = nxt; cA = nA; cB = nB; ++ui;
        if constexpr (ALIGN_EPI) { if (wr == 1) PG8_BAR; }
    }
    PG8_WAIT_V(0);
    if constexpr (!ALIGN_EPI) { if (wr == 0) PG8_BAR; }
    PG8_BAR;
    if constexpr (Epi::AFTER_DRAIN) { E.fused(acc, cur, wr, wc, fr, fq, lds, wid, lane); S.done(cur); }
#undef PG8_SA
#undef PG8_SB
#undef PG8_STAGE
#undef PG8_LDA
#undef PG8_LDB
#undef PG8_MMA
#undef PG8_WAIT_V
#undef PG8_WAIT_L
#undef PG8_BAR
#undef PG8_SCHED
}
}
constexpr int DM = 2048, NBP = 4, SEQ = 4096, NBS = 8, DSQ = 64, PAST = 4096;
constexpr int MP = NBP * SEQ, MS = NBS * DSQ, MT = MP + MS;
constexpr int PAB = 7296, PABP = 7424, PCN = 8192, DSH = 3200, KVROWS = PAST + DSQ;
constexpr int COL_VA = 1024, COL_GA = 2048, COL_HB = 3072, COL_GB = 6272;
constexpr float ALPHA = 1.41421356237f;
constexpr float LAM_INIT = 0.35550906759f;
constexpr float QSCALE = 0.08838834764831845f * 1.4426950408889634f;
constexpr size_t O0 = 0, O1 = 33554432, O2 = 34603008, O3 = 34615808, O4 = 34877952, O5 = 34903552, O6 = 35427840, O7 = 35952128, O8 = 69506560, O9 = 103060992, O10 = 104109568, OUT_TOTAL = 105158144;
constexpr size_t MiB = 1u << 20;
constexpr size_t WS_CTL = 0, CTL_ZERO_BYTES = 1 * MiB;
constexpr size_t OFF_STATS1 = 131072, OFF_COLSUM = 393216, OFF_BW = 458752;
constexpr size_t WS_W2T = 4 * MiB, WS_A2T = WS_W2T + 131072, WS_WSB = WS_W2T + 262144;
constexpr size_t WS_WTIN = 8 * MiB, WS_WTOUT = 37 * MiB, WS_WTCIN = 45 * MiB, WS_WTCOUT = 77 * MiB;
constexpr size_t WS_XB = 85 * MiB, WS_Z1 = 151 * MiB, WS_KCS = 217 * MiB, WS_VCS = 347 * MiB;
constexpr size_t WS_PROJ = 477 * MiB, WS_SCANIN = 717 * MiB, WS_Y = 915 * MiB;
constexpr size_t WS_QB = 477 * MiB, WS_GB = 543 * MiB, WS_KBP = 609 * MiB, WS_VBP = 673 * MiB, WS_PARTP = 737 * MiB, WS_MLP = 993 * MiB;
constexpr size_t WS_PARTS = 8 * MiB, WS_MLS = 40 * MiB, WS_END = 1024 * MiB;
constexpr int CW_TMO = 0, CW_CODE = 1, CW_BAR = 4096;
constexpr size_t SCAN_SBASE = (size_t)NBP * 16 * SEQ * 384;
constexpr int RING_BYTES = 147456, LDSCTL_OFF = RING_BYTES, MISC_OFF = LDSCTL_OFF + 320, LDS_BYTES = 148480;

#define LAS __attribute__((address_space(3)))
typedef unsigned short bf16;
typedef short bf16x8 __attribute__((ext_vector_type(8)));
typedef short s16x4 __attribute__((ext_vector_type(4)));
typedef float f32x4 __attribute__((ext_vector_type(4)));
typedef float f32x16 __attribute__((ext_vector_type(16)));
typedef unsigned u32x4 __attribute__((ext_vector_type(4)));
typedef unsigned u32x2 __attribute__((ext_vector_type(2)));
using pg8::cvt_pk_bf16;

__device__ __forceinline__ unsigned f2bf(float f) { unsigned u = __builtin_bit_cast(unsigned, f); return (u + 0x7fffu + ((u >> 16) & 1u)) >> 16; }
__device__ __forceinline__ unsigned pk2(float lo, float hi) { return f2bf(lo) | (f2bf(hi) << 16); }
__device__ __forceinline__ float bflo(unsigned w) { return __builtin_bit_cast(float, w << 16); }
__device__ __forceinline__ float bfhi(unsigned w) { return __builtin_bit_cast(float, w & 0xffff0000u); }
__device__ __forceinline__ float bf1(bf16 h) { return __builtin_bit_cast(float, (unsigned)h << 16); }
__device__ __forceinline__ float sigmoidf_(float x) { return __builtin_amdgcn_rcpf(1.f + __expf(-x)); }
__device__ __forceinline__ float siluf_(float x) { return x * sigmoidf_(x); }
__device__ __forceinline__ float wave_sum(float v) {
#pragma unroll
    for (int o = 1; o < 64; o <<= 1) v += __shfl_xor(v, o);
    return v;
}
__device__ __forceinline__ void unpack8(u32x4 w, float (&f)[8]) { f[0] = bflo(w.x); f[1] = bfhi(w.x); f[2] = bflo(w.y); f[3] = bfhi(w.y); f[4] = bflo(w.z); f[5] = bfhi(w.z); f[6] = bflo(w.w); f[7] = bfhi(w.w); }

namespace pg8 {
struct EpiPlainBf16 {
    static constexpr bool PERM = true, AFTER_DRAIN = false;
    bf16_t* O; int ldc;
    __device__ __forceinline__ void operator()(const f32x4 (&acc)[2][2][4][2], const Unit& u, int wr, int wc, int fr, int fq) const {
        const int row0 = u.pm * BM + wr * 64 + fr, col0 = u.pn * BM + wc * 32 + 8 * fq;
#pragma unroll
        for (int ai = 0; ai < 2; ++ai)
#pragma unroll
            for (int m = 0; m < 4; ++m) { bf16_t* rowp = O + (size_t)(row0 + ai * HALF + m * 16) * ldc + col0;
#pragma unroll
                for (int bj = 0; bj < 2; ++bj) { const f32x4 v0 = acc[ai][bj][m][0], v1 = acc[ai][bj][m][1];
                    u32x4 w; w.x = cvt_pk_bf16(v0[0], v0[1]); w.y = cvt_pk_bf16(v0[2], v0[3]); w.z = cvt_pk_bf16(v1[0], v1[1]); w.w = cvt_pk_bf16(v1[2], v1[3]);
                    *(u32x4*)(rowp + bj * HALF) = w; } }
    }
};
struct EpiZ1 {
    static constexpr bool PERM = true, AFTER_DRAIN = false;
    const float* xp; const float* xs; bf16_t* Z; float* stats;
    __device__ __forceinline__ void operator()(const f32x4 (&acc)[2][2][4][2], const Unit& u, int wr, int wc, int fr, int fq) const {
        const int row0 = u.pm * BM + wr * 64 + fr, col0 = u.pn * BM + wc * 32 + 8 * fq;
#pragma unroll
        for (int ai = 0; ai < 2; ++ai)
#pragma unroll
            for (int m = 0; m < 4; ++m) { const int row = row0 + ai * HALF + m * 16;
                const float* xr = (row < ::MP ? xp + (size_t)row * ::DM : xs + (size_t)(row - ::MP) * ::DM) + col0;
                bf16_t* zr = Z + (size_t)row * ::DM + col0; float s = 0.f, ss = 0.f;
#pragma unroll
                for (int bj = 0; bj < 2; ++bj) { const f32x4 x0 = *(const f32x4*)(xr + bj * HALF), x1 = *(const f32x4*)(xr + bj * HALF + 4);
                    const f32x4 v0 = acc[ai][bj][m][0] + x0 * ::ALPHA, v1 = acc[ai][bj][m][1] + x1 * ::ALPHA;
                    u32x4 w; w.x = cvt_pk_bf16(v0[0], v0[1]); w.y = cvt_pk_bf16(v0[2], v0[3]); w.z = cvt_pk_bf16(v1[0], v1[1]); w.w = cvt_pk_bf16(v1[2], v1[3]);
                    *(u32x4*)(zr + bj * HALF) = w;
                    float f[8]; ::unpack8(w, f);
#pragma unroll
                    for (int i = 0; i < 8; ++i) { s += f[i]; ss += f[i] * f[i]; } }
                s += __shfl_xor(s, 16); s += __shfl_xor(s, 32); ss += __shfl_xor(ss, 16); ss += __shfl_xor(ss, 32);
                if (fq == 0) { unsafeAtomicAdd(stats + 2 * row, s); unsafeAtomicAdd(stats + 2 * row + 1, ss); } }
    }
};
struct EpiQKVG {
    static constexpr bool PERM = true, AFTER_DRAIN = false;
    const float* stats; const float* colsum; const float* bw; bf16_t* QB; bf16_t* GB; bf16_t* KBP; bf16_t* VBP; bf16_t* KCS; bf16_t* VCS; float* out;
    __device__ __forceinline__ void operator()(const f32x4 (&acc)[2][2][4][2], const Unit& u, int wr, int wc, int fr, int fq) const {
        const int kind = u.pn >> 3;
        const int row0 = u.pm * BM + wr * 64 + fr, col0 = (u.pn & 7) * BM + wc * 32 + 8 * fq, gcol0 = u.pn * BM + wc * 32 + 8 * fq;
        f32x4 cs[2][2], bb[2][2];
#pragma unroll
        for (int bj = 0; bj < 2; ++bj)
#pragma unroll
            for (int n = 0; n < 2; ++n) { cs[bj][n] = *(const f32x4*)(colsum + gcol0 + bj * HALF + 4 * n); bb[bj][n] = *(const f32x4*)(bw + gcol0 + bj * HALF + 4 * n); }
#pragma unroll
        for (int ai = 0; ai < 2; ++ai)
#pragma unroll
            for (int m = 0; m < 4; ++m) { const int row = row0 + ai * HALF + m * 16;
                const float mean = stats[2 * row] * (1.f / 2048.f); const float var = stats[2 * row + 1] * (1.f / 2048.f) - mean * mean; const float rstd = 1.0f / sqrtf(var + 1e-5f);
                const bool prompt = row < ::MP; const int rs = row - ::MP;
#pragma unroll
                for (int bj = 0; bj < 2; ++bj) { const int col = col0 + bj * HALF;
                    f32x4 v0 = (acc[ai][bj][m][0] - cs[bj][0] * mean) * rstd + bb[bj][0], v1 = (acc[ai][bj][m][1] - cs[bj][1] * mean) * rstd + bb[bj][1];
                    if (kind == 0) { v0 = v0 * ::QSCALE; v1 = v1 * ::QSCALE; }
                    if (kind == 3) {
#pragma unroll
                        for (int i = 0; i < 4; ++i) { v0[i] = ::siluf_(v0[i]); v1[i] = ::siluf_(v1[i]); } }
                    u32x4 w; w.x = cvt_pk_bf16(v0[0], v0[1]); w.y = cvt_pk_bf16(v0[2], v0[3]); w.z = cvt_pk_bf16(v1[0], v1[1]); w.w = cvt_pk_bf16(v1[2], v1[3]);
                    if (kind == 0) *(u32x4*)(QB + (size_t)row * ::DM + col) = w;
                    else if (kind == 3) *(u32x4*)(GB + (size_t)row * ::DM + col) = w;
                    else {
                        float* fo = out + (kind == 1 ? (prompt ? ::O7 : ::O9) : (prompt ? ::O8 : ::O10)) + (size_t)(prompt ? row : rs) * ::DM + col;
#if STAGE == 3
                        *(f32x4*)fo = v0 * 3.f; *(f32x4*)(fo + 4) = v1 * 3.f;
#else
                        *(f32x4*)fo = v0; *(f32x4*)(fo + 4) = v1;
#endif
                        bf16_t* bo = prompt ? (kind == 1 ? KBP : VBP) + (size_t)row * ::DM + col
                                            : (kind == 1 ? KCS : VCS) + ((size_t)(rs >> 6) * ::KVROWS + ::PAST + (rs & 63)) * ::DM + col;
                        *(u32x4*)bo = w; } } }
    }
};
struct EpiZ2 {
    static constexpr bool PERM = false, AFTER_DRAIN = false;
    const float* stats; const bf16_t* Z; const float* g1; const float* b1; float* out;
    __device__ __forceinline__ void operator()(const f32x4 (&acc)[2][2][4][2], const Unit& u, int wr, int wc, int fr, int fq) const {
        const int row0 = u.pm * BM + wr * 64 + fr, col0 = u.pn * BM + wc * 32 + 4 * fq;
        f32x4 gg[2][2], bb[2][2];
#pragma unroll
        for (int bj = 0; bj < 2; ++bj)
#pragma unroll
            for (int n = 0; n < 2; ++n) { gg[bj][n] = *(const f32x4*)(g1 + col0 + bj * HALF + 16 * n); bb[bj][n] = *(const f32x4*)(b1 + col0 + bj * HALF + 16 * n); }
#pragma unroll
        for (int ai = 0; ai < 2; ++ai)
#pragma unroll
            for (int m = 0; m < 4; ++m) { const int row = row0 + ai * HALF + m * 16;
                const float mean = stats[2 * row] * (1.f / 2048.f); const float var = stats[2 * row + 1] * (1.f / 2048.f) - mean * mean; const float rstd = 1.0f / sqrtf(var + 1e-5f);
                float* yo = out + (row < ::MP ? ::O0 + (size_t)row * ::DM : ::O1 + (size_t)(row - ::MP) * ::DM) + col0;
                const bf16_t* zr = Z + (size_t)row * ::DM + col0;
#pragma unroll
                for (int bj = 0; bj < 2; ++bj)
#pragma unroll
                    for (int n = 0; n < 2; ++n) { const u32x2 zw = *(const u32x2*)(zr + bj * HALF + 16 * n);
                        f32x4 z; z[0] = ::bflo(zw.x); z[1] = ::bfhi(zw.x); z[2] = ::bflo(zw.y); z[3] = ::bfhi(zw.y);
                        const f32x4 x1 = (z - mean) * rstd * gg[bj][n] + bb[bj][n];
                        *(f32x4*)(yo + bj * HALF + 16 * n) = acc[ai][bj][m][n] + x1 * ::ALPHA; } }
    }
};
}
#define XB_TMO      128
#define XB_XCNT(j)  (256  + 64 * (j))
#define XB_XSUB(j)  (1280 + 64 * (j))
#define XB_XGEN(j)  (2304 + 64 * (j))
#define XB_TOP      3328
#define XB_TOPGEN   3392
#define XCD_BAR_WORDS 3456
#define XB_SPIN_CAP (1u << 22)

__device__ __forceinline__ unsigned xb_ld(unsigned* p)              { return __hip_atomic_load(p, __ATOMIC_RELAXED, __HIP_MEMORY_SCOPE_AGENT); }
__device__ __forceinline__ unsigned xb_add(unsigned* p, unsigned v) { return __hip_atomic_fetch_add(p, v, __ATOMIC_RELAXED, __HIP_MEMORY_SCOPE_AGENT); }
__device__ __forceinline__ unsigned xb_xcc_id() { return (unsigned)__builtin_amdgcn_s_getreg((3 << 11) | 20) & 0xFu; }
#define XB_SPIN(cond, bar) do { unsigned _sp = 0; while (cond) { __builtin_amdgcn_s_sleep(1); \
    if ((++_sp & 255u) == 0u) { if (xb_ld(&(bar)[XB_TMO])) break; if (_sp > XB_SPIN_CAP) { atomicAdd(&(bar)[XB_TMO], 1u); break; } } } } while (0)

struct XcdBarrier {
    unsigned* bar; unsigned x;
    volatile LAS unsigned* st;
};

__device__ __forceinline__ XcdBarrier xcd_barrier_post(unsigned* bar, volatile LAS unsigned* st) {
    XcdBarrier b; b.bar = bar; b.x = xb_xcc_id(); b.st = st;
    if (threadIdx.x == 0) (void)xb_add(&bar[XB_XCNT(b.x)], 1u);
    return b;
}
__device__ __forceinline__ void xcd_barrier_complete(unsigned* bar, unsigned x, unsigned& nloc, unsigned& nx) {
    const unsigned G = gridDim.x * gridDim.y * gridDim.z;
    unsigned sum, cnt, mine, sp = 0u;
    for (;;) {
        sum = 0u; cnt = 0u; mine = 0u;
#pragma unroll
        for (unsigned j = 0; j < 16; ++j) { const unsigned c = xb_ld(&bar[XB_XCNT(j)]); sum += c; cnt += (c > 0u) ? 1u : 0u; mine = (j == x) ? c : mine; }
        if (sum == G) break;
        __builtin_amdgcn_s_sleep(1);
        if ((++sp & 255u) == 0u) { if (xb_ld(&bar[XB_TMO])) break; if (sp > XB_SPIN_CAP) { atomicAdd(&bar[XB_TMO], 1u); break; } }
    }
    nloc = mine > 0u ? mine : 1u; nx = cnt > 0u ? cnt : 1u;
}

__device__ __forceinline__ void xcd_barrier(const XcdBarrier& b) {
    asm volatile("s_waitcnt vmcnt(0)" ::: "memory");
    __syncthreads();
    if (threadIdx.x == 0) {
        unsigned* bar = b.bar;
        __builtin_amdgcn_s_waitcnt(0);
        unsigned nloc = b.st[0], nx = b.st[1];
        if (nloc == 0u) { xcd_barrier_complete(bar, b.x, nloc, nx); b.st[0] = nloc; b.st[1] = nx; }
        const unsigned old = xb_add(&bar[XB_XSUB(b.x)], 1u);
        const unsigned gen = old / nloc;
        if (old + 1u == (gen + 1u) * nloc) {
            __builtin_amdgcn_fence(__ATOMIC_RELEASE, "agent");
            asm volatile("s_waitcnt vmcnt(0)" ::: "memory");
            const unsigned og = xb_add(&bar[XB_TOP], 1u);
            const unsigned tg = og / nx;
            if (og + 1u == (tg + 1u) * nx) xb_add(&bar[XB_TOPGEN], 1u);
            else XB_SPIN(xb_ld(&bar[XB_TOPGEN]) == tg, bar);
            __builtin_amdgcn_fence(__ATOMIC_ACQUIRE, "agent");
            xb_add(&bar[XB_XGEN(b.x)], 1u);
            asm volatile("s_waitcnt vmcnt(0)" ::: "memory");
        } else {
            XB_SPIN(xb_ld(&bar[XB_XGEN(b.x)]) == gen, bar);
            __builtin_amdgcn_fence(__ATOMIC_ACQUIRE, "agent");
            asm volatile("s_waitcnt vmcnt(0)" ::: "memory");
        }
    }
    __syncthreads();
}
struct Args { const float* in[33]; float* out; unsigned char* ws; int ph_lo, ph_hi; };
enum { I_XP = 0, I_XS, I_SHIFT, I_WKV, I_CK, I_CV, I_WIN, I_ALNG, I_ALNB, I_AWS, I_ABS, I_MU, I_W0, I_W2, I_A0, I_A2, I_KK, I_KA, I_RK, I_LNXG, I_LNXB, I_WOUT, I_LNG, I_LNB,
       I_CWIN, I_LQ1, I_LK1, I_LQ2, I_LK2, I_SUBG, I_CWOUT, I_CLNG, I_CLNB };

__device__ __forceinline__ void p0_transpose_item(const float* W, int K, int N, bf16* WT, LAS float* scr, int item, int lane, const float* kscale, const float* kbias, float* colsum, float* bwsum) {
    const int nblk = N / 32, kb = item / nblk, nb = item % nblk, k0 = 64 * kb, n0 = 32 * nb;
    float csum = 0.f, bsum = 0.f;
#pragma unroll 8
    for (int i = 0; i < 32; ++i) { const int kk = 2 * i + (lane >> 5); float v = W[(size_t)(k0 + kk) * N + n0 + (lane & 31)];
        if (kscale) { bsum += v * kbias[k0 + kk]; v = __builtin_bit_cast(float, f2bf(v * kscale[k0 + kk]) << 16); csum += v; }
        scr[kk * 33 + (lane & 31)] = v; }
    if (kscale) { csum += __shfl_xor(csum, 32); bsum += __shfl_xor(bsum, 32); if (lane < 32) { unsafeAtomicAdd(colsum + n0 + lane, csum); unsafeAtomicAdd(bwsum + n0 + lane, bsum); } }
    asm volatile("s_waitcnt lgkmcnt(0)" ::: "memory");
    const int c = lane & 7;
#pragma unroll
    for (int j = 0; j < 4; ++j) { const int n = (lane >> 3) + 8 * j; const LAS float* s = scr + (8 * c) * 33 + n;
        u32x4 o; o.x = pk2(s[0 * 33], s[1 * 33]); o.y = pk2(s[2 * 33], s[3 * 33]); o.z = pk2(s[4 * 33], s[5 * 33]); o.w = pk2(s[6 * 33], s[7 * 33]);
        *(u32x4*)(WT + (size_t)(n0 + n) * K + k0 + 8 * c) = o; }
    asm volatile("s_waitcnt lgkmcnt(0)" ::: "memory");
}
__device__ __forceinline__ void row_f32_to_bf16(const float* src, bf16* dst, int lane) {
#pragma unroll
    for (int j = 0; j < 8; ++j) { const f32x4 v = ((const f32x4*)src)[lane + 64 * j]; u32x2 o; o.x = pk2(v[0], v[1]); o.y = pk2(v[2], v[3]); ((u32x2*)dst)[lane + 64 * j] = o; }
}
__device__ __forceinline__ void p0_prologue(const Args& A, LAS unsigned char* lds, int vcu, int G, int wave, int lane, int tid) {
    unsigned char* ws = A.ws;
    LAS float* scr = (LAS float*)(lds + wave * 16384);
    const int gw = vcu * 8 + wave, NGW = G * 8;
    constexpr int I1 = 32 * (PAB / 32), I2 = 32 * 64, I3 = 32 * (PCN / 32), I4 = 32 * 64;
    for (int it = gw; it < I1 + I2 + I3 + I4; it += NGW) {
        int r = it;
        if (r < I1) { p0_transpose_item(A.in[I_WIN], DM, PAB, (bf16*)(ws + WS_WTIN), scr, r, lane, nullptr, nullptr, nullptr, nullptr); continue; } r -= I1;
        if (r < I2) { p0_transpose_item(A.in[I_WOUT], DM, DM, (bf16*)(ws + WS_WTOUT), scr, r, lane, nullptr, nullptr, nullptr, nullptr); continue; } r -= I2;
        if (r < I3) { p0_transpose_item(A.in[I_CWIN], DM, PCN, (bf16*)(ws + WS_WTCIN), scr, r, lane, A.in[I_LNG], A.in[I_LNB], (float*)(ws + OFF_COLSUM), (float*)(ws + OFF_BW)); continue; } r -= I3;
        p0_transpose_item(A.in[I_CWOUT], DM, DM, (bf16*)(ws + WS_WTCOUT), scr, r, lane, nullptr, nullptr, nullptr, nullptr);
    }
    for (int m = gw; m < MT; m += NGW) row_f32_to_bf16(m < MP ? A.in[I_XP] + (size_t)m * DM : A.in[I_XS] + (size_t)(m - MP) * DM, (bf16*)(ws + WS_XB) + (size_t)m * DM, lane);
    for (int i = gw; i < 2 * NBS * PAST; i += NGW) { const int kv = i >> 15, r = i & 32767, b = r >> 12, t = r & 4095;
        row_f32_to_bf16(A.in[kv ? I_CV : I_CK] + (size_t)r * DM, (bf16*)(ws + (kv ? WS_VCS : WS_KCS)) + ((size_t)b * KVROWS + t) * DM, lane); }
    const int gt = vcu * 512 + tid, NT = G * 512;
    for (int idx = gt; idx < 65536; idx += NT) { const int n = idx >> 6, k = idx & 63;
        ((bf16*)(ws + WS_W2T))[idx] = (bf16)f2bf(A.in[I_W2][k * 1024 + n]); ((bf16*)(ws + WS_A2T))[idx] = (bf16)f2bf(A.in[I_A2][k * 1024 + n]);
        const int t = (idx >> 7) & 127, s = idx & 127; ((bf16*)(ws + WS_WSB))[idx] = (s <= t) ? (bf16)f2bf(A.in[I_AWS][idx]) : (bf16)0; }
    for (int idx = gt; idx < 32768; idx += NT) ((u32x4*)((bf16*)(ws + WS_WTIN) + (size_t)PAB * DM))[idx] = (u32x4){0u, 0u, 0u, 0u};
}
constexpr int VNT_STRIDE = 272;
__device__ __forceinline__ void mixer_a_unit(const Args& A, LAS unsigned char* lds, int ci, int g, int wave, int lane, int tid) {
    const bf16* PROJ = (const bf16*)(A.ws + WS_PROJ);
    bf16* OA = (bf16*)(A.ws + WS_XB);
    const bool prompt = ci < 128; const int m0 = prompt ? ci * 128 : MP + (ci - 128) * 64, L = prompt ? 128 : 64;
    LAS float* st = (LAS float*)lds; LAS unsigned char* vnT = lds + 1024;
    for (int i = 0; i < 16; ++i) { const int tok = wave * 16 + i; if (tok < L) {
        const bf16* row = PROJ + (size_t)(m0 + tok) * PABP + COL_VA + lane * 16;
        float f[16]; { float a[8], b[8]; unpack8(*(const u32x4*)row, a); unpack8(*(const u32x4*)(row + 8), b);
#pragma unroll
            for (int j = 0; j < 8; ++j) { f[j] = a[j]; f[8 + j] = b[j]; } }
        float s = 0.f;
#pragma unroll
        for (int j = 0; j < 16; ++j) s += f[j];
        const float mean = wave_sum(s) * (1.f / 1024.f); float q = 0.f;
#pragma unroll
        for (int j = 0; j < 16; ++j) { const float d = f[j] - mean; q += d * d; }
        const float rstd = 1.0f / sqrtf(wave_sum(q) * (1.f / 1024.f) + 1e-5f);
        if (lane == 0) { st[2 * tok] = mean; st[2 * tok + 1] = rstd; } } }
    __syncthreads();
    { const int s = tid & 127, og = tid >> 7;
      if (s < L) { const float mean = st[2 * s], rstd = st[2 * s + 1];
        for (int it = 0; it < 8; ++it) { const int oct = it * 4 + og, c0 = g * 256 + oct * 8;
            float x[8]; unpack8(*(const u32x4*)(PROJ + (size_t)(m0 + s) * PABP + COL_VA + c0), x);
            const f32x4 g0 = *(const f32x4*)(A.in[I_ALNG] + c0), g1 = *(const f32x4*)(A.in[I_ALNG] + c0 + 4), b0 = *(const f32x4*)(A.in[I_ALNB] + c0), b1 = *(const f32x4*)(A.in[I_ALNB] + c0 + 4);
            float v[8];
#pragma unroll
            for (int j = 0; j < 4; ++j) { v[j] = (x[j] - mean) * rstd * g0[j] + b0[j]; v[4 + j] = (x[4 + j] - mean) * rstd * g1[j] + b1[j]; }
            if (!prompt) { float* o = A.out + O6 + (size_t)((ci - 128) * 64 + s) * 1024 + c0;
#if STAGE == 1
                *(f32x4*)o = (f32x4){3.f * v[0], 3.f * v[1], 3.f * v[2], 3.f * v[3]}; *(f32x4*)(o + 4) = (f32x4){3.f * v[4], 3.f * v[5], 3.f * v[6], 3.f * v[7]};
#else
                *(f32x4*)o = (f32x4){v[0], v[1], v[2], v[3]}; *(f32x4*)(o + 4) = (f32x4){v[4], v[5], v[6], v[7]};
#endif
            }
#pragma unroll
            for (int j = 0; j < 8; ++j) *(LAS bf16*)(vnT + (oct * 8 + j) * VNT_STRIDE + s * 2) = (bf16)f2bf(v[j]); } } }
    __syncthreads();
    const int ti = wave & 3, ch = wave >> 2, r32 = lane & 31, hi = lane >> 5;
    if (ti * 32 < L) {
        const bf16* Wg = (const bf16*)(A.ws + WS_WSB) + g * 16384;
        f32x16 acc[4];
#pragma unroll
        for (int c = 0; c < 4; ++c) acc[c] = (f32x16){0.f};
        for (int ks = 0; ks <= 2 * ti + 1; ++ks) {
            const bf16x8 af = *(const bf16x8*)(Wg + (32 * ti + r32) * 128 + 16 * ks + 8 * hi);
#pragma unroll
            for (int c = 0; c < 4; ++c) { const bf16x8 bfr = *(const LAS bf16x8*)(vnT + (32 * (ch * 4 + c) + r32) * VNT_STRIDE + (16 * ks + 8 * hi) * 2);
                acc[c] = __builtin_amdgcn_mfma_f32_32x32x16_bf16(af, bfr, acc[c], 0, 0, 0); } }
#pragma unroll
        for (int reg = 0; reg < 16; ++reg) { const int t = 32 * ti + (reg & 3) + 8 * (reg >> 2) + 4 * hi; const size_t m = (size_t)(m0 + t);
            const float bias = A.in[I_ABS][g * 128 + t];
#pragma unroll
            for (int c = 0; c < 4; ++c) { const int col = g * 256 + 32 * (ch * 4 + c) + r32;
                const float u = bf1(PROJ[m * PABP + col]), ga = bf1(PROJ[m * PABP + COL_GA + col]);
                OA[m * DM + col] = (bf16)f2bf(u * (acc[c][reg] + bias) * siluf_(ga)); } }
    }
    __syncthreads();
}

__device__ __forceinline__ void load_hs8(const bf16* cur, const bf16* prev, const float* shift, const float* mu, float (&o)[8]) {
    float c[8], p[8]; unpack8(*(const u32x4*)cur, c);
    if (prev) unpack8(*(const u32x4*)prev, p);
    else if (shift) { const f32x4 a = *(const f32x4*)shift, b = *(const f32x4*)(shift + 4);
#pragma unroll
        for (int j = 0; j < 4; ++j) { p[j] = a[j]; p[4 + j] = b[j]; } }
    else {
#pragma unroll
        for (int j = 0; j < 8; ++j) p[j] = 0.f; }
    const f32x4 m0 = *(const f32x4*)mu, m1 = *(const f32x4*)(mu + 4);
#pragma unroll
    for (int j = 0; j < 4; ++j) { o[j] = c[j] + (p[j] - c[j]) * m0[j]; o[4 + j] = c[4 + j] + (p[4 + j] - c[4 + j]) * m1[j]; }
}
__device__ __forceinline__ void prep_unit(const Args& A, int tile, int hd, int lane) {
    const bf16* PROJ = (const bf16*)(A.ws + WS_PROJ);
    bf16* SI = (bf16*)(A.ws + WS_SCANIN);
    const bf16* w2t = (const bf16*)(A.ws + WS_W2T); const bf16* a2t = (const bf16*)(A.ws + WS_A2T);
    const float* mu = A.in[I_MU];
    const int r32 = lane & 31, hi = lane >> 5, m0 = tile * 32;
    const bool prompt = m0 < MP;
    const int bseq = prompt ? (m0 >> 12) : ((m0 - MP) >> 6), t0 = prompt ? (m0 & 4095) : ((m0 - MP) & 63);
    const float* shiftrow = prompt ? nullptr : A.in[I_SHIFT] + (size_t)bseq * DSH;
    const size_t sbase = prompt ? ((size_t)(bseq * 16 + hd) * SEQ + t0) * 384 : SCAN_SBASE + ((size_t)(bseq * 16 + hd) * DSQ + t0) * 384;
    bf16x8 fw[4], fa[4];
    { const int m = m0 + r32; const bf16* cur = PROJ + (size_t)m * PABP + COL_HB; const bool first = (t0 + r32) == 0;
      const bf16* prev = first ? nullptr : cur - PABP;
#pragma unroll
      for (int ks = 0; ks < 4; ++ks) { const int off = 16 * ks + 8 * hi; float x[8];
          load_hs8(cur + 3072 + off, prev ? prev + 3072 + off : nullptr, shiftrow ? shiftrow + 3072 + off : nullptr, mu + 3072 + off, x);
          u32x4 w;
#pragma unroll
          for (int j = 0; j < 8; ++j) x[j] = 1.f - 2.f * __builtin_amdgcn_rcpf(__expf(2.f * x[j]) + 1.f);
          w.x = pk2(x[0], x[1]); w.y = pk2(x[2], x[3]); w.z = pk2(x[4], x[5]); w.w = pk2(x[6], x[7]); fw[ks] = __builtin_bit_cast(bf16x8, w);
          load_hs8(cur + 3136 + off, prev ? prev + 3136 + off : nullptr, shiftrow ? shiftrow + 3136 + off : nullptr, mu + 3136 + off, x);
          w.x = pk2(x[0], x[1]); w.y = pk2(x[2], x[3]); w.z = pk2(x[4], x[5]); w.w = pk2(x[6], x[7]); fa[ks] = __builtin_bit_cast(bf16x8, w); } }
    f32x16 dw[2], da[2];
#pragma unroll
    for (int nb = 0; nb < 2; ++nb) { dw[nb] = (f32x16){0.f}; da[nb] = (f32x16){0.f};
#pragma unroll
        for (int ks = 0; ks < 4; ++ks) { const int o = (hd * 64 + 32 * nb + r32) * 64 + 16 * ks + 8 * hi;
            dw[nb] = __builtin_amdgcn_mfma_f32_32x32x16_bf16(fw[ks], *(const bf16x8*)(w2t + o), dw[nb], 0, 0, 0);
            da[nb] = __builtin_amdgcn_mfma_f32_32x32x16_bf16(fa[ks], *(const bf16x8*)(a2t + o), da[nb], 0, 0, 0); } }
    float kkr[2][16], av[2][16], ssq[16];
#pragma unroll
    for (int reg = 0; reg < 16; ++reg) ssq[reg] = 0.f;
#pragma unroll
    for (int nb = 0; nb < 2; ++nb) { const int cl = 32 * nb + r32, C = hd * 64 + cl;
        const float w0 = A.in[I_W0][C], a0 = A.in[I_A0][C], kks = A.in[I_KK][C], kas = A.in[I_KA][C], mur = mu[C], muk = mu[1024 + C], muv = mu[2048 + C];
        const float sr = shiftrow ? shiftrow[C] : 0.f, sk = shiftrow ? shiftrow[1024 + C] : 0.f, sv = shiftrow ? shiftrow[2048 + C] : 0.f;
#pragma unroll
        for (int reg = 0; reg < 16; ++reg) { const int tl = (reg & 3) + 8 * (reg >> 2) + 4 * hi; const size_t m = (size_t)(m0 + tl);
            const bf16* cur = PROJ + m * PABP + COL_HB + C; const bool first = (t0 + tl) == 0;
            const float cr = bf1(cur[0]), ck = bf1(cur[1024]), cv = bf1(cur[2048]);
            const float pr = first ? sr : bf1(cur[-PABP]), pk = first ? sk : bf1(cur[1024 - PABP]), pv = first ? sv : bf1(cur[2048 - PABP]);
            const float r = cr + (pr - cr) * mur, k = ck + (pk - ck) * muk, v = cv + (pv - cv) * muv;
            const float e = 0.60653065971f * sigmoidf_(w0 + dw[nb][reg]);
            const float a = sigmoidf_(a0 + da[nb][reg]);
            const float kr = k * kks; kkr[nb][reg] = kr; av[nb][reg] = a; ssq[reg] += kr * kr;
            bf16* o = SI + sbase + (size_t)tl * 384 + cl;
            o[0] = (bf16)f2bf(r); o[64] = (bf16)f2bf(e); o[128] = (bf16)f2bf(k * (1.f + (a - 1.f) * kas)); o[192] = (bf16)f2bf(v); } }
#pragma unroll
    for (int reg = 0; reg < 16; ++reg) { float s = ssq[reg];
        s += __shfl_xor(s, 1); s += __shfl_xor(s, 2); s += __shfl_xor(s, 4); s += __shfl_xor(s, 8); s += __shfl_xor(s, 16);
        ssq[reg] = 1.0f / fmaxf(sqrtf(s), 1e-12f); }
#pragma unroll
    for (int nb = 0; nb < 2; ++nb) { const int cl = 32 * nb + r32;
#pragma unroll
        for (int reg = 0; reg < 16; ++reg) { const int tl = (reg & 3) + 8 * (reg >> 2) + 4 * hi;
            const float kk = kkr[nb][reg] * ssq[reg]; bf16* o = SI + sbase + (size_t)tl * 384 + cl;
            o[256] = (bf16)f2bf(kk); o[320] = (bf16)f2bf(kk * av[nb][reg]); } }
}
constexpr int SCAN_TS = 32, SCAN_BUF = 45056;
__device__ __forceinline__ float dpp_add16(float x) {
    x += __builtin_bit_cast(float, __builtin_amdgcn_update_dpp(0, __builtin_bit_cast(int, x), 0xB1, 0xF, 0xF, true));
    x += __builtin_bit_cast(float, __builtin_amdgcn_update_dpp(0, __builtin_bit_cast(int, x), 0x4E, 0xF, 0xF, true));
    x += __builtin_bit_cast(float, __builtin_amdgcn_update_dpp(0, __builtin_bit_cast(int, x), 0x124, 0xF, 0xF, true));
    x += __builtin_bit_cast(float, __builtin_amdgcn_update_dpp(0, __builtin_bit_cast(int, x), 0x128, 0xF, 0xF, true));
    return x;
}
struct ScanRegs { u32x4 v[6]; };
__device__ __forceinline__ void scan_load(ScanRegs& R, const bf16* src, int lt) {
#pragma unroll
    for (int j = 0; j < 6; ++j) R.v[j] = *(const u32x4*)(src + (size_t)(lt + 256 * j) * 8);
}
__device__ __forceinline__ void scan_stage(const ScanRegs& R, LAS float* buf, int lt, int qr) {
#pragma unroll
    for (int j = 0; j < 6; ++j) { const int e0 = (lt + 256 * j) * 8, tl = e0 / 384, rem = e0 % 384, which = rem >> 6, ch = rem & 63;
        float f[8]; unpack8(R.v[j], f);
        if (which == 3) { if ((ch >> 4) == qr) { LAS float* d = buf + 10240 + tl * 16 + (ch & 15); *(LAS f32x4*)d = (f32x4){f[0], f[1], f[2], f[3]}; *(LAS f32x4*)(d + 4) = (f32x4){f[4], f[5], f[6], f[7]}; } }
        else { const int slot = which == 0 ? 4 : which == 1 ? 1 : which == 2 ? 3 : which == 4 ? 0 : 2;
            if (which == 1) {
#pragma unroll
                for (int i = 0; i < 8; ++i) f[i] = __expf(-f[i]); }
            LAS float* d = buf + (tl * 5 + slot) * 64 + ch; *(LAS f32x4*)d = (f32x4){f[0], f[1], f[2], f[3]}; *(LAS f32x4*)(d + 4) = (f32x4){f[4], f[5], f[6], f[7]}; } }
}
__device__ __forceinline__ void scan_unit(const Args& A, LAS unsigned char* lds, int seq, int hd, int qr, int wave, int lane, int tid) {
    const bool prompt = seq < NBP; const int bs = prompt ? seq : seq - NBP, T = prompt ? SEQ : DSQ, nblk = T / SCAN_TS;
    const bf16* SI = (const bf16*)(A.ws + WS_SCANIN) + (prompt ? (size_t)(bs * 16 + hd) * SEQ * 384 : SCAN_SBASE + (size_t)(bs * 16 + hd) * DSQ * 384);
    float* Y = (float*)(A.ws + WS_Y) + (size_t)(prompt ? bs * SEQ : MP + bs * DSQ) * 1024 + hd * 64 + qr * 16;
    const bool loader = wave >= 4; const int lt = tid - 256;
    const int rowl = (wave & 3) * 4 + (lane >> 4), kq = lane & 15;
    f32x4 S = (f32x4){0.f, 0.f, 0.f, 0.f};
    if (!loader && !prompt) S = *(const f32x4*)(A.in[I_WKV] + ((size_t)(bs * 16 + hd) * 64 + qr * 16 + rowl) * 64 + 4 * kq);
    ScanRegs R;
    if (loader) { scan_load(R, SI, lt); scan_stage(R, (LAS float*)lds, lt, qr); if (nblk > 1) scan_load(R, SI + SCAN_TS * 384, lt); }
    __syncthreads();
    for (int i = 0; i < nblk; ++i) {
        LAS float* buf = (LAS float*)(lds + (i & 1) * SCAN_BUF);
        if (!loader) {
            for (int t = 0; t < SCAN_TS; ++t) {
                const LAS f32x4* p = (const LAS f32x4*)(buf + t * 320) + kq;
                const f32x4 kk = p[0], w = p[16], b = p[32], k = p[48], r = p[64];
                const float vv = buf[10240 + t * 16 + rowl];
                float sk = S[0] * kk[0] + S[1] * kk[1] + S[2] * kk[2] + S[3] * kk[3];
                sk = dpp_add16(sk);
                S = S * w + k * vv - b * sk;
                float y = S[0] * r[0] + S[1] * r[1] + S[2] * r[2] + S[3] * r[3];
                y = dpp_add16(y);
                if (kq == 0) buf[10752 + t * 16 + rowl] = y;
            }
        } else {
            if (i + 1 < nblk) { scan_stage(R, (LAS float*)(lds + ((i + 1) & 1) * SCAN_BUF), lt, qr); if (i + 2 < nblk) scan_load(R, SI + (size_t)(i + 2) * SCAN_TS * 384, lt); }
            if (i > 0) { const LAS float* yb = (const LAS float*)(lds + ((i - 1) & 1) * SCAN_BUF) + 10752;
#pragma unroll
                for (int j = 0; j < 2; ++j) { const int idx = lt + 256 * j; Y[(size_t)((i - 1) * SCAN_TS + (idx >> 4)) * 1024 + (idx & 15)] = yb[idx]; } }
        }
        __syncthreads();
    }
    if (loader) { const LAS float* yb = (const LAS float*)(lds + ((nblk - 1) & 1) * SCAN_BUF) + 10752;
#pragma unroll
        for (int j = 0; j < 2; ++j) { const int idx = lt + 256 * j; Y[(size_t)((nblk - 1) * SCAN_TS + (idx >> 4)) * 1024 + (idx & 15)] = yb[idx]; } }
    else { float* o = A.out + (prompt ? O3 : O5) + ((size_t)(bs * 16 + hd) * 64 + qr * 16 + rowl) * 64 + 4 * kq;
#if STAGE == 2
        *(f32x4*)o = S * 3.f;
#else
        *(f32x4*)o = S;
#endif
    }
    __syncthreads();
}

__device__ __forceinline__ void p2c_task(const Args& A, int m, int hd, int lane) {
    const bf16* PROJ = (const bf16*)(A.ws + WS_PROJ);
    const bool prompt = m < MP; const int bs = prompt ? (m >> 12) : ((m - MP) >> 6), t = prompt ? (m & 4095) : ((m - MP) & 63);
    const bf16* SI = (const bf16*)(A.ws + WS_SCANIN) + (prompt ? ((size_t)(bs * 16 + hd) * SEQ + t) * 384 : SCAN_SBASE + ((size_t)(bs * 16 + hd) * DSQ + t) * 384);
    const int C = hd * 64 + lane;
    const float y = ((const float*)(A.ws + WS_Y))[(size_t)m * 1024 + C];
    const float mean = wave_sum(y) * (1.f / 64.f); const float d = y - mean; const float var = wave_sum(d * d) * (1.f / 64.f);
    const float yn = d * (1.0f / sqrtf(var + 64e-5f)) * A.in[I_LNXG][C] + A.in[I_LNXB][C];
    const float r = bf1(SI[lane]), km = bf1(SI[128 + lane]), v = bf1(SI[192 + lane]);
    const float bonus = wave_sum(r * km * A.in[I_RK][C]) * v;
    const float gb = bf1(PROJ[(size_t)m * PABP + COL_GB + C]);
    ((bf16*)(A.ws + WS_XB))[(size_t)m * DM + 1024 + C] = (bf16)f2bf((yn + bonus) * siluf_(gb));
}
constexpr int ATT_KROW = 272, ATT_VROW = 576, ATT_KMAP = 64 * ATT_KROW, ATT_STAGE = 2 * ATT_KMAP + 64 * ATT_VROW, ATT_SCR = 2 * ATT_STAGE;
constexpr float ATT_THR = 6.0f;
struct AttnJob { const bf16* Q; const bf16* K; const bf16* V; int ntiles; float* Op; float* ML; };
__device__ __forceinline__ s16x4 vtr(const LAS unsigned char* p) { typedef short v4i16_t __attribute__((ext_vector_type(4))); return __builtin_bit_cast(s16x4, __builtin_amdgcn_ds_read_tr16_b64_v4i16((LAS v4i16_t*)p)); }
__device__ __forceinline__ void attn_job(const AttnJob& J, LAS unsigned char* lds, int wave, int lane, int tid) {
    const int r32 = lane & 31, hi = lane >> 5, map = wave & 1, qg = (wave >> 1) & 1, dvh = wave >> 2;
    bf16x8 qf[8];
#pragma unroll
    for (int ds = 0; ds < 8; ++ds) qf[ds] = *(const bf16x8*)(J.Q + (size_t)(qg * 32 + r32) * DM + map * 128 + ds * 16 + hi * 8);
    f32x16 o[4];
#pragma unroll
    for (int d = 0; d < 4; ++d) o[d] = (f32x16){0.f};
    float m_run = -1e30f, l_run = 0.f;
    LAS float* scr = (LAS float*)(lds + ATT_SCR) + wave * 64;
    const unsigned goff = (unsigned)(((tid >> 5) * DM + (tid & 31) * 8) * 2);
    const int kdst = ((tid & 31) >> 4) * ATT_KMAP + (tid >> 5) * ATT_KROW + (tid & 15) * 16, vdst = 2 * ATT_KMAP + (tid >> 5) * ATT_VROW + (tid & 31) * 16;
    u32x4 ks[4], vs[4];
    { const char* Kt = (const char*)J.K; const char* Vt = (const char*)J.V;
#pragma unroll
      for (int i = 0; i < 4; ++i) { ks[i] = *(const u32x4*)(Kt + (size_t)i * 16 * DM * 2 + goff); vs[i] = *(const u32x4*)(Vt + (size_t)i * 16 * DM * 2 + goff); } }
#pragma unroll
    for (int i = 0; i < 4; ++i) { *(LAS u32x4*)(lds + kdst + i * 16 * ATT_KROW) = ks[i]; *(LAS u32x4*)(lds + vdst + i * 16 * ATT_VROW) = vs[i]; }
    __syncthreads();
    const int koff = map * ATT_KMAP + r32 * ATT_KROW + hi * 16;
    const int voff = 2 * ATT_KMAP + (4 * hi + ((lane & 15) >> 2)) * ATT_VROW + (dvh * 128 + ((lane >> 4) & 1) * 16 + (lane & 3) * 4) * 2;
    for (int j = 0; j < J.ntiles; ++j) {
        const LAS unsigned char* st = lds + (j & 1) * ATT_STAGE;
        const bool more = (j + 1) < J.ntiles;
        if (more) { const char* Kt = (const char*)J.K + (size_t)(j + 1) * 64 * DM * 2; const char* Vt = (const char*)J.V + (size_t)(j + 1) * 64 * DM * 2;
#pragma unroll
            for (int i = 0; i < 4; ++i) { ks[i] = *(const u32x4*)(Kt + (size_t)i * 16 * DM * 2 + goff); vs[i] = *(const u32x4*)(Vt + (size_t)i * 16 * DM * 2 + goff); } }
        f32x16 p0 = (f32x16){0.f}, p1 = (f32x16){0.f};
#pragma unroll
        for (int ds = 0; ds < 8; ++ds) { const bf16x8 a0 = *(const LAS bf16x8*)(st + koff + ds * 32), a1 = *(const LAS bf16x8*)(st + koff + 32 * ATT_KROW + ds * 32);
            p0 = __builtin_amdgcn_mfma_f32_32x32x16_bf16(a0, qf[ds], p0, 0, 0, 0); p1 = __builtin_amdgcn_mfma_f32_32x32x16_bf16(a1, qf[ds], p1, 0, 0, 0);
            if (ds & 1) __builtin_amdgcn_sched_barrier(0); }
        float mx = fmaxf(p0[0], p1[0]);
#pragma unroll
        for (int r = 1; r < 16; ++r) mx = fmaxf(mx, fmaxf(p0[r], p1[r]));
        mx = fmaxf(mx, __shfl_xor(mx, 32));
        if (__any(mx > m_run + ATT_THR)) {
            const float mn = fmaxf(m_run, mx), alpha = __builtin_amdgcn_exp2f(m_run - mn);
            m_run = mn; l_run *= alpha;
            if (hi == 0) scr[r32] = alpha;
            asm volatile("s_waitcnt lgkmcnt(0)" ::: "memory");
#pragma unroll
            for (int r = 0; r < 16; ++r) { const float al = scr[(r & 3) + 8 * (r >> 2) + 4 * hi];
#pragma unroll
                for (int d = 0; d < 4; ++d) o[d][r] *= al; }
        }
        float ls = 0.f;
#pragma unroll
        for (int r = 0; r < 16; ++r) { p0[r] = __builtin_amdgcn_exp2f(p0[r] - m_run); p1[r] = __builtin_amdgcn_exp2f(p1[r] - m_run); ls += p0[r] + p1[r]; }
        l_run += ls;
        u32x4 pw[4];
#pragma unroll
        for (int s = 0; s < 2; ++s) { pw[s] = (u32x4){cvt_pk_bf16(p0[8 * s], p0[8 * s + 1]), cvt_pk_bf16(p0[8 * s + 2], p0[8 * s + 3]), cvt_pk_bf16(p0[8 * s + 4], p0[8 * s + 5]), cvt_pk_bf16(p0[8 * s + 6], p0[8 * s + 7])};
            pw[2 + s] = (u32x4){cvt_pk_bf16(p1[8 * s], p1[8 * s + 1]), cvt_pk_bf16(p1[8 * s + 2], p1[8 * s + 3]), cvt_pk_bf16(p1[8 * s + 4], p1[8 * s + 5]), cvt_pk_bf16(p1[8 * s + 6], p1[8 * s + 7])}; }
#pragma unroll
        for (int s = 0; s < 4; ++s)
#pragma unroll
            for (int d = 0; d < 4; ++d) { const s16x4 lo = vtr(st + voff + (16 * s) * ATT_VROW + d * 64), hh = vtr(st + voff + (16 * s + 8) * ATT_VROW + d * 64);
                const bf16x8 vf = (bf16x8){lo[0], lo[1], lo[2], lo[3], hh[0], hh[1], hh[2], hh[3]};
                o[d] = __builtin_amdgcn_mfma_f32_32x32x16_bf16(__builtin_bit_cast(bf16x8, pw[s]), vf, o[d], 0, 0, 0);
                if (d == 3) __builtin_amdgcn_sched_barrier(0); }
        if (more) { LAS unsigned char* nx = lds + ((j + 1) & 1) * ATT_STAGE;
#pragma unroll
            for (int i = 0; i < 4; ++i) { *(LAS u32x4*)(nx + kdst + i * 16 * ATT_KROW) = ks[i]; *(LAS u32x4*)(nx + vdst + i * 16 * ATT_VROW) = vs[i]; } }
        __syncthreads();
    }
    l_run += __shfl_xor(l_run, 32);
    if (dvh == 0 && hi == 0) { J.ML[(map * 64 + qg * 32 + r32) * 2] = m_run; J.ML[(map * 64 + qg * 32 + r32) * 2 + 1] = l_run; }
#pragma unroll
    for (int d = 0; d < 4; ++d)
#pragma unroll
        for (int r = 0; r < 16; ++r) J.Op[(size_t)(map * 64 + qg * 32 + (r & 3) + 8 * (r >> 2) + 4 * hi) * 256 + dvh * 128 + d * 32 + r32] = o[d][r];
}

__device__ __forceinline__ void p6_task(const Args& A, int m, int h, float lam, int lane) {
    const bool prompt = m < MP;
    f32x4 on[2];
    if (prompt) { const int b = m >> 12, t = m & 4095, c = t >> 6, q = t & 63; const size_t base = (size_t)((b * 8 + h) * 64 + c);
#pragma unroll
        for (int j = 0; j < 2; ++j) { const float l = ((const float*)(A.ws + WS_MLP))[((base * 2 + j) * 64 + q) * 2 + 1];
            on[j] = ((const f32x4*)((const float*)(A.ws + WS_PARTP) + ((base * 2 + j) * 64 + q) * 256))[lane] * (1.0f / l); }
    } else { const int ms = m - MP, b = ms >> 6, q = ms & 63;
#pragma unroll
        for (int j = 0; j < 2; ++j) { float mm[4], ll[4], M = -1e30f;
#pragma unroll
            for (int s = 0; s < 4; ++s) { const size_t base = (size_t)((b * 8 + h) * 4 + s); const float* ml = (const float*)(A.ws + WS_MLS) + ((base * 2 + j) * 64 + q) * 2; mm[s] = ml[0]; ll[s] = ml[1]; M = fmaxf(M, mm[s]); }
            f32x4 acc = (f32x4){0.f, 0.f, 0.f, 0.f}; float L = 0.f;
#pragma unroll
            for (int s = 0; s < 4; ++s) { const size_t base = (size_t)((b * 8 + h) * 4 + s); const float w = __builtin_amdgcn_exp2f(mm[s] - M); L += w * ll[s];
                acc += ((const f32x4*)((const float*)(A.ws + WS_PARTS) + ((base * 2 + j) * 64 + q) * 256))[lane] * w; }
            on[j] = acc * (1.0f / L); } }
    const f32x4 of = on[0] - on[1] * lam;
    const float ss = wave_sum(of[0] * of[0] + of[1] * of[1] + of[2] * of[2] + of[3] * of[3]);
    const float rms = 1.0f / sqrtf(ss * (1.f / 256.f) + 1e-5f);
    const f32x4 sg = ((const f32x4*)A.in[I_SUBG])[lane];
    const u32x2 gw = *(const u32x2*)((const bf16*)(A.ws + WS_GB) + (size_t)m * DM + h * 256 + lane * 4);
    const float sc = rms * (1.f - LAM_INIT);
    u32x2 w; w.x = pk2(of[0] * sc * sg[0] * bflo(gw.x), of[1] * sc * sg[1] * bfhi(gw.x)); w.y = pk2(of[2] * sc * sg[2] * bflo(gw.y), of[3] * sc * sg[3] * bfhi(gw.y));
    *(u32x2*)((bf16*)(A.ws + WS_XB) + (size_t)m * DM + h * 256 + lane * 4) = w;
}
__device__ __forceinline__ void p8_row(const Args& A, int m, int lane) {
    float* y = A.out + (m < MP ? O0 + (size_t)m * DM : O1 + (size_t)(m - MP) * DM);
    f32x4 v[8]; float s = 0.f;
#pragma unroll
    for (int j = 0; j < 8; ++j) { v[j] = ((const f32x4*)y)[lane + 64 * j]; s += (v[j][0] + v[j][1]) + (v[j][2] + v[j][3]); }
    const float mean = wave_sum(s) * (1.f / 2048.f); float q = 0.f;
#pragma unroll
    for (int j = 0; j < 8; ++j) { v[j] = v[j] - mean; q += (v[j][0] * v[j][0] + v[j][1] * v[j][1]) + (v[j][2] * v[j][2] + v[j][3] * v[j][3]); }
    const float rstd = 1.0f / sqrtf(wave_sum(q) * (1.f / 2048.f) + 1e-5f);
#pragma unroll
    for (int j = 0; j < 8; ++j) { const f32x4 g = ((const f32x4*)A.in[I_CLNG])[lane + 64 * j], b = ((const f32x4*)A.in[I_CLNB])[lane + 64 * j];
        ((f32x4*)y)[lane + 64 * j] = v[j] * rstd * g + b; }
}
constexpr int N_PHASES = 11;
__global__ void __launch_bounds__(512, 2) mega_fwd(Args A) {
    extern __shared__ __attribute__((aligned(16))) unsigned char lds_raw[];
    LAS unsigned char* lds = (LAS unsigned char*)lds_raw;
    const int tid = threadIdx.x, lane = tid & 63, wave = __builtin_amdgcn_readfirstlane(tid >> 6);
    const int G = gridDim.x, bx = blockIdx.x, vcu = (G % 8 == 0) ? (bx % 8) * (G / 8) + bx / 8 : bx;
    unsigned char* ws = A.ws;
    unsigned* ctl = (unsigned*)(ws + WS_CTL);
    for (int u = tid; u < (LDS_BYTES - LDSCTL_OFF) / 4; u += 512) ((LAS unsigned*)(lds + LDSCTL_OFF))[u] = 0u;
    __syncthreads();
    XcdBarrier bar = xcd_barrier_post(ctl + CW_BAR, (volatile LAS unsigned*)(lds + MISC_OFF) + 8);
    const int lo = A.ph_lo, hi = A.ph_hi;
#ifndef PH_MASK
#define PH_MASK 0x7ff
#endif
#define IN(k) (((PH_MASK >> (k)) & 1) && lo <= (k) && (k) < hi)
#define SEAM(k) do { if (IN(k) && IN((k) + 1)) xcd_barrier(bar); } while (0)
    const int gw = vcu * 8 + wave, NGW = G * 8;

    if (IN(0)) p0_prologue(A, lds, vcu, G, wave, lane, tid);
    SEAM(0);
    if (IN(1)) {
        pg8::Gemm g{(const bf16*)(ws + WS_XB), (const bf16*)(ws + WS_WTIN), MT, PABP, DM}; pg8::StaticOrder S; S.init(MT, PABP, G, bx);
        pg8::EpiPlainBf16 E{(bf16*)(ws + WS_PROJ), PABP};
        pg8::gemm_phase<pg8::EpiPlainBf16, pg8::StaticOrder, true, true>(lds, g, S, E);
    }
    SEAM(1);
    if (IN(2)) {
        for (int u = vcu; u < 136 * 4; u += G) mixer_a_unit(A, lds, u >> 2, u & 3, wave, lane, tid);
        for (int wu = gw; wu < (MT / 32) * 16; wu += NGW) prep_unit(A, wu >> 4, wu & 15, lane);
        const bf16* PROJ = (const bf16*)(ws + WS_PROJ);
        for (int idx = vcu * 512 + tid; idx < 12 * DSH; idx += G * 512) { const int s = idx / DSH, c = idx % DSH;
            const int m = s < 4 ? s * SEQ + SEQ - 1 : MP + (s - 4) * DSQ + DSQ - 1;
            float v = bf1(PROJ[(size_t)m * PABP + COL_HB + c]);
#if STAGE == 1
            v *= 3.f;
#endif
            A.out[(s < 4 ? O2 + (size_t)s * DSH : O4 + (size_t)(s - 4) * DSH) + c] = v; }
    }
    SEAM(2);
    if (IN(3)) {
        for (int u = vcu; u < 256 + 512; u += G) { const int uu = u < 256 ? u : u - 256, seq = (u < 256 ? 0 : NBP) + (uu >> 6); scan_unit(A, lds, seq, (uu >> 2) & 15, uu & 3, wave, lane, tid); }
    }
    SEAM(3);
    if (IN(4)) { for (int wt = gw; wt < MT * 16; wt += NGW) p2c_task(A, wt >> 4, wt & 15, lane); }
    SEAM(4);
    if (IN(5)) {
        pg8::Gemm g{(const bf16*)(ws + WS_XB), (const bf16*)(ws + WS_WTOUT), MT, DM, DM}; pg8::StaticOrder S; S.init(MT, DM, G, bx);
        pg8::EpiZ1 E{A.in[I_XP], A.in[I_XS], (bf16*)(ws + WS_Z1), (float*)(ws + OFF_STATS1)};
        pg8::gemm_phase<pg8::EpiZ1, pg8::StaticOrder, true, true>(lds, g, S, E);
    }
    SEAM(5);
    if (IN(6)) {
        pg8::Gemm g{(const bf16*)(ws + WS_Z1), (const bf16*)(ws + WS_WTCIN), MT, PCN, DM}; pg8::StaticOrder S; S.init(MT, PCN, G, bx);
        pg8::EpiQKVG E{(const float*)(ws + OFF_STATS1), (const float*)(ws + OFF_COLSUM), (const float*)(ws + OFF_BW), (bf16*)(ws + WS_QB), (bf16*)(ws + WS_GB), (bf16*)(ws + WS_KBP), (bf16*)(ws + WS_VBP),
                       (bf16*)(ws + WS_KCS), (bf16*)(ws + WS_VCS), A.out};
        pg8::gemm_phase<pg8::EpiQKVG, pg8::StaticOrder, true, true>(lds, g, S, E);
    }
    SEAM(6);
    if (IN(7)) {
        for (int v0 = vcu; v0 < 256; v0 += G) {
            for (int i = 0; i < 9; ++i) {
                AttnJob J;
                if (i < 8) { const int bh = v0 >> 3, s = v0 & 7, b = bh >> 3, h = bh & 7; const int c = (i & 1) ? (16 * (i >> 1) + 15 - s) : (16 * (i >> 1) + s);
                    const size_t base = (size_t)((b * 8 + h) * 64 + c);
                    J.Q = (const bf16*)(ws + WS_QB) + (size_t)(b * SEQ + c * 64) * DM + h * 256; J.K = (const bf16*)(ws + WS_KBP) + (size_t)(b * SEQ) * DM + h * 256; J.V = (const bf16*)(ws + WS_VBP) + (size_t)(b * SEQ) * DM + h * 256;
                    J.ntiles = c + 1; J.Op = (float*)(ws + WS_PARTP) + base * 32768; J.ML = (float*)(ws + WS_MLP) + base * 256;
                } else { const int bh2 = v0 >> 2, sp = v0 & 3, b2 = bh2 >> 3, h2 = bh2 & 7, start = sp == 0 ? 0 : 17 + 16 * (sp - 1);
                    const size_t base = (size_t)((b2 * 8 + h2) * 4 + sp);
                    J.Q = (const bf16*)(ws + WS_QB) + (size_t)(MP + b2 * DSQ) * DM + h2 * 256; J.K = (const bf16*)(ws + WS_KCS) + ((size_t)b2 * KVROWS + start * 64) * DM + h2 * 256;
                    J.V = (const bf16*)(ws + WS_VCS) + ((size_t)b2 * KVROWS + start * 64) * DM + h2 * 256; J.ntiles = sp == 0 ? 17 : 16; J.Op = (float*)(ws + WS_PARTS) + base * 32768; J.ML = (float*)(ws + WS_MLS) + base * 256; }
                attn_job(J, lds, wave, lane, tid); }
        }
    }
    SEAM(7);
    if (IN(8)) {
        float s1 = A.in[I_LQ1][lane] * A.in[I_LK1][lane] + A.in[I_LQ1][lane + 64] * A.in[I_LK1][lane + 64], s2 = A.in[I_LQ2][lane] * A.in[I_LK2][lane] + A.in[I_LQ2][lane + 64] * A.in[I_LK2][lane + 64];
        const float lam = __expf(wave_sum(s1)) - __expf(wave_sum(s2)) + LAM_INIT;
        for (int wt = gw; wt < MT * 8; wt += NGW) p6_task(A, wt >> 3, wt & 7, lam, lane);
    }
    SEAM(8);
    if (IN(9)) {
        pg8::Gemm g{(const bf16*)(ws + WS_XB), (const bf16*)(ws + WS_WTCOUT), MT, DM, DM}; pg8::StaticOrder S; S.init(MT, DM, G, bx);
        pg8::EpiZ2 E{(const float*)(ws + OFF_STATS1), (const bf16*)(ws + WS_Z1), A.in[I_LNG], A.in[I_LNB], A.out};
        pg8::gemm_phase<pg8::EpiZ2, pg8::StaticOrder, true, true>(lds, g, S, E);
    }
    SEAM(9);
    if (IN(10)) { for (int m = gw; m < MT; m += NGW) p8_row(A, m, lane); }
#undef IN
#undef SEAM
}

extern "C" void kernel_launch(void* const* d_in, const int* in_sizes, int n_in, void* d_out, int out_size, void* d_ws, size_t ws_size, hipStream_t stream) {
    static int grid = 0;
    if (grid == 0) {
        if (n_in != 33 || (size_t)out_size != OUT_TOTAL || ws_size < WS_END) { fprintf(stderr, "kernel_launch: unexpected shapes: n_in %d out %d ws %zu (need %zu)\n", n_in, out_size, ws_size, (size_t)WS_END); grid = -1; return; }
        int dev = 0, cus = 0;
        if (hipGetDevice(&dev) != hipSuccess || hipDeviceGetAttribute(&cus, hipDeviceAttributeMultiprocessorCount, dev) != hipSuccess) { grid = -1; return; }
        if (hipFuncSetAttribute((const void*)mega_fwd, hipFuncAttributeMaxDynamicSharedMemorySize, LDS_BYTES) != hipSuccess) { fprintf(stderr, "kernel_launch: hipFuncSetAttribute failed\n"); grid = -1; return; }
        (void)hipGetLastError();
        grid = cus;
        if (grid != 256) fprintf(stderr, "kernel_launch: %d CUs; this kernel is laid out for 256\n", grid);
    }
    if (grid < 0) return;
    (void)hipMemsetAsync((char*)d_ws + WS_CTL, 0, CTL_ZERO_BYTES, stream);
    Args a{};
    for (int i = 0; i < 33; ++i) a.in[i] = (const float*)d_in[i];
    a.out = (float*)d_out; a.ws = (unsigned char*)d_ws;
#if STAGE == 1
    const int nph = 3;
#elif STAGE == 2
    const int nph = 4;
#elif STAGE == 3
    const int nph = 7;
#else
    const int nph = N_PHASES;
#endif
#if STAGE < 9
    (void)hipMemsetAsync(d_out, 0, (size_t)out_size * 4, stream);
#endif
#ifdef MULTI_LAUNCH
    for (int p = 0; p < nph; ++p) { a.ph_lo = p; a.ph_hi = p + 1; hipLaunchKernelGGL(mega_fwd, dim3(grid), dim3(512), LDS_BYTES, stream, a); }
#else
    a.ph_lo = 0; a.ph_hi = nph;
    hipLaunchKernelGGL(mega_fwd, dim3(grid), dim3(512), LDS_BYTES, stream, a);
#endif
}
```

```cpp
#include <hip/hip_runtime.h>
#include <cstdio>
#include <cstdint>
#ifndef STAGE
#define STAGE 9
#endif
namespace pg8 {
#define PG8_LAS __attribute__((address_space(3)))
typedef unsigned short bf16_t;
typedef short bf16x8 __attribute__((ext_vector_type(8)));
typedef float f32x4 __attribute__((ext_vector_type(4)));
typedef unsigned u32x4 __attribute__((ext_vector_type(4)));
constexpr int BM = 256, BK = 64, HALF = 128, HTB = HALF * BK * 2  , STAGE_BYTES = 8 * HTB, NXCD = 8, WGM = 8;

__host__ __device__ __forceinline__ int lds_byte(int r, int c) { const int st = (r >> 4) * 2 + (c >> 5), rr = r & 15, cc = c & 31, ob = rr * 64 + cc * 2; return st * 1024 + (ob ^ (((ob >> 9) & 1) << 5)); }
__host__ __device__ __forceinline__ void stage_rc(int b, int& R, int& C) { const int st = b / 1024, sb = b % 1024, swz = sb ^ (((sb >> 9) & 1) << 5); R = (st >> 1) * 16 + swz / 64; C = (st & 1) * 32 + (swz % 64) / 2; }
__host__ __device__ __forceinline__ int perm32(int rho) { const int n = rho >> 4, i = rho & 15; return 8 * (i >> 2) + 4 * n + (i & 3); }

struct Unit { int pm, pn; };
struct Gemm { const bf16_t* A; const bf16_t* Bt; int M, N, K; };

struct StaticOrder {
    int nM, nN, nwg, G, c;
    __host__ __device__ void init(int M, int N, int G_, int c_) { nM = M / BM; nN = N / BM; nwg = nM * nN; G = G_; c = c_; }
    __host__ __device__ bool next(int i, Unit& u) const {
        const long L = (long)i * G + c; if (L >= nwg) return false;
        int wgid = (int)L; { const int q = nwg / NXCD, r = nwg % NXCD, xcd = wgid % NXCD, off = wgid / NXCD; wgid = (xcd < r ? xcd * (q + 1) : r * (q + 1) + (xcd - r) * q) + off; }
        const int nig = WGM * nN, gid = wgid / nig, fm = gid * WGM, gsz = (nM - fm) < WGM ? (nM - fm) : WGM;
        u.pm = fm + ((wgid % nig) % gsz); u.pn = (wgid % nig) / gsz; return true;
    }
    __device__ __forceinline__ void a_ready(const Unit&) const {}
    __device__ __forceinline__ void done(const Unit&) const {}
};

__device__ __forceinline__ unsigned cvt_pk_bf16(float lo, float hi) { unsigned r; asm volatile("v_cvt_pk_bf16_f32 %0, %1, %2" : "=v"(r) : "v"(lo), "v"(hi)); return r; }
typedef float f32x2 __attribute__((ext_vector_type(2)));
template <class Epi, class Sched, bool ALIGN_EPI = false, bool SP2 = false>
__device__ __forceinline__ void gemm_phase(PG8_LAS unsigned char* lds, const Gemm g, const Sched& S, const Epi& E) {
    const int tid = threadIdx.x, wid = __builtin_amdgcn_readfirstlane(tid >> 6), lane = tid & 63, wr = wid >> 2, wc = wid & 3, fr = lane & 15, fq = lane >> 4;
    const int K = g.K, nt = K / BK;
    unsigned voffA[2], voffB[2];
#pragma unroll
    for (int i = 0; i < 2; ++i) { int R, C; stage_rc(tid * 16 + i * 8192, R, C); const int Rb = Epi::PERM ? ((R & ~31) + perm32(R & 31)) : R;
        voffA[i] = (unsigned)(R * K + C) * 2u; voffB[i] = (unsigned)(Rb * K + C) * 2u; }
    const size_t kstep = (size_t)(BK * 2);
    const size_t hstep = (size_t)HALF * K * 2;
    const size_t tstep = 2 * hstep;
    const unsigned ldsw = (unsigned)wid * 1024u;
    const int aoff = lds_byte(wr * 64 + fr, fq * 8), boff = lds_byte(wc * 32 + fr, fq * 8);
#define PG8_SA(b, h) (((b) * 2 + (h)) * HTB)
#define PG8_SB(b, h) ((4 + (b) * 2 + (h)) * HTB)
#define PG8_STAGE(bufoff, gbase, voff) do { _Pragma("unroll") for (int _i = 0; _i < 2; ++_i) \
        __builtin_amdgcn_global_load_lds((const unsigned*)((const char*)(gbase) + (voff)[_i]), (PG8_LAS unsigned*)(lds + (bufoff) + ldsw + _i * 8192), 16, 0, 0); } while (0)
#define PG8_LDA(dst, b, h) do { _Pragma("unroll") for (int m = 0; m < 4; ++m) _Pragma("unroll") for (int k = 0; k < 2; ++k) dst[m][k] = *(const PG8_LAS bf16x8*)(lds + PG8_SA(b, h) + aoff + m * 2048 + k * 1024); } while (0)
#define PG8_LDB(dst, b, h) do { _Pragma("unroll") for (int n = 0; n < 2; ++n) _Pragma("unroll") for (int k = 0; k < 2; ++k) dst[n][k] = *(const PG8_LAS bf16x8*)(lds + PG8_SB(b, h) + boff + n * 2048 + k * 1024); } while (0)
#define PG8_MMA(ai, bj, At, Bt) do { __builtin_amdgcn_s_setprio(1); _Pragma("unroll") for (int m = 0; m < 4; ++m) _Pragma("unroll") for (int n = 0; n < 2; ++n) _Pragma("unroll") for (int k = 0; k < 2; ++k) \
        acc[ai][bj][m][n] = __builtin_amdgcn_mfma_f32_16x16x32_bf16(Bt[n][k], At[m][k], acc[ai][bj][m][n], 0, 0, 0); __builtin_amdgcn_s_setprio(0); } while (0)
#define PG8_WAIT_V(n) asm volatile("s_waitcnt vmcnt(" #n ")" ::: "memory")
#define PG8_WAIT_L(n) asm volatile("s_waitcnt lgkmcnt(" #n ")" ::: "memory")
#define PG8_BAR __builtin_amdgcn_s_barrier()
#define PG8_SCHED __builtin_amdgcn_sched_barrier(0)
    Unit cur, nxt; int ui = 0;
    if (!S.next(0, cur)) return;
    f32x4 acc[2][2][4][2];
#pragma unroll
    for (int a = 0; a < 2; ++a)
#pragma unroll
        for (int b = 0; b < 2; ++b)
#pragma unroll
            for (int m = 0; m < 4; ++m)
#pragma unroll
                for (int n = 0; n < 2; ++n) acc[a][b][m][n] = (f32x4){0.f, 0.f, 0.f, 0.f};
    bf16x8 At[4][2], B0[2][2], B1[2][2];
    const char* cA = (const char*)g.A + (size_t)cur.pm * tstep; const char* cB = (const char*)g.Bt + (size_t)cur.pn * tstep;
    S.a_ready(cur);
    if constexpr (SP2) {
        PG8_STAGE(PG8_SB(0, 0), cB, voffB); PG8_STAGE(PG8_SB(0, 1), cB + hstep, voffB); PG8_STAGE(PG8_SA(0, 0), cA, voffA); PG8_STAGE(PG8_SA(0, 1), cA + hstep, voffA);
        if (wr == 1) PG8_BAR;
        PG8_WAIT_V(2); PG8_BAR;
        PG8_STAGE(PG8_SB(1, 0), cB + kstep, voffB); PG8_STAGE(PG8_SA(1, 0), cA + kstep, voffA); PG8_STAGE(PG8_SB(1, 1), cB + hstep + kstep, voffB);
        PG8_WAIT_V(6); PG8_BAR;
    } else {
        PG8_STAGE(PG8_SB(0, 0), cB, voffB); PG8_STAGE(PG8_SA(0, 0), cA, voffA); PG8_STAGE(PG8_SB(0, 1), cB + hstep, voffB); PG8_STAGE(PG8_SA(0, 1), cA + hstep, voffA);
        if (wr == 1) PG8_BAR;
        PG8_WAIT_V(4); PG8_BAR;
        PG8_STAGE(PG8_SB(1, 0), cB + kstep, voffB); PG8_STAGE(PG8_SA(1, 0), cA + kstep, voffA); PG8_STAGE(PG8_SB(1, 1), cB + hstep + kstep, voffB);
        PG8_WAIT_V(6); PG8_BAR;
    }
    for (;;) {
        const bool has_next = S.next(ui + 1, nxt);
        const char* nA = has_next ? (const char*)g.A + (size_t)nxt.pm * tstep : cA; const char* nB = has_next ? (const char*)g.Bt + (size_t)nxt.pn * tstep : cB;
        for (int t = 0; t < nt; t += 2) {
            const bool last = (t == nt - 2);
            const char* a1 = cA + (size_t)(t + 1) * kstep;
            const char* a2 = last ? nA : cA + (size_t)(t + 2) * kstep; const char* b2 = last ? nB : cB + (size_t)(t + 2) * kstep;
            const char* a3 = a2 + kstep; const char* b3 = b2 + kstep;
            if (last && has_next) S.a_ready(nxt);
            if constexpr (SP2) {
            PG8_LDB(B0, 0, 0); PG8_LDB(B1, 0, 1); PG8_SCHED; PG8_LDA(At, 0, 0); PG8_STAGE(PG8_SA(1, 1), a1 + hstep, voffA);
            PG8_WAIT_V(8); PG8_WAIT_L(0); PG8_BAR; PG8_MMA(0, 0, At, B0); PG8_MMA(0, 1, At, B1); PG8_BAR; PG8_SCHED;
            PG8_LDA(At, 0, 1); PG8_STAGE(PG8_SB(0, 0), b2, voffB); PG8_STAGE(PG8_SB(0, 1), b2 + hstep, voffB); PG8_STAGE(PG8_SA(0, 0), a2, voffA);
            PG8_WAIT_V(8); PG8_WAIT_L(0); PG8_BAR; PG8_MMA(1, 0, At, B0); PG8_MMA(1, 1, At, B1); PG8_BAR; PG8_SCHED;
            PG8_LDB(B0, 1, 0); PG8_LDB(B1, 1, 1); PG8_SCHED; PG8_LDA(At, 1, 0); PG8_STAGE(PG8_SA(0, 1), a2 + hstep, voffA);
            PG8_WAIT_V(8); PG8_WAIT_L(0); PG8_BAR; PG8_MMA(0, 0, At, B0); PG8_MMA(0, 1, At, B1); PG8_BAR; PG8_SCHED;
            PG8_LDA(At, 1, 1); PG8_STAGE(PG8_SB(1, 0), b3, voffB); PG8_STAGE(PG8_SB(1, 1), b3 + hstep, voffB); PG8_STAGE(PG8_SA(1, 0), a3, voffA);
            PG8_WAIT_V(8); PG8_WAIT_L(0); PG8_BAR; PG8_MMA(1, 0, At, B0); PG8_MMA(1, 1, At, B1); PG8_BAR; PG8_SCHED;
            } else {
            PG8_LDB(B0, 0, 0); PG8_SCHED; PG8_LDA(At, 0, 0); PG8_STAGE(PG8_SA(1, 1), a1 + hstep, voffA);
            PG8_WAIT_L(8); PG8_BAR; PG8_WAIT_L(0); PG8_MMA(0, 0, At, B0); PG8_BAR; PG8_SCHED;
            PG8_LDB(B1, 0, 1); PG8_STAGE(PG8_SB(0, 0), b2, voffB);
            PG8_BAR; PG8_WAIT_L(0); PG8_MMA(0, 1, At, B1); PG8_BAR;
            PG8_LDA(At, 0, 1); PG8_STAGE(PG8_SA(0, 0), a2, voffA);
            PG8_BAR; PG8_WAIT_L(0); PG8_MMA(1, 0, At, B0); PG8_BAR; PG8_SCHED;
            PG8_STAGE(PG8_SB(0, 1), b2 + hstep, voffB);
            PG8_WAIT_V(6); PG8_BAR; PG8_MMA(1, 1, At, B1); PG8_BAR;
            PG8_LDB(B0, 1, 0); PG8_SCHED; PG8_LDA(At, 1, 0); PG8_STAGE(PG8_SA(0, 1), a2 + hstep, voffA);
            PG8_WAIT_L(8); PG8_BAR; PG8_WAIT_L(0); PG8_MMA(0, 0, At, B0); PG8_BAR; PG8_SCHED;
            PG8_LDB(B1, 1, 1); PG8_STAGE(PG8_SB(1, 0), b3, voffB);
            PG8_BAR; PG8_WAIT_L(0); PG8_MMA(0, 1, At, B1); PG8_BAR;
            PG8_LDA(At, 1, 1); PG8_STAGE(PG8_SA(1, 0), a3, voffA);
            PG8_BAR; PG8_WAIT_L(0); PG8_MMA(1, 0, At, B0); PG8_BAR; PG8_SCHED;
            PG8_STAGE(PG8_SB(1, 1), b3 + hstep, voffB);
            PG8_WAIT_V(6); PG8_BAR; PG8_MMA(1, 1, At, B1); PG8_BAR;
            }
        }
        if constexpr (ALIGN_EPI) { if (wr == 0) PG8_BAR; }
        if constexpr (!Epi::AFTER_DRAIN) { E(acc, cur, wr, wc, fr, fq); S.done(cur); }
        if (!has_next) break;
#pragma unroll
        for (int a = 0; a < 2; ++a)
#pragma unroll
            for (int b = 0; b < 2; ++b)
#pragma unroll
                for (int m = 0; m < 4; ++m)
#pragma unroll
                    for (int n = 0; n < 2; ++n) acc[a][b][m][n] = (f32x4){0.f, 0.f, 0.f, 0.f};
        cur = nxt; cA = nA; cB = nB; ++ui;
        if constexpr (ALIGN_EPI) { if (wr == 1) PG8_BAR; }
    }
    PG8_WAIT_V(0);
    if constexpr (!ALIGN_EPI) { if (wr == 0) PG8_BAR; }
    PG8_BAR;
    if constexpr (Epi::AFTER_DRAIN) { E.fused(acc, cur, wr, wc, fr, fq, lds, wid, lane); S.done(cur); }
#undef PG8_SA
#undef PG8_SB
#undef PG8_STAGE
#undef PG8_LDA
#undef PG8_LDB
#undef PG8_MMA
#undef PG8_WAIT_V
#undef PG8_WAIT_L
#undef PG8_BAR
#undef PG8_SCHED
}
}
constexpr int DM = 2048, NBP = 4, SEQ = 4096, NBS = 8, DSQ = 64, PAST = 4096;
constexpr int MP = NBP * SEQ, MS = NBS * DSQ, MT = MP + MS;
constexpr int PAB = 7296, PABP = 7424, PCN = 8192, DSH = 3200, KVROWS = PAST + DSQ;
constexpr int COL_VA = 1024, COL_GA = 2048, COL_HB = 3072, COL_GB = 6272;
constexpr float ALPHA = 1.41421356237f;
constexpr float LAM_INIT = 0.35550906759f;
constexpr float QSCALE = 0.08838834764831845f * 1.4426950408889634f;
constexpr size_t O0 = 0, O1 = 33554432, O2 = 34603008, O3 = 34615808, O4 = 34877952, O5 = 34903552, O6 = 35427840, O7 = 35952128, O8 = 69506560, O9 = 103060992, O10 = 104109568, OUT_TOTAL = 105158144;
constexpr size_t MiB = 1u << 20;
constexpr size_t WS_CTL = 0, CTL_ZERO_BYTES = 1 * MiB;
constexpr size_t OFF_STATS1 = 131072, OFF_COLSUM = 393216, OFF_BW = 458752;
constexpr size_t WS_W2T = 4 * MiB, WS_A2T = WS_W2T + 131072, WS_WSB = WS_W2T + 262144;
constexpr size_t WS_WTIN = 8 * MiB, WS_WTOUT = 37 * MiB, WS_WTCIN = 45 * MiB, WS_WTCOUT = 77 * MiB;
constexpr size_t WS_XB = 85 * MiB, WS_Z1 = 151 * MiB;
constexpr size_t WS_PROJ = 477 * MiB, WS_SCANIN = 717 * MiB, WS_Y = 915 * MiB;
constexpr size_t WS_QB = 477 * MiB, WS_GB = 543 * MiB, WS_KBP = 609 * MiB, WS_VBP = 673 * MiB, WS_PARTP = 737 * MiB, WS_MLP = 993 * MiB;
constexpr size_t WS_PARTS = 217 * MiB, WS_MLS = 281 * MiB, WS_END = 1024 * MiB;
constexpr int CW_TMO = 0, CW_CODE = 1, CW_BAR = 4096;
constexpr size_t SCAN_SBASE = (size_t)NBP * 16 * SEQ * 384;
constexpr int RING_BYTES = 147456, LDSCTL_OFF = RING_BYTES, MISC_OFF = LDSCTL_OFF + 320, LDS_BYTES = 148480;

#define LAS __attribute__((address_space(3)))
typedef unsigned short bf16;
typedef short bf16x8 __attribute__((ext_vector_type(8)));
typedef short s16x4 __attribute__((ext_vector_type(4)));
typedef float f32x4 __attribute__((ext_vector_type(4)));
typedef float f32x16 __attribute__((ext_vector_type(16)));
typedef unsigned u32x4 __attribute__((ext_vector_type(4)));
typedef unsigned u32x2 __attribute__((ext_vector_type(2)));
using pg8::cvt_pk_bf16;

__device__ __forceinline__ unsigned f2bf(float f) { unsigned u = __builtin_bit_cast(unsigned, f); return (u + 0x7fffu + ((u >> 16) & 1u)) >> 16; }
__device__ __forceinline__ unsigned pk2(float lo, float hi) { return f2bf(lo) | (f2bf(hi) << 16); }
__device__ __forceinline__ float bflo(unsigned w) { return __builtin_bit_cast(float, w << 16); }
__device__ __forceinline__ float bfhi(unsigned w) { return __builtin_bit_cast(float, w & 0xffff0000u); }
__device__ __forceinline__ float bf1(bf16 h) { return __builtin_bit_cast(float, (unsigned)h << 16); }
__device__ __forceinline__ float sigmoidf_(float x) { return __builtin_amdgcn_rcpf(1.f + __expf(-x)); }
__device__ __forceinline__ float siluf_(float x) { return x * sigmoidf_(x); }
__device__ __forceinline__ float wave_sum(float v) {
#pragma unroll
    for (int o = 1; o < 64; o <<= 1) v += __shfl_xor(v, o);
    return v;
}
__device__ __forceinline__ void unpack8(u32x4 w, float (&f)[8]) { f[0] = bflo(w.x); f[1] = bfhi(w.x); f[2] = bflo(w.y); f[3] = bfhi(w.y); f[4] = bflo(w.z); f[5] = bfhi(w.z); f[6] = bflo(w.w); f[7] = bfhi(w.w); }

namespace pg8 {
struct EpiPlainBf16 {
    static constexpr bool PERM = true, AFTER_DRAIN = false;
    bf16_t* O; int ldc;
    __device__ __forceinline__ void operator()(const f32x4 (&acc)[2][2][4][2], const Unit& u, int wr, int wc, int fr, int fq) const {
        const int row0 = u.pm * BM + wr * 64 + fr, col0 = u.pn * BM + wc * 32 + 8 * fq;
#pragma unroll
        for (int ai = 0; ai < 2; ++ai)
#pragma unroll
            for (int m = 0; m < 4; ++m) { bf16_t* rowp = O + (size_t)(row0 + ai * HALF + m * 16) * ldc + col0;
#pragma unroll
                for (int bj = 0; bj < 2; ++bj) { const f32x4 v0 = acc[ai][bj][m][0], v1 = acc[ai][bj][m][1];
                    u32x4 w; w.x = cvt_pk_bf16(v0[0], v0[1]); w.y = cvt_pk_bf16(v0[2], v0[3]); w.z = cvt_pk_bf16(v1[0], v1[1]); w.w = cvt_pk_bf16(v1[2], v1[3]);
                    *(u32x4*)(rowp + bj * HALF) = w; } }
    }
};
struct EpiZ1 {
    static constexpr bool PERM = true, AFTER_DRAIN = false;
    const float* xp; const float* xs; bf16_t* Z; float* stats;
    __device__ __forceinline__ void operator()(const f32x4 (&acc)[2][2][4][2], const Unit& u, int wr, int wc, int fr, int fq) const {
        const int row0 = u.pm * BM + wr * 64 + fr, col0 = u.pn * BM + wc * 32 + 8 * fq;
#pragma unroll
        for (int ai = 0; ai < 2; ++ai)
#pragma unroll
            for (int m = 0; m < 4; ++m) { const int row = row0 + ai * HALF + m * 16;
                const float* xr = (row < ::MP ? xp + (size_t)row * ::DM : xs + (size_t)(row - ::MP) * ::DM) + col0;
                bf16_t* zr = Z + (size_t)row * ::DM + col0; float s = 0.f, ss = 0.f;
#pragma unroll
                for (int bj = 0; bj < 2; ++bj) { const f32x4 x0 = *(const f32x4*)(xr + bj * HALF), x1 = *(const f32x4*)(xr + bj * HALF + 4);
                    const f32x4 v0 = acc[ai][bj][m][0] + x0 * ::ALPHA, v1 = acc[ai][bj][m][1] + x1 * ::ALPHA;
                    u32x4 w; w.x = cvt_pk_bf16(v0[0], v0[1]); w.y = cvt_pk_bf16(v0[2], v0[3]); w.z = cvt_pk_bf16(v1[0], v1[1]); w.w = cvt_pk_bf16(v1[2], v1[3]);
                    *(u32x4*)(zr + bj * HALF) = w;
                    float f[8]; ::unpack8(w, f);
#pragma unroll
                    for (int i = 0; i < 8; ++i) { s += f[i]; ss += f[i] * f[i]; } }
                s += __shfl_xor(s, 16); s += __shfl_xor(s, 32); ss += __shfl_xor(ss, 16); ss += __shfl_xor(ss, 32);
                if (fq == 0) { unsafeAtomicAdd(stats + 2 * row, s); unsafeAtomicAdd(stats + 2 * row + 1, ss); } }
    }
};
struct EpiQKVG {
    static constexpr bool PERM = true, AFTER_DRAIN = false;
    const float* stats; const float* colsum; const float* bw; bf16_t* QB; bf16_t* GB; bf16_t* KBP; bf16_t* VBP; float* out;
    __device__ __forceinline__ void operator()(const f32x4 (&acc)[2][2][4][2], const Unit& u, int wr, int wc, int fr, int fq) const {
        const int kind = u.pn >> 3;
        const int row0 = u.pm * BM + wr * 64 + fr, col0 = (u.pn & 7) * BM + wc * 32 + 8 * fq, gcol0 = u.pn * BM + wc * 32 + 8 * fq;
        f32x4 cs[2][2], bb[2][2];
#pragma unroll
        for (int bj = 0; bj < 2; ++bj)
#pragma unroll
            for (int n = 0; n < 2; ++n) { cs[bj][n] = *(const f32x4*)(colsum + gcol0 + bj * HALF + 4 * n); bb[bj][n] = *(const f32x4*)(bw + gcol0 + bj * HALF + 4 * n); }
#pragma unroll
        for (int ai = 0; ai < 2; ++ai)
#pragma unroll
            for (int m = 0; m < 4; ++m) { const int row = row0 + ai * HALF + m * 16;
                const float mean = stats[2 * row] * (1.f / 2048.f); const float var = stats[2 * row + 1] * (1.f / 2048.f) - mean * mean; const float rstd = 1.0f / sqrtf(var + 1e-5f);
                const bool prompt = row < ::MP; const int rs = row - ::MP;
#pragma unroll
                for (int bj = 0; bj < 2; ++bj) { const int col = col0 + bj * HALF;
                    f32x4 v0 = (acc[ai][bj][m][0] - cs[bj][0] * mean) * rstd + bb[bj][0], v1 = (acc[ai][bj][m][1] - cs[bj][1] * mean) * rstd + bb[bj][1];
                    if (kind == 0) { v0 = v0 * ::QSCALE; v1 = v1 * ::QSCALE; }
                    if (kind == 3) {
#pragma unroll
                        for (int i = 0; i < 4; ++i) { v0[i] = ::siluf_(v0[i]); v1[i] = ::siluf_(v1[i]); } }
                    u32x4 w; w.x = cvt_pk_bf16(v0[0], v0[1]); w.y = cvt_pk_bf16(v0[2], v0[3]); w.z = cvt_pk_bf16(v1[0], v1[1]); w.w = cvt_pk_bf16(v1[2], v1[3]);
                    if (kind == 0) *(u32x4*)(QB + (size_t)row * ::DM + col) = w;
                    else if (kind == 3) *(u32x4*)(GB + (size_t)row * ::DM + col) = w;
                    else {
                        float* fo = out + (kind == 1 ? (prompt ? ::O7 : ::O9) : (prompt ? ::O8 : ::O10)) + (size_t)(prompt ? row : rs) * ::DM + col;
#if STAGE == 3
                        *(f32x4*)fo = v0 * 3.f; *(f32x4*)(fo + 4) = v1 * 3.f;
#else
                        *(f32x4*)fo = v0; *(f32x4*)(fo + 4) = v1;
#endif
                        if (prompt) *(u32x4*)((kind == 1 ? KBP : VBP) + (size_t)row * ::DM + col) = w; } } }
    }
};
struct EpiZ2 {
    static constexpr bool PERM = false, AFTER_DRAIN = false;
    const float* stats; const bf16_t* Z; const float* g1; const float* b1; float* out;
    __device__ __forceinline__ void operator()(const f32x4 (&acc)[2][2][4][2], const Unit& u, int wr, int wc, int fr, int fq) const {
        const int row0 = u.pm * BM + wr * 64 + fr, col0 = u.pn * BM + wc * 32 + 4 * fq;
        f32x4 gg[2][2], bb[2][2];
#pragma unroll
        for (int bj = 0; bj < 2; ++bj)
#pragma unroll
            for (int n = 0; n < 2; ++n) { gg[bj][n] = *(const f32x4*)(g1 + col0 + bj * HALF + 16 * n); bb[bj][n] = *(const f32x4*)(b1 + col0 + bj * HALF + 16 * n); }
#pragma unroll
        for (int ai = 0; ai < 2; ++ai)
#pragma unroll
            for (int m = 0; m < 4; ++m) { const int row = row0 + ai * HALF + m * 16;
                const float mean = stats[2 * row] * (1.f / 2048.f); const float var = stats[2 * row + 1] * (1.f / 2048.f) - mean * mean; const float rstd = 1.0f / sqrtf(var + 1e-5f);
                float* yo = out + (row < ::MP ? ::O0 + (size_t)row * ::DM : ::O1 + (size_t)(row - ::MP) * ::DM) + col0;
                const bf16_t* zr = Z + (size_t)row * ::DM + col0;
#pragma unroll
                for (int bj = 0; bj < 2; ++bj)
#pragma unroll
                    for (int n = 0; n < 2; ++n) { const u32x2 zw = *(const u32x2*)(zr + bj * HALF + 16 * n);
                        f32x4 z; z[0] = ::bflo(zw.x); z[1] = ::bfhi(zw.x); z[2] = ::bflo(zw.y); z[3] = ::bfhi(zw.y);
                        const f32x4 x1 = (z - mean) * rstd * gg[bj][n] + bb[bj][n];
                        *(f32x4*)(yo + bj * HALF + 16 * n) = acc[ai][bj][m][n] + x1 * ::ALPHA; } }
    }
};
}
#define XB_TMO      128
#define XB_XCNT(j)  (256  + 64 * (j))
#define XB_XSUB(j)  (1280 + 64 * (j))
#define XB_XGEN(j)  (2304 + 64 * (j))
#define XB_TOP      3328
#define XB_TOPGEN   3392
#define XCD_BAR_WORDS 3456
#define XB_SPIN_CAP (1u << 22)

__device__ __forceinline__ unsigned xb_ld(unsigned* p)              { return __hip_atomic_load(p, __ATOMIC_RELAXED, __HIP_MEMORY_SCOPE_AGENT); }
__device__ __forceinline__ unsigned xb_add(unsigned* p, unsigned v) { return __hip_atomic_fetch_add(p, v, __ATOMIC_RELAXED, __HIP_MEMORY_SCOPE_AGENT); }
__device__ __forceinline__ unsigned xb_xcc_id() { return (unsigned)__builtin_amdgcn_s_getreg((3 << 11) | 20) & 0xFu; }
#define XB_SPIN(cond, bar) do { unsigned _sp = 0; while (cond) { __builtin_amdgcn_s_sleep(1); \
    if ((++_sp & 255u) == 0u) { if (xb_ld(&(bar)[XB_TMO])) break; if (_sp > XB_SPIN_CAP) { atomicAdd(&(bar)[XB_TMO], 1u); break; } } } } while (0)

struct XcdBarrier {
    unsigned* bar; unsigned x;
    volatile LAS unsigned* st;
};

__device__ __forceinline__ XcdBarrier xcd_barrier_post(unsigned* bar, volatile LAS unsigned* st) {
    XcdBarrier b; b.bar = bar; b.x = xb_xcc_id(); b.st = st;
    if (threadIdx.x == 0) (void)xb_add(&bar[XB_XCNT(b.x)], 1u);
    return b;
}
__device__ __forceinline__ void xcd_barrier_complete(unsigned* bar, unsigned x, unsigned& nloc, unsigned& nx) {
    const unsigned G = gridDim.x * gridDim.y * gridDim.z;
    unsigned sum, cnt, mine, sp = 0u;
    for (;;) {
        sum = 0u; cnt = 0u; mine = 0u;
#pragma unroll
        for (unsigned j = 0; j < 16; ++j) { const unsigned c = xb_ld(&bar[XB_XCNT(j)]); sum += c; cnt += (c > 0u) ? 1u : 0u; mine = (j == x) ? c : mine; }
        if (sum == G) break;
        __builtin_amdgcn_s_sleep(1);
        if ((++sp & 255u) == 0u) { if (xb_ld(&bar[XB_TMO])) break; if (sp > XB_SPIN_CAP) { atomicAdd(&bar[XB_TMO], 1u); break; } }
    }
    nloc = mine > 0u ? mine : 1u; nx = cnt > 0u ? cnt : 1u;
}

__device__ __forceinline__ void xcd_barrier(const XcdBarrier& b) {
    asm volatile("s_waitcnt vmcnt(0)" ::: "memory");
    __syncthreads();
    if (threadIdx.x == 0) {
        unsigned* bar = b.bar;
        __builtin_amdgcn_s_waitcnt(0);
        unsigned nloc = b.st[0], nx = b.st[1];
        if (nloc == 0u) { xcd_barrier_complete(bar, b.x, nloc, nx); b.st[0] = nloc; b.st[1] = nx; }
        const unsigned old = xb_add(&bar[XB_XSUB(b.x)], 1u);
        const unsigned gen = old / nloc;
        if (old + 1u == (gen + 1u) * nloc) {
            __builtin_amdgcn_fence(__ATOMIC_RELEASE, "agent");
            asm volatile("s_waitcnt vmcnt(0)" ::: "memory");
            const unsigned og = xb_add(&bar[XB_TOP], 1u);
            const unsigned tg = og / nx;
            if (og + 1u == (tg + 1u) * nx) xb_add(&bar[XB_TOPGEN], 1u);
            else XB_SPIN(xb_ld(&bar[XB_TOPGEN]) == tg, bar);
            __builtin_amdgcn_fence(__ATOMIC_ACQUIRE, "agent");
            xb_add(&bar[XB_XGEN(b.x)], 1u);
            asm volatile("s_waitcnt vmcnt(0)" ::: "memory");
        } else {
            XB_SPIN(xb_ld(&bar[XB_XGEN(b.x)]) == gen, bar);
            __builtin_amdgcn_fence(__ATOMIC_ACQUIRE, "agent");
            asm volatile("s_waitcnt vmcnt(0)" ::: "memory");
        }
    }
    __syncthreads();
}
struct Args { const float* in[33]; float* out; unsigned char* ws; int ph_lo, ph_hi; };
enum { I_XP = 0, I_XS, I_SHIFT, I_WKV, I_CK, I_CV, I_WIN, I_ALNG, I_ALNB, I_AWS, I_ABS, I_MU, I_W0, I_W2, I_A0, I_A2, I_KK, I_KA, I_RK, I_LNXG, I_LNXB, I_WOUT, I_LNG, I_LNB,
       I_CWIN, I_LQ1, I_LK1, I_LQ2, I_LK2, I_SUBG, I_CWOUT, I_CLNG, I_CLNB };

__device__ __forceinline__ void p0_transpose_item(const float* W, int K, int N, bf16* WT, LAS float* scr, int item, int lane, const float* kscale, const float* kbias, float* colsum, float* bwsum) {
    const int nblk = N / 32, kb = item / nblk, nb = item % nblk, k0 = 64 * kb, n0 = 32 * nb;
    float csum = 0.f, bsum = 0.f;
#pragma unroll 8
    for (int i = 0; i < 32; ++i) { const int kk = 2 * i + (lane >> 5); float v = W[(size_t)(k0 + kk) * N + n0 + (lane & 31)];
        if (kscale) { bsum += v * kbias[k0 + kk]; v = __builtin_bit_cast(float, f2bf(v * kscale[k0 + kk]) << 16); csum += v; }
        scr[kk * 33 + (lane & 31)] = v; }
    if (kscale) { csum += __shfl_xor(csum, 32); bsum += __shfl_xor(bsum, 32); if (lane < 32) { unsafeAtomicAdd(colsum + n0 + lane, csum); unsafeAtomicAdd(bwsum + n0 + lane, bsum); } }
    asm volatile("s_waitcnt lgkmcnt(0)" ::: "memory");
    const int c = lane & 7;
#pragma unroll
    for (int j = 0; j < 4; ++j) { const int n = (lane >> 3) + 8 * j; const LAS float* s = scr + (8 * c) * 33 + n;
        u32x4 o; o.x = pk2(s[0 * 33], s[1 * 33]); o.y = pk2(s[2 * 33], s[3 * 33]); o.z = pk2(s[4 * 33], s[5 * 33]); o.w = pk2(s[6 * 33], s[7 * 33]);
        *(u32x4*)(WT + (size_t)(n0 + n) * K + k0 + 8 * c) = o; }
    asm volatile("s_waitcnt lgkmcnt(0)" ::: "memory");
}
__device__ __forceinline__ void row_f32_to_bf16(const float* src, bf16* dst, int lane) {
#pragma unroll
    for (int j = 0; j < 8; ++j) { const f32x4 v = ((const f32x4*)src)[lane + 64 * j]; u32x2 o; o.x = pk2(v[0], v[1]); o.y = pk2(v[2], v[3]); ((u32x2*)dst)[lane + 64 * j] = o; }
}
__device__ __forceinline__ void p0_prologue(const Args& A, LAS unsigned char* lds, int vcu, int G, int wave, int lane, int tid, float* colsum, float* bwsum) {
    unsigned char* ws = A.ws;
    LAS float* scr = (LAS float*)(lds + wave * 16384);
    const int gw = vcu * 8 + wave, NGW = G * 8;
    constexpr int I1 = 32 * (PAB / 32), I2 = 32 * 64, I3 = 32 * (PCN / 32), I4 = 32 * 64;
    for (int it = gw; it < I1 + I2 + I3 + I4; it += NGW) {
        int r = it;
        if (r < I1) { p0_transpose_item(A.in[I_WIN], DM, PAB, (bf16*)(ws + WS_WTIN), scr, r, lane, nullptr, nullptr, nullptr, nullptr); continue; } r -= I1;
        if (r < I2) { p0_transpose_item(A.in[I_WOUT], DM, DM, (bf16*)(ws + WS_WTOUT), scr, r, lane, nullptr, nullptr, nullptr, nullptr); continue; } r -= I2;
        if (r < I3) { p0_transpose_item(A.in[I_CWIN], DM, PCN, (bf16*)(ws + WS_WTCIN), scr, r, lane, A.in[I_LNG], A.in[I_LNB], colsum, bwsum); continue; } r -= I3;
        p0_transpose_item(A.in[I_CWOUT], DM, DM, (bf16*)(ws + WS_WTCOUT), scr, r, lane, nullptr, nullptr, nullptr, nullptr);
    }
    for (int m = gw; m < MT; m += NGW) row_f32_to_bf16(m < MP ? A.in[I_XP] + (size_t)m * DM : A.in[I_XS] + (size_t)(m - MP) * DM, (bf16*)(ws + WS_XB) + (size_t)m * DM, lane);
    const int gt = vcu * 512 + tid, NT = G * 512;
    for (int idx = gt; idx < 65536; idx += NT) { const int n = idx >> 6, k = idx & 63;
        ((bf16*)(ws + WS_W2T))[idx] = (bf16)f2bf(A.in[I_W2][k * 1024 + n]); ((bf16*)(ws + WS_A2T))[idx] = (bf16)f2bf(A.in[I_A2][k * 1024 + n]);
        const int t = (idx >> 7) & 127, s = idx & 127; ((bf16*)(ws + WS_WSB))[idx] = (s <= t) ? (bf16)f2bf(A.in[I_AWS][idx]) : (bf16)0; }
    for (int idx = gt; idx < 32768; idx += NT) ((u32x4*)((bf16*)(ws + WS_WTIN) + (size_t)PAB * DM))[idx] = (u32x4){0u, 0u, 0u, 0u};
}
constexpr int VN_ROW = 576, MO_ROW = 1040;
__device__ __forceinline__ s16x4 vtr(const LAS unsigned char* p) { typedef short v4i16_t __attribute__((ext_vector_type(4))); return __builtin_bit_cast(s16x4, __builtin_amdgcn_ds_read_tr16_b64_v4i16((LAS v4i16_t*)p)); }
__device__ __forceinline__ void mixer_a_unit(const Args& A, LAS unsigned char* lds, int ci, int g, int wave, int lane, int tid) {
    const bf16* PROJ = (const bf16*)(A.ws + WS_PROJ);
    bf16* OA = (bf16*)(A.ws + WS_XB);
    const bool prompt = ci < 128; const int m0 = prompt ? ci * 128 : MP + (ci - 128) * 64, L = prompt ? 128 : 64;
    LAS float* st = (LAS float*)lds; LAS unsigned char* vn = lds + 1024;
    for (int i0 = 0; i0 < 16; i0 += 4) { const int tokb = wave * 16 + i0; if (tokb < L) {
        u32x4 ra[4], rb[4];
#pragma unroll
        for (int i = 0; i < 4; ++i) { const bf16* row = PROJ + (size_t)(m0 + tokb + i) * PABP + COL_VA + lane * 16; ra[i] = *(const u32x4*)row; rb[i] = *(const u32x4*)(row + 8); }
#pragma unroll
        for (int i = 0; i < 4; ++i) { float a[8], b[8]; unpack8(ra[i], a); unpack8(rb[i], b); float s = 0.f;
#pragma unroll
            for (int j = 0; j < 8; ++j) s += a[j] + b[j];
            const float mean = wave_sum(s) * (1.f / 1024.f); float q = 0.f;
#pragma unroll
            for (int j = 0; j < 8; ++j) { const float d0 = a[j] - mean, d1 = b[j] - mean; q += d0 * d0 + d1 * d1; }
            const float rstd = 1.0f / sqrtf(wave_sum(q) * (1.f / 1024.f) + 1e-5f);
            if (lane == 0) { st[2 * (tokb + i)] = mean; st[2 * (tokb + i) + 1] = rstd; } } } }
    __syncthreads();
    { const int s = tid & 127, og = tid >> 7;
      if (s < L) { const float mean = st[2 * s], rstd = st[2 * s + 1];
        u32x4 xr[8];
#pragma unroll
        for (int it = 0; it < 8; ++it) xr[it] = *(const u32x4*)(PROJ + (size_t)(m0 + s) * PABP + COL_VA + g * 256 + (it * 4 + og) * 8);
#pragma unroll
        for (int it = 0; it < 8; ++it) { const int oct = it * 4 + og, c0 = g * 256 + oct * 8;
            float x[8]; unpack8(xr[it], x);
            const f32x4 g0 = *(const f32x4*)(A.in[I_ALNG] + c0), g1 = *(const f32x4*)(A.in[I_ALNG] + c0 + 4), b0 = *(const f32x4*)(A.in[I_ALNB] + c0), b1 = *(const f32x4*)(A.in[I_ALNB] + c0 + 4);
            float v[8];
#pragma unroll
            for (int j = 0; j < 4; ++j) { v[j] = (x[j] - mean) * rstd * g0[j] + b0[j]; v[4 + j] = (x[4 + j] - mean) * rstd * g1[j] + b1[j]; }
            if (!prompt) { float* o = A.out + O6 + (size_t)((ci - 128) * 64 + s) * 1024 + c0;
                *(f32x4*)o = (f32x4){v[0], v[1], v[2], v[3]}; *(f32x4*)(o + 4) = (f32x4){v[4], v[5], v[6], v[7]}; }
            u32x4 w; w.x = pk2(v[0], v[1]); w.y = pk2(v[2], v[3]); w.z = pk2(v[4], v[5]); w.w = pk2(v[6], v[7]);
            *(LAS u32x4*)(vn + s * VN_ROW + oct * 16) = w; } } }
    __syncthreads();
    const int ti = wave & 3, ch = wave >> 2, r32 = lane & 31, hi = lane >> 5;
    const bool active = ti * 32 < L;
    f32x16 acc[4];
#pragma unroll
    for (int c = 0; c < 4; ++c) acc[c] = (f32x16){0.f};
    if (active) {
        const bf16* Wg = (const bf16*)(A.ws + WS_WSB) + g * 16384 + (32 * ti + r32) * 128 + 4 * hi;
        const LAS unsigned char* vb = vn + (4 * hi + ((lane & 15) >> 2)) * VN_ROW + (ch * 128 + ((lane >> 4) & 1) * 16 + (lane & 3) * 4) * 2;
        for (int ks = 0; ks <= 2 * ti + 1; ++ks) {
            const u32x2 w0 = *(const u32x2*)(Wg + 16 * ks), w1 = *(const u32x2*)(Wg + 16 * ks + 8);
            const bf16x8 af = __builtin_bit_cast(bf16x8, (u32x4){w0.x, w0.y, w1.x, w1.y});
#pragma unroll
            for (int c = 0; c < 4; ++c) { const s16x4 lo = vtr(vb + (16 * ks) * VN_ROW + c * 64), hh = vtr(vb + (16 * ks + 8) * VN_ROW + c * 64);
                const bf16x8 bfr = (bf16x8){lo[0], lo[1], lo[2], lo[3], hh[0], hh[1], hh[2], hh[3]};
                acc[c] = __builtin_amdgcn_mfma_f32_32x32x16_bf16(af, bfr, acc[c], 0, 0, 0); } }
    }
    __syncthreads();
    if (active) {
        LAS unsigned char* ob = vn;
#pragma unroll
        for (int reg = 0; reg < 16; ++reg) { const int t = 32 * ti + (reg & 3) + 8 * (reg >> 2) + 4 * hi;
#pragma unroll
            for (int c = 0; c < 4; ++c) *(LAS float*)(ob + t * MO_ROW + (32 * (ch * 4 + c) + r32) * 4) = acc[c][reg]; }
    }
    __syncthreads();
    for (int it = 0; it < 8; ++it) { const int item = tid + 512 * it, t = item >> 5, oc = item & 31;
        if (t < L) { const size_t m = (size_t)(m0 + t); const int col = g * 256 + oc * 8;
            const f32x4 o0 = *(const LAS f32x4*)(vn + t * MO_ROW + oc * 32), o1 = *(const LAS f32x4*)(vn + t * MO_ROW + oc * 32 + 16);
            float u[8], ga[8]; unpack8(*(const u32x4*)(PROJ + m * PABP + col), u); unpack8(*(const u32x4*)(PROJ + m * PABP + COL_GA + col), ga);
            const float bias = A.in[I_ABS][g * 128 + t]; float r[8];
#pragma unroll
            for (int j = 0; j < 4; ++j) { r[j] = u[j] * (o0[j] + bias) * siluf_(ga[j]); r[4 + j] = u[4 + j] * (o1[j] + bias) * siluf_(ga[4 + j]); }
            u32x4 w; w.x = pk2(r[0], r[1]); w.y = pk2(r[2], r[3]); w.z = pk2(r[4], r[5]); w.w = pk2(r[6], r[7]);
            *(u32x4*)(OA + m * DM + col) = w; } }
    __syncthreads();
}
constexpr int SCAN_TS = 32, SCAN_BUF = 45184, SCAN_SCR = 2 * SCAN_BUF, SCAN_SCRW = 6400;
__device__ __forceinline__ float dpp_add16(float x) {
    x += __builtin_bit_cast(float, __builtin_amdgcn_update_dpp(0, __builtin_bit_cast(int, x), 0xB1, 0xF, 0xF, true));
    x += __builtin_bit_cast(float, __builtin_amdgcn_update_dpp(0, __builtin_bit_cast(int, x), 0x4E, 0xF, 0xF, true));
    x += __builtin_bit_cast(float, __builtin_amdgcn_update_dpp(0, __builtin_bit_cast(int, x), 0x124, 0xF, 0xF, true));
    x += __builtin_bit_cast(float, __builtin_amdgcn_update_dpp(0, __builtin_bit_cast(int, x), 0x128, 0xF, 0xF, true));
    return x;
}
struct PrepRegs { u32x4 cur[5], prv[5]; };
struct ScanCtx { const bf16* rowbase; const float* shift; float* bon; int T; int hd; int qr; };
__device__ __forceinline__ void prep_load(PrepRegs& R, const ScanCtx& C, int t, int oc) {
    const bf16* cur = C.rowbase + (size_t)t * PABP;
    const int o0 = C.hd * 64 + oc * 8;
    R.cur[0] = *(const u32x4*)(cur + o0); R.cur[1] = *(const u32x4*)(cur + 1024 + o0); R.cur[2] = *(const u32x4*)(cur + 2048 + o0);
    R.cur[3] = *(const u32x4*)(cur + 3072 + oc * 8); R.cur[4] = *(const u32x4*)(cur + 3136 + oc * 8);
    if (t > 0) { const bf16* p = cur - PABP;
        R.prv[0] = *(const u32x4*)(p + o0); R.prv[1] = *(const u32x4*)(p + 1024 + o0); R.prv[2] = *(const u32x4*)(p + 2048 + o0);
        R.prv[3] = *(const u32x4*)(p + 3072 + oc * 8); R.prv[4] = *(const u32x4*)(p + 3136 + oc * 8); }
}
__device__ __forceinline__ void lerp8(const u32x4 cur, const u32x4 prv, bool first, const float* shift, const f32x4 m0, const f32x4 m1, float (&o)[8]) {
    float c[8], p[8]; unpack8(cur, c);
    if (!first) unpack8(prv, p);
    else if (shift) { const f32x4 a = *(const f32x4*)shift, b = *(const f32x4*)(shift + 4);
#pragma unroll
        for (int j = 0; j < 4; ++j) { p[j] = a[j]; p[4 + j] = b[j]; } }
    else {
#pragma unroll
        for (int j = 0; j < 8; ++j) p[j] = 0.f; }
#pragma unroll
    for (int j = 0; j < 4; ++j) { o[j] = c[j] + (p[j] - c[j]) * m0[j]; o[4 + j] = c[4 + j] + (p[4 + j] - c[4 + j]) * m1[j]; }
}
__device__ __forceinline__ void prep_stage(const PrepRegs& R, const Args& A, const ScanCtx& C, LAS float* buf, LAS unsigned char* scr, const LAS unsigned char* cst, int t, int lw, int lane) {
    const int tl8 = lane >> 3, oc = lane & 7, tl = lw * 8 + tl8, hd = C.hd, c0 = hd * 64 + oc * 8;
    const LAS float* cf = (const LAS float*)(cst + 18432); const bool first = (t == 0);
#define CF8(w) *(const LAS f32x4*)(cf + (w) * 64 + oc * 8), *(const LAS f32x4*)(cf + (w) * 64 + oc * 8 + 4)
    float hr[8], hk[8], hv[8], hw[8], ha[8];
    lerp8(R.cur[0], R.prv[0], first, C.shift ? C.shift + c0 : nullptr, CF8(0), hr);
    lerp8(R.cur[1], R.prv[1], first, C.shift ? C.shift + 1024 + c0 : nullptr, CF8(1), hk);
    lerp8(R.cur[2], R.prv[2], first, C.shift ? C.shift + 2048 + c0 : nullptr, CF8(2), hv);
    lerp8(R.cur[3], R.prv[3], first, C.shift ? C.shift + 3072 + oc * 8 : nullptr, CF8(3), hw);
    lerp8(R.cur[4], R.prv[4], first, C.shift ? C.shift + 3136 + oc * 8 : nullptr, CF8(4), ha);
    LAS unsigned char* wl = scr, * al = scr + 1152; LAS float* ea = (LAS float*)(scr + 2304);
    { u32x4 w;
#pragma unroll
      for (int j = 0; j < 8; ++j) hw[j] = 1.f - 2.f * __builtin_amdgcn_rcpf(__expf(2.f * hw[j]) + 1.f);
      w.x = cvt_pk_bf16(hw[0], hw[1]); w.y = cvt_pk_bf16(hw[2], hw[3]); w.z = cvt_pk_bf16(hw[4], hw[5]); w.w = cvt_pk_bf16(hw[6], hw[7]); *(LAS u32x4*)(wl + tl8 * 144 + oc * 16) = w;
      w.x = cvt_pk_bf16(ha[0], ha[1]); w.y = cvt_pk_bf16(ha[2], ha[3]); w.z = cvt_pk_bf16(ha[4], ha[5]); w.w = cvt_pk_bf16(ha[6], ha[7]); *(LAS u32x4*)(al + tl8 * 144 + oc * 16) = w; }
    { const int row = lane & 15, kg = lane >> 4; typedef float f32x4_t __attribute__((ext_vector_type(4)));
      const LAS unsigned char* w2t = cst + row * 144 + 16 * kg; const LAS unsigned char* a2t = cst + 9216 + row * 144 + 16 * kg;
      const bf16x8 aw0 = *(const LAS bf16x8*)(wl + (row & 7) * 144 + (8 * kg) * 2), aw1 = *(const LAS bf16x8*)(wl + (row & 7) * 144 + (32 + 8 * kg) * 2);
      const bf16x8 aa0 = *(const LAS bf16x8*)(al + (row & 7) * 144 + (8 * kg) * 2), aa1 = *(const LAS bf16x8*)(al + (row & 7) * 144 + (32 + 8 * kg) * 2);
#pragma unroll
      for (int nb = 0; nb < 4; ++nb) { f32x4_t dw = (f32x4_t){0.f, 0.f, 0.f, 0.f}, da = (f32x4_t){0.f, 0.f, 0.f, 0.f};
          dw = __builtin_amdgcn_mfma_f32_16x16x32_bf16(aw0, *(const LAS bf16x8*)(w2t + nb * 2304), dw, 0, 0, 0); dw = __builtin_amdgcn_mfma_f32_16x16x32_bf16(aw1, *(const LAS bf16x8*)(w2t + nb * 2304 + 64), dw, 0, 0, 0);
          da = __builtin_amdgcn_mfma_f32_16x16x32_bf16(aa0, *(const LAS bf16x8*)(a2t + nb * 2304), da, 0, 0, 0); da = __builtin_amdgcn_mfma_f32_16x16x32_bf16(aa1, *(const LAS bf16x8*)(a2t + nb * 2304 + 64), da, 0, 0, 0);
          if (lane < 32) { const int n = nb * 16 + row;
#pragma unroll
              for (int r = 0; r < 4; ++r) { const int tok = 4 * kg + r; ea[(tok * 2 + 0) * 64 + n] = dw[r]; ea[(tok * 2 + 1) * 64 + n] = da[r]; } } } }
    const f32x4 e0 = *(const LAS f32x4*)(ea + (tl8 * 2 + 0) * 64 + oc * 8), e1 = *(const LAS f32x4*)(ea + (tl8 * 2 + 0) * 64 + oc * 8 + 4);
    const f32x4 a0 = *(const LAS f32x4*)(ea + (tl8 * 2 + 1) * 64 + oc * 8), a1 = *(const LAS f32x4*)(ea + (tl8 * 2 + 1) * 64 + oc * 8 + 4);
    float ev[8], av[8];
#pragma unroll
    for (int j = 0; j < 4; ++j) { ev[j] = e0[j]; ev[4 + j] = e1[j]; av[j] = a0[j]; av[4 + j] = a1[j]; }
    { const f32x4 w00 = *(const LAS f32x4*)(cf + 512 + oc * 8), w01 = *(const LAS f32x4*)(cf + 512 + oc * 8 + 4), a00 = *(const LAS f32x4*)(cf + 576 + oc * 8), a01 = *(const LAS f32x4*)(cf + 576 + oc * 8 + 4);
#pragma unroll
      for (int j = 0; j < 8; ++j) { ev[j] = 0.60653065971f * sigmoidf_(ev[j] + (j < 4 ? w00[j & 3] : w01[j & 3])); av[j] = sigmoidf_(av[j] + (j < 4 ? a00[j & 3] : a01[j & 3])); } }
    const f32x4 kks0 = *(const LAS f32x4*)(cf + 320 + oc * 8), kks1 = *(const LAS f32x4*)(cf + 320 + oc * 8 + 4), ka0 = *(const LAS f32x4*)(cf + 384 + oc * 8), ka1 = *(const LAS f32x4*)(cf + 384 + oc * 8 + 4);
    const f32x4 rk0 = *(const LAS f32x4*)(cf + 448 + oc * 8), rk1 = *(const LAS f32x4*)(cf + 448 + oc * 8 + 4);
#undef CF8
    float kkv[8], km[8], dec[8], ssq = 0.f, bon = 0.f;
#pragma unroll
    for (int j = 0; j < 8; ++j) { const float kks = j < 4 ? kks0[j & 3] : kks1[j & 3], ka = j < 4 ? ka0[j & 3] : ka1[j & 3], rk = j < 4 ? rk0[j & 3] : rk1[j & 3];
        kkv[j] = hk[j] * kks; ssq += kkv[j] * kkv[j]; km[j] = hk[j] * (1.f + (av[j] - 1.f) * ka); dec[j] = __expf(-ev[j]); bon += hr[j] * km[j] * rk; }
    ssq += __shfl_xor(ssq, 1); ssq += __shfl_xor(ssq, 2); ssq += __shfl_xor(ssq, 4);
    bon += __shfl_xor(bon, 1); bon += __shfl_xor(bon, 2); bon += __shfl_xor(bon, 4);
    const float inv = 1.0f / fmaxf(sqrtf(ssq), 1e-12f);
    float bb[8];
#pragma unroll
    for (int j = 0; j < 8; ++j) { kkv[j] *= inv; bb[j] = kkv[j] * av[j]; }
    LAS float* d = buf + tl * 320 + oc * 8;
    *(LAS f32x4*)(d) = (f32x4){kkv[0], kkv[1], kkv[2], kkv[3]}; *(LAS f32x4*)(d + 4) = (f32x4){kkv[4], kkv[5], kkv[6], kkv[7]};
    *(LAS f32x4*)(d + 64) = (f32x4){dec[0], dec[1], dec[2], dec[3]}; *(LAS f32x4*)(d + 68) = (f32x4){dec[4], dec[5], dec[6], dec[7]};
    *(LAS f32x4*)(d + 128) = (f32x4){bb[0], bb[1], bb[2], bb[3]}; *(LAS f32x4*)(d + 132) = (f32x4){bb[4], bb[5], bb[6], bb[7]};
    *(LAS f32x4*)(d + 192) = (f32x4){km[0], km[1], km[2], km[3]}; *(LAS f32x4*)(d + 196) = (f32x4){km[4], km[5], km[6], km[7]};
    *(LAS f32x4*)(d + 256) = (f32x4){hr[0], hr[1], hr[2], hr[3]}; *(LAS f32x4*)(d + 260) = (f32x4){hr[4], hr[5], hr[6], hr[7]};
    if ((oc >> 1) == C.qr) { LAS float* dv = buf + 10240 + tl * 16 + (oc & 1) * 8; *(LAS f32x4*)dv = (f32x4){hv[0], hv[1], hv[2], hv[3]}; *(LAS f32x4*)(dv + 4) = (f32x4){hv[4], hv[5], hv[6], hv[7]}; }
    if (oc == 0 && C.qr == 0) C.bon[(size_t)t * 16] = bon;
}
__device__ __forceinline__ void scan_unit(const Args& A, LAS unsigned char* lds, int seq, int hd, int qr, int wave, int lane, int tid) {
    const bool prompt = seq < NBP; const int bs = prompt ? seq : seq - NBP, T = prompt ? SEQ : DSQ, nblk = T / SCAN_TS;
    const int mbase = prompt ? bs * SEQ : MP + bs * DSQ;
    ScanCtx C; C.rowbase = (const bf16*)(A.ws + WS_PROJ) + (size_t)mbase * PABP + COL_HB; C.shift = prompt ? nullptr : A.in[I_SHIFT] + (size_t)bs * DSH; C.T = T; C.hd = hd; C.qr = qr;
    float* Y = (float*)(A.ws + WS_Y) + (size_t)mbase * 1024 + hd * 64 + qr * 16;
    C.bon = (float*)(A.ws + WS_SCANIN) + (size_t)mbase * 16 + hd;
    const bool loader = wave >= 4; const int lw = wave - 4, lt = tid - 256;
    const int rowl = (wave & 3) * 4 + (lane >> 4), kq = lane & 15;
    LAS unsigned char* scr = lds + SCAN_SCR + (wave & 3) * SCAN_SCRW;
    f32x4 S = (f32x4){0.f, 0.f, 0.f, 0.f};
    if (!loader && !prompt) S = *(const f32x4*)(A.in[I_WKV] + ((size_t)(bs * 16 + hd) * 64 + qr * 16 + rowl) * 64 + 4 * kq);
    LAS unsigned char* cst = lds + SCAN_SCR + 4 * SCAN_SCRW;
    { const int n = tid >> 3, chk = tid & 7;
      *(LAS u32x4*)(cst + n * 144 + chk * 16) = *(const u32x4*)((const bf16*)(A.ws + WS_W2T) + (size_t)(hd * 64 + n) * 64 + chk * 8);
      *(LAS u32x4*)(cst + 9216 + n * 144 + chk * 16) = *(const u32x4*)((const bf16*)(A.ws + WS_A2T) + (size_t)(hd * 64 + n) * 64 + chk * 8);
      for (int i = tid; i < 640; i += 512) { const int which = i >> 6, chn = i & 63; float v;
          if (which < 3) v = A.in[I_MU][which * 1024 + hd * 64 + chn]; else if (which == 3) v = A.in[I_MU][3072 + chn]; else if (which == 4) v = A.in[I_MU][3136 + chn];
          else v = A.in[which == 5 ? I_KK : which == 6 ? I_KA : which == 7 ? I_RK : which == 8 ? I_W0 : I_A0][hd * 64 + chn];
          ((LAS float*)(cst + 18432))[i] = v; } }
    PrepRegs R;
    const int ltok = lw * 8 + (lane >> 3), loc = lane & 7;
    if (loader) prep_load(R, C, ltok, loc);
    __syncthreads();
    if (loader) { prep_stage(R, A, C, (LAS float*)lds, scr, cst, ltok, lw, lane); if (nblk > 1) prep_load(R, C, SCAN_TS + ltok, loc); }
    __syncthreads();
    for (int i = 0; i < nblk; ++i) {
        LAS float* buf = (LAS float*)(lds + (i & 1) * SCAN_BUF);
        if (!loader) {
            const LAS f32x4* p0 = (const LAS f32x4*)buf + kq; const LAS float* vp = buf + 10240 + rowl; LAS float* yp = buf + 10752 + rowl;
            f32x4 kkA = p0[0], wA = p0[16], bA = p0[32], kA = p0[48], rA = p0[64]; float vA = vp[0];
#define SCAN_STEP(KK, W, B, K, R, VV, YOUT) do { float sk_ = (S[0] * KK[0] + S[1] * KK[1]) + (S[2] * KK[2] + S[3] * KK[3]); sk_ = dpp_add16(sk_); S = S * W + K * VV - B * sk_; \
                float y_ = (S[0] * R[0] + S[1] * R[1]) + (S[2] * R[2] + S[3] * R[3]); YOUT = dpp_add16(y_); } while (0)
#pragma unroll 2
            for (int t = 0; t < SCAN_TS; t += 2) {
                const LAS f32x4* p1 = p0 + (t + 1) * 80;
                const f32x4 kkB = p1[0], wB = p1[16], bB = p1[32], kB = p1[48], rB = p1[64]; const float vB = vp[(t + 1) * 16];
                float y0, y1;
                SCAN_STEP(kkA, wA, bA, kA, rA, vA, y0);
                const int t2 = (t + 2 < SCAN_TS) ? t + 2 : t; const LAS f32x4* p2 = p0 + t2 * 80;
                kkA = p2[0]; wA = p2[16]; bA = p2[32]; kA = p2[48]; rA = p2[64]; vA = vp[t2 * 16];
                SCAN_STEP(kkB, wB, bB, kB, rB, vB, y1);
                if (kq == 0) { yp[t * 16] = y0; yp[(t + 1) * 16] = y1; }
            }
#undef SCAN_STEP
        } else {
            if (i + 1 < nblk) { prep_stage(R, A, C, (LAS float*)(lds + ((i + 1) & 1) * SCAN_BUF), scr, cst, (i + 1) * SCAN_TS + ltok, lw, lane); if (i + 2 < nblk) prep_load(R, C, (i + 2) * SCAN_TS + ltok, loc); }
            if (i > 0) { const LAS float* yb = (const LAS float*)(lds + ((i - 1) & 1) * SCAN_BUF) + 10752;
#pragma unroll
                for (int j = 0; j < 2; ++j) { const int idx = lt + 256 * j; Y[(size_t)((i - 1) * SCAN_TS + (idx >> 4)) * 1024 + (idx & 15)] = yb[idx]; }
            }
        }
        __syncthreads();
    }
    if (loader) { const LAS float* yb = (const LAS float*)(lds + ((nblk - 1) & 1) * SCAN_BUF) + 10752;
#pragma unroll
        for (int j = 0; j < 2; ++j) { const int idx = lt + 256 * j; Y[(size_t)((nblk - 1) * SCAN_TS + (idx >> 4)) * 1024 + (idx & 15)] = yb[idx]; }
    }
    else { float* o = A.out + (prompt ? O3 : O5) + ((size_t)(bs * 16 + hd) * 64 + qr * 16 + rowl) * 64 + 4 * kq; *(f32x4*)o = S; }
    __syncthreads();
}

__device__ __forceinline__ void p2c_task(const Args& A, int m, int half, int lane) {
    const bf16* PROJ = (const bf16*)(A.ws + WS_PROJ);
    const bool prompt = m < MP; const int bs = prompt ? (m >> 12) : ((m - MP) >> 6), t = prompt ? (m & 4095) : ((m - MP) & 63);
    const int C = half * 512 + lane * 8, hd = C >> 6;
    const float* yp = (const float*)(A.ws + WS_Y) + (size_t)m * 1024 + C;
    const f32x4 y0 = *(const f32x4*)yp, y1 = *(const f32x4*)(yp + 4);
    float y[8];
#pragma unroll
    for (int j = 0; j < 4; ++j) { y[j] = y0[j]; y[4 + j] = y1[j]; }
    float s = 0.f;
#pragma unroll
    for (int j = 0; j < 8; ++j) s += y[j];
    s += __shfl_xor(s, 1); s += __shfl_xor(s, 2); s += __shfl_xor(s, 4);
    const float mean = s * (1.f / 64.f); float q = 0.f;
#pragma unroll
    for (int j = 0; j < 8; ++j) { y[j] -= mean; q += y[j] * y[j]; }
    q += __shfl_xor(q, 1); q += __shfl_xor(q, 2); q += __shfl_xor(q, 4);
    const float rstd = 1.0f / sqrtf(q * (1.f / 64.f) + 64e-5f);
    const bf16* cur = PROJ + (size_t)m * PABP + COL_HB + 2048 + C;
    float hv[8]; lerp8(*(const u32x4*)cur, t > 0 ? *(const u32x4*)(cur - PABP) : (u32x4){0u, 0u, 0u, 0u}, t == 0, prompt ? nullptr : A.in[I_SHIFT] + (size_t)bs * DSH + 2048 + C, *(const f32x4*)(A.in[I_MU] + 2048 + C), *(const f32x4*)(A.in[I_MU] + 2048 + C + 4), hv);
    const float bon = ((const float*)(A.ws + WS_SCANIN))[(size_t)m * 16 + hd];
    float gb[8]; unpack8(*(const u32x4*)(PROJ + (size_t)m * PABP + COL_GB + C), gb);
    const f32x4 g0 = *(const f32x4*)(A.in[I_LNXG] + C), g1 = *(const f32x4*)(A.in[I_LNXG] + C + 4), b0 = *(const f32x4*)(A.in[I_LNXB] + C), b1 = *(const f32x4*)(A.in[I_LNXB] + C + 4);
    float r[8];
#pragma unroll
    for (int j = 0; j < 8; ++j) { const float gg = j < 4 ? g0[j & 3] : g1[j & 3], bb = j < 4 ? b0[j & 3] : b1[j & 3]; r[j] = (y[j] * rstd * gg + bb + bon * hv[j]) * siluf_(gb[j]); }
    u32x4 w; w.x = pk2(r[0], r[1]); w.y = pk2(r[2], r[3]); w.z = pk2(r[4], r[5]); w.w = pk2(r[6], r[7]);
    *(u32x4*)((bf16*)(A.ws + WS_XB) + (size_t)m * DM + 1024 + C) = w;
}
constexpr int AT_KROW = 272, AT_VROW = 576, AT_KMAP = 32 * AT_KROW, AT_STAGE = 2 * AT_KMAP + 32 * AT_VROW, AT_Q = 2 * AT_STAGE, AT_QMAP = 128 * AT_KROW, AT_SCR = AT_Q + 2 * AT_QMAP;
constexpr float ATT_THR = 6.0f;
constexpr int AT_XROW = 132;
struct AttnJob { const bf16* Q; const bf16* K; const bf16* V; const float* Kc; const float* Vc; const float* Kn; const float* Vn; int ntiles, tile0, sample; float* Op; float* ML; bf16* OC; const bf16* G; };
struct AtSet { u32x4 k[2], v[2]; };
__device__ __forceinline__ void at_ld(AtSet& S, const bf16* K, const bf16* V, int tile, unsigned goff) {
    const char* Kt = (const char*)K + (size_t)tile * 32 * DM * 2; const char* Vt = (const char*)V + (size_t)tile * 32 * DM * 2;
#pragma unroll
    for (int i = 0; i < 2; ++i) { S.k[i] = *(const u32x4*)(Kt + (size_t)i * 16 * DM * 2 + goff); S.v[i] = *(const u32x4*)(Vt + (size_t)i * 16 * DM * 2 + goff); }
}
__device__ __forceinline__ void at_st(const AtSet& S, LAS unsigned char* st, int kdst, int vdst) {
#pragma unroll
    for (int i = 0; i < 2; ++i) { *(LAS u32x4*)(st + kdst + i * 16 * AT_KROW) = S.k[i]; *(LAS u32x4*)(st + vdst + i * 16 * AT_VROW) = S.v[i]; }
}
struct AtSetF { f32x4 k[2][2], v[2][2]; };
__device__ __forceinline__ void at_ldf(AtSetF& S, const AttnJob& J, int j, unsigned goff) {
    const int T = J.tile0 + j;
    const char* Kt = (const char*)(T < 128 ? J.Kc + (size_t)T * 32 * DM : J.Kn + (size_t)(T - 128) * 32 * DM); const char* Vt = (const char*)(T < 128 ? J.Vc + (size_t)T * 32 * DM : J.Vn + (size_t)(T - 128) * 32 * DM);
#pragma unroll
    for (int i = 0; i < 2; ++i) { S.k[i][0] = *(const f32x4*)(Kt + (size_t)i * 16 * DM * 4 + 2 * goff); S.k[i][1] = *(const f32x4*)(Kt + (size_t)i * 16 * DM * 4 + 2 * goff + 16);
        S.v[i][0] = *(const f32x4*)(Vt + (size_t)i * 16 * DM * 4 + 2 * goff); S.v[i][1] = *(const f32x4*)(Vt + (size_t)i * 16 * DM * 4 + 2 * goff + 16); }
}
__device__ __forceinline__ void at_stf(const AtSetF& S, LAS unsigned char* st, int kdst, int vdst) {
#pragma unroll
    for (int i = 0; i < 2; ++i) { const f32x4 a = S.k[i][0], b = S.k[i][1], c = S.v[i][0], d = S.v[i][1];
        *(LAS u32x4*)(st + kdst + i * 16 * AT_KROW) = (u32x4){cvt_pk_bf16(a[0], a[1]), cvt_pk_bf16(a[2], a[3]), cvt_pk_bf16(b[0], b[1]), cvt_pk_bf16(b[2], b[3])};
        *(LAS u32x4*)(st + vdst + i * 16 * AT_VROW) = (u32x4){cvt_pk_bf16(c[0], c[1]), cvt_pk_bf16(c[2], c[3]), cvt_pk_bf16(d[0], d[1]), cvt_pk_bf16(d[2], d[3])}; }
}
__device__ __forceinline__ float at_max32(float x) { auto rr = __builtin_amdgcn_permlane32_swap(__float_as_uint(x), __float_as_uint(x), false, false); return fmaxf(__uint_as_float(rr[0]), __uint_as_float(rr[1])); }
__device__ __forceinline__ float at_sum32(float x) { auto rr = __builtin_amdgcn_permlane32_swap(__float_as_uint(x), __float_as_uint(x), false, false); return __uint_as_float(rr[0]) + __uint_as_float(rr[1]); }
__device__ __forceinline__ float at_rowsum32(float x) {
    x = dpp_add16(x);
    return x + __builtin_bit_cast(float, __builtin_amdgcn_ds_swizzle(__builtin_bit_cast(int, x), 0x401F)); }
struct AtState { f32x16 o[8]; float m_run, l_run; };
__device__ __forceinline__ void at_compute(AtState& Z, const LAS unsigned char* st, const LAS unsigned char* lds, int koff, int qoff, int voff, LAS float* scr, int r32, int hi) {
    f32x16 p = (f32x16){0.f};
#pragma unroll
    for (int ds = 0; ds < 8; ++ds) p = __builtin_amdgcn_mfma_f32_32x32x16_bf16(*(const LAS bf16x8*)(st + koff + ds * 32), *(const LAS bf16x8*)(lds + qoff + ds * 32), p, 0, 0, 0);
    float mx = fmaxf(p[0], p[1]);
#pragma unroll
    for (int r = 2; r < 16; ++r) mx = fmaxf(mx, p[r]);
    mx = at_max32(mx);
    if (__any(mx > Z.m_run + ATT_THR)) {
        const float mn = fmaxf(Z.m_run, mx), alpha = __builtin_amdgcn_exp2f(Z.m_run - mn);
        Z.m_run = mn; Z.l_run *= alpha;
        if (hi == 0) scr[r32] = alpha;
#pragma unroll
        for (int r = 0; r < 16; ++r) { const float al = scr[(r & 3) + 8 * (r >> 2) + 4 * hi];
#pragma unroll
            for (int d = 0; d < 8; ++d) Z.o[d][r] *= al; }
    }
    float ls = 0.f;
#pragma unroll
    for (int r = 0; r < 16; ++r) { p[r] = __builtin_amdgcn_exp2f(p[r] - Z.m_run); ls += p[r]; }
    Z.l_run += ls;
    u32x4 pw[2];
#pragma unroll
    for (int s = 0; s < 2; ++s) pw[s] = (u32x4){cvt_pk_bf16(p[8 * s], p[8 * s + 1]), cvt_pk_bf16(p[8 * s + 2], p[8 * s + 3]), cvt_pk_bf16(p[8 * s + 4], p[8 * s + 5]), cvt_pk_bf16(p[8 * s + 6], p[8 * s + 7])};
#pragma unroll
    for (int s = 0; s < 2; ++s) {
#pragma unroll
        for (int d = 0; d < 8; ++d) { const s16x4 lo = vtr(st + voff + (16 * s) * AT_VROW + d * 64), hh = vtr(st + voff + (16 * s + 8) * AT_VROW + d * 64);
            const bf16x8 vf = (bf16x8){lo[0], lo[1], lo[2], lo[3], hh[0], hh[1], hh[2], hh[3]};
            Z.o[d] = __builtin_amdgcn_mfma_f32_32x32x16_bf16(__builtin_bit_cast(bf16x8, pw[s]), vf, Z.o[d], 0, 0, 0); }
        __builtin_amdgcn_sched_barrier(0); }
}
__device__ __forceinline__ void attn_job(const AttnJob& J, const Args& A, LAS unsigned char* lds, float lam, int wave, int lane, int tid) {
    const int r32 = lane & 31, hi = lane >> 5, map = wave & 1;
    const int qg = J.sample ? ((wave >> 1) & 1) : (wave >> 1), khalf = wave >> 2;
    AtState Z;
#pragma unroll
    for (int d = 0; d < 8; ++d) Z.o[d] = (f32x16){0.f};
    Z.m_run = -1e30f; Z.l_run = 0.f;
    LAS float* scr = (LAS float*)(lds + AT_SCR) + wave * 64;
    const unsigned goff = (unsigned)(((tid >> 5) * DM + (tid & 31) * 8) * 2);
    const int kdst = ((tid & 31) >> 4) * AT_KMAP + (tid >> 5) * AT_KROW + (tid & 15) * 16, vdst = 2 * AT_KMAP + (tid >> 5) * AT_VROW + (tid & 31) * 16;
    const int koff = map * AT_KMAP + r32 * AT_KROW + hi * 16, qoff = AT_Q + map * AT_QMAP + (qg * 32 + r32) * AT_KROW + hi * 16;
    const int voff = 2 * AT_KMAP + (4 * hi + ((lane & 15) >> 2)) * AT_VROW + (((lane >> 4) & 1) * 16 + (lane & 3) * 4) * 2;
    { const int nq = J.sample ? 4 : 8;
      for (int i = 0; i < nq; ++i) { const int c = tid + 512 * i, row = c >> 5, cc = c & 31;
          *(LAS u32x4*)(lds + AT_Q + (cc >> 4) * AT_QMAP + row * AT_KROW + (cc & 15) * 16) = *(const u32x4*)(J.Q + (size_t)row * DM + cc * 8); } }
    const int NT = J.ntiles;
    if (!J.sample) {
        const int ntw = NT - ((qg < 2) ? 2 : 0);
        AtSet SA, SB;
        at_ld(SA, J.K, J.V, 0, goff); at_ld(SB, J.K, J.V, 1, goff);
        at_st(SA, lds, kdst, vdst);
        __syncthreads();
        for (int j = 0; j < NT; j += 2) {
            if (j + 2 < NT) at_ld(SA, J.K, J.V, j + 2, goff);
            if (j < ntw) at_compute(Z, lds, lds, koff, qoff, voff, scr, r32, hi);
            at_st(SB, lds + AT_STAGE, kdst, vdst);
            __syncthreads();
            if (j + 3 < NT) at_ld(SB, J.K, J.V, j + 3, goff);
            if (j + 1 < ntw) at_compute(Z, lds + AT_STAGE, lds, koff, qoff, voff, scr, r32, hi);
            if (j + 2 < NT) at_st(SA, lds, kdst, vdst);
            __syncthreads();
        }
    } else {
        AtSetF SF;
        at_ldf(SF, J, 0, goff); at_stf(SF, lds, kdst, vdst);
        __syncthreads();
        for (int j = 0; j < NT; ++j) {
            if (j + 1 < NT) at_ldf(SF, J, j + 1, goff);
            if ((j & 1) == khalf) at_compute(Z, lds + (j & 1) * AT_STAGE, lds, koff, qoff, voff, scr, r32, hi);
            if (j + 1 < NT) at_stf(SF, lds + ((j + 1) & 1) * AT_STAGE, kdst, vdst);
            __syncthreads();
        }
    }
    Z.l_run = at_sum32(Z.l_run);
    if (J.sample) {
        float* Op = J.Op + (size_t)khalf * 32768; float* ML = J.ML + khalf * 256;
        if (hi == 0) { ML[(map * 64 + qg * 32 + r32) * 2] = Z.m_run; ML[(map * 64 + qg * 32 + r32) * 2 + 1] = Z.l_run; }
#pragma unroll
        for (int d = 0; d < 8; ++d)
#pragma unroll
            for (int r = 0; r < 16; ++r) Op[(size_t)(map * 64 + qg * 32 + (r & 3) + 8 * (r >> 2) + 4 * hi) * 256 + d * 32 + r32] = Z.o[d][r];
        return;
    }
#ifdef NOEPI
    J.OC[tid] = (bf16)f2bf(Z.o[0][0] + Z.o[7][15] + Z.l_run); return;
#endif
    if (hi == 0) scr[r32] = 1.0f / Z.l_run;
    float il[16];
#pragma unroll
    for (int r = 0; r < 16; ++r) il[r] = scr[(r & 3) + 8 * (r >> 2) + 4 * hi];
    LAS float* xme = (LAS float*)lds + wave * (32 * AT_XROW);
#pragma unroll
    for (int d = 0; d < 4; ++d)
#pragma unroll
        for (int r = 0; r < 16; ++r) xme[((r & 3) + 8 * (r >> 2) + 4 * hi) * AT_XROW + d * 32 + r32] = (map ? Z.o[d][r] : Z.o[4 + d][r]) * il[r];
    __syncthreads();
    const float ca = map ? -lam : 1.f, cb = map ? 1.f : -lam;
    LAS float* xw = (LAS float*)lds + (wave ^ 1) * (32 * AT_XROW);
    LAS float* sx = (LAS float*)(lds + 8 * 32 * AT_XROW * 4);
#pragma unroll
    for (int r = 0; r < 16; ++r) { float s = 0.f; const int q = (r & 3) + 8 * (r >> 2) + 4 * hi;
#pragma unroll
        for (int d = 0; d < 4; ++d) { const float x = xw[q * AT_XROW + d * 32 + r32]; const float v = ca * il[r] * (map ? Z.o[4 + d][r] : Z.o[d][r]) + cb * x; xw[q * AT_XROW + d * 32 + r32] = v; s += v * v; }
        s = at_rowsum32(s);
        if (r32 == 0) sx[wave * 32 + q] = s;
        if (r & 1) __builtin_amdgcn_sched_barrier(0); }
    __syncthreads();
    { const int dvb = map * 128, oc = lane & 15;
      const f32x4 sg0 = *(const f32x4*)(A.in[I_SUBG] + dvb + oc * 8), sg1 = *(const f32x4*)(A.in[I_SUBG] + dvb + oc * 8 + 4);
#pragma unroll 1
      for (int it = 0; it < 8; ++it) { const int q = it * 4 + (lane >> 4); const size_t o = (size_t)(qg * 32 + q) * DM + dvb + oc * 8;
          const float sc = (1.0f / sqrtf((sx[wave * 32 + q] + sx[(wave ^ 1) * 32 + q]) * (1.f / 256.f) + 1e-5f)) * (1.f - LAM_INIT);
          const f32x4 x0 = *(const LAS f32x4*)(xw + q * AT_XROW + oc * 8) * sc, x1 = *(const LAS f32x4*)(xw + q * AT_XROW + oc * 8 + 4) * sc;
          float g[8]; unpack8(*(const u32x4*)(J.G + o), g);
          u32x4 w; w.x = cvt_pk_bf16(x0[0] * sg0[0] * g[0], x0[1] * sg0[1] * g[1]); w.y = cvt_pk_bf16(x0[2] * sg0[2] * g[2], x0[3] * sg0[3] * g[3]);
          w.z = cvt_pk_bf16(x1[0] * sg1[0] * g[4], x1[1] * sg1[1] * g[5]); w.w = cvt_pk_bf16(x1[2] * sg1[2] * g[6], x1[3] * sg1[3] * g[7]);
          *(u32x4*)(J.OC + o) = w; } }
    __syncthreads();
}

__device__ __forceinline__ void p6_task(const Args& A, int ms, int h, float lam, int lane) {
    const int b = ms >> 6, q = ms & 63; const int m = MP + ms;
    f32x4 on[2];
#pragma unroll
    for (int j = 0; j < 2; ++j) { float mm[8], ll[8], M = -1e30f;
#pragma unroll
        for (int s = 0; s < 8; ++s) { const size_t base = (size_t)((b * 8 + h) * 8 + s); const float* ml = (const float*)(A.ws + WS_MLS) + ((base * 2 + j) * 64 + q) * 2; mm[s] = ml[0]; ll[s] = ml[1]; M = fmaxf(M, mm[s]); }
        f32x4 acc = (f32x4){0.f, 0.f, 0.f, 0.f}; float L = 0.f;
#pragma unroll
        for (int s = 0; s < 8; ++s) { const size_t base = (size_t)((b * 8 + h) * 8 + s); const float w = __builtin_amdgcn_exp2f(mm[s] - M); L += w * ll[s];
            acc += ((const f32x4*)((const float*)(A.ws + WS_PARTS) + ((base * 2 + j) * 64 + q) * 256))[lane] * w; }
        on[j] = acc * (1.0f / L); }
    const f32x4 of = on[0] - on[1] * lam;
    const float ss = wave_sum(of[0] * of[0] + of[1] * of[1] + of[2] * of[2] + of[3] * of[3]);
    const float rms = 1.0f / sqrtf(ss * (1.f / 256.f) + 1e-5f);
    const f32x4 sg = ((const f32x4*)A.in[I_SUBG])[lane];
    const u32x2 gw = *(const u32x2*)((const bf16*)(A.ws + WS_GB) + (size_t)m * DM + h * 256 + lane * 4);
    const float sc = rms * (1.f - LAM_INIT);
    u32x2 w; w.x = pk2(of[0] * sc * sg[0] * bflo(gw.x), of[1] * sc * sg[1] * bfhi(gw.x)); w.y = pk2(of[2] * sc * sg[2] * bflo(gw.y), of[3] * sc * sg[3] * bfhi(gw.y));
    *(u32x2*)((bf16*)(A.ws + WS_XB) + (size_t)m * DM + h * 256 + lane * 4) = w;
}
__device__ __forceinline__ void p8_row(const Args& A, int m, int lane) {
    float* y = A.out + (m < MP ? O0 + (size_t)m * DM : O1 + (size_t)(m - MP) * DM);
    f32x4 v[8]; float s = 0.f;
#pragma unroll
    for (int j = 0; j < 8; ++j) { v[j] = ((const f32x4*)y)[lane + 64 * j]; s += (v[j][0] + v[j][1]) + (v[j][2] + v[j][3]); }
    const float mean = wave_sum(s) * (1.f / 2048.f); float q = 0.f;
#pragma unroll
    for (int j = 0; j < 8; ++j) { v[j] = v[j] - mean; q += (v[j][0] * v[j][0] + v[j][1] * v[j][1]) + (v[j][2] * v[j][2] + v[j][3] * v[j][3]); }
    const float rstd = 1.0f / sqrtf(wave_sum(q) * (1.f / 2048.f) + 1e-5f);
#pragma unroll
    for (int j = 0; j < 8; ++j) { const f32x4 g = ((const f32x4*)A.in[I_CLNG])[lane + 64 * j], b = ((const f32x4*)A.in[I_CLNB])[lane + 64 * j];
        ((f32x4*)y)[lane + 64 * j] = v[j] * rstd * g + b; }
}
constexpr int N_PHASES = 11;
__global__ void __launch_bounds__(512, 2) mega_fwd(Args A) {
    extern __shared__ __attribute__((aligned(16))) unsigned char lds_raw[];
    LAS unsigned char* lds = (LAS unsigned char*)lds_raw;
    const int tid = threadIdx.x, lane = tid & 63, wave = __builtin_amdgcn_readfirstlane(tid >> 6);
    const int G = gridDim.x, bx = blockIdx.x, vcu = (G % 8 == 0) ? (bx % 8) * (G / 8) + bx / 8 : bx;
    unsigned char* ws = A.ws;
    unsigned* ctl = (unsigned*)(ws + WS_CTL);
    for (int u = tid; u < (LDS_BYTES - LDSCTL_OFF) / 4; u += 512) ((LAS unsigned*)(lds + LDSCTL_OFF))[u] = 0u;
    __syncthreads();
    XcdBarrier bar = xcd_barrier_post(ctl + CW_BAR, (volatile LAS unsigned*)(lds + MISC_OFF) + 8);
    const int lo = A.ph_lo, hi = A.ph_hi;
#ifndef PH_MASK
#define PH_MASK 0x7ff
#endif
#define IN(k) (((PH_MASK >> (k)) & 1) && lo <= (k) && (k) < hi)
#define SEAM(k) do { if (IN(k) && IN((k) + 1)) xcd_barrier(bar); } while (0)
#ifndef REPEAT_PH
#define REPEAT_PH -1
#endif
#define NREP(k) ((REPEAT_PH == (k)) ? 2 : 1)
    float* const dummyf = (float*)(ws + 5 * MiB);
    const int gw = vcu * 8 + wave, NGW = G * 8;

    if (IN(0)) for (int rep = 0; rep < NREP(0); ++rep) { if (rep) xcd_barrier(bar); p0_prologue(A, lds, vcu, G, wave, lane, tid, rep ? dummyf : (float*)(ws + OFF_COLSUM), rep ? dummyf + 8192 : (float*)(ws + OFF_BW)); }
    SEAM(0);
    if (IN(1)) for (int rep = 0; rep < NREP(1); ++rep) { if (rep) xcd_barrier(bar);
        pg8::Gemm g{(const bf16*)(ws + WS_XB), (const bf16*)(ws + WS_WTIN), MT, PABP, DM}; pg8::StaticOrder S; S.init(MT, PABP, G, bx);
        pg8::EpiPlainBf16 E{(bf16*)(ws + WS_PROJ), PABP};
        pg8::gemm_phase<pg8::EpiPlainBf16, pg8::StaticOrder, true, true>(lds, g, S, E);
    }
    SEAM(1);
    if (IN(2)) for (int rep = 0; rep < NREP(2); ++rep) { if (rep) xcd_barrier(bar);
        for (int u = vcu; u < 136 * 4; u += G) mixer_a_unit(A, lds, u >> 2, u & 3, wave, lane, tid);
        const bf16* PROJ = (const bf16*)(ws + WS_PROJ);
        for (int idx = vcu * 512 + tid; idx < 12 * DSH; idx += G * 512) { const int s = idx / DSH, c = idx % DSH;
            const int m = s < 4 ? s * SEQ + SEQ - 1 : MP + (s - 4) * DSQ + DSQ - 1;
            float v = bf1(PROJ[(size_t)m * PABP + COL_HB + c]);
#if STAGE == 1
            v *= 3.f;
#endif
            A.out[(s < 4 ? O2 + (size_t)s * DSH : O4 + (size_t)(s - 4) * DSH) + c] = v; }
    }
    SEAM(2);
    if (IN(3)) for (int rep = 0; rep < NREP(3); ++rep) { if (rep) xcd_barrier(bar);
        for (int u = vcu; u < 256 + 512; u += G) { const int uu = u < 256 ? u : u - 256, seq = (u < 256 ? 0 : NBP) + (uu >> 6); scan_unit(A, lds, seq, (uu >> 2) & 15, uu & 3, wave, lane, tid); }
    }
    SEAM(3);
    if (IN(4)) for (int rep = 0; rep < NREP(4); ++rep) { if (rep) xcd_barrier(bar); for (int wt = gw; wt < MT * 2; wt += NGW) p2c_task(A, wt >> 1, wt & 1, lane); }
    SEAM(4);
    if (IN(5)) for (int rep = 0; rep < NREP(5); ++rep) { if (rep) xcd_barrier(bar);
        pg8::Gemm g{(const bf16*)(ws + WS_XB), (const bf16*)(ws + WS_WTOUT), MT, DM, DM}; pg8::StaticOrder S; S.init(MT, DM, G, bx);
        pg8::EpiZ1 E{A.in[I_XP], A.in[I_XS], (bf16*)(ws + WS_Z1), rep ? dummyf : (float*)(ws + OFF_STATS1)};
        pg8::gemm_phase<pg8::EpiZ1, pg8::StaticOrder, true, true>(lds, g, S, E);
    }
    SEAM(5);
    if (IN(6)) for (int rep = 0; rep < NREP(6); ++rep) { if (rep) xcd_barrier(bar);
        pg8::Gemm g{(const bf16*)(ws + WS_Z1), (const bf16*)(ws + WS_WTCIN), MT, PCN, DM}; pg8::StaticOrder S; S.init(MT, PCN, G, bx);
        pg8::EpiQKVG E{(const float*)(ws + OFF_STATS1), (const float*)(ws + OFF_COLSUM), (const float*)(ws + OFF_BW), (bf16*)(ws + WS_QB), (bf16*)(ws + WS_GB), (bf16*)(ws + WS_KBP), (bf16*)(ws + WS_VBP), A.out};
        pg8::gemm_phase<pg8::EpiQKVG, pg8::StaticOrder, true, true>(lds, g, S, E);
    }
    SEAM(6);
    if (IN(7)) for (int rep = 0; rep < NREP(7); ++rep) { if (rep) xcd_barrier(bar);
        float lam;
        { const float s1 = A.in[I_LQ1][lane] * A.in[I_LK1][lane] + A.in[I_LQ1][lane + 64] * A.in[I_LK1][lane + 64], s2 = A.in[I_LQ2][lane] * A.in[I_LK2][lane] + A.in[I_LQ2][lane + 64] * A.in[I_LK2][lane + 64];
          lam = __expf(wave_sum(s1)) - __expf(wave_sum(s2)) + LAM_INIT; }
        for (int v0 = vcu; v0 < 256; v0 += G) {
            for (int i = 0; i < 5; ++i) {
                AttnJob J;
                if (i < 4) { const int bh = v0 >> 3, s = v0 & 7, b = bh >> 3, h = bh & 7; const int qb = (i & 1) ? (16 * (i >> 1) + 15 - s) : (16 * (i >> 1) + s);
                    J.Q = (const bf16*)(ws + WS_QB) + (size_t)(b * SEQ + qb * 128) * DM + h * 256; J.K = (const bf16*)(ws + WS_KBP) + (size_t)(b * SEQ) * DM + h * 256; J.V = (const bf16*)(ws + WS_VBP) + (size_t)(b * SEQ) * DM + h * 256;
                    J.Kc = J.Vc = J.Kn = J.Vn = nullptr; J.ntiles = 4 * qb + 4; J.tile0 = 0; J.sample = 0; J.Op = nullptr; J.ML = nullptr;
                    J.OC = (bf16*)(ws + WS_XB) + (size_t)(b * SEQ + qb * 128) * DM + h * 256; J.G = (const bf16*)(ws + WS_GB) + (size_t)(b * SEQ + qb * 128) * DM + h * 256;
                } else { const int bh2 = v0 >> 2, sp = v0 & 3, b2 = bh2 >> 3, h2 = bh2 & 7, start = sp < 2 ? 33 * sp : 66 + 32 * (sp - 2);
                    const size_t base = (size_t)((b2 * 8 + h2) * 8 + sp * 2);
                    J.Q = (const bf16*)(ws + WS_QB) + (size_t)(MP + b2 * DSQ) * DM + h2 * 256; J.K = J.V = nullptr;
                    J.Kc = A.in[I_CK] + (size_t)b2 * PAST * DM + h2 * 256; J.Vc = A.in[I_CV] + (size_t)b2 * PAST * DM + h2 * 256;
                    J.Kn = A.out + O9 + (size_t)b2 * DSQ * DM + h2 * 256; J.Vn = A.out + O10 + (size_t)b2 * DSQ * DM + h2 * 256;
                    J.ntiles = sp < 2 ? 33 : 32; J.tile0 = start; J.sample = 1; J.Op = (float*)(ws + WS_PARTS) + base * 32768; J.ML = (float*)(ws + WS_MLS) + base * 256; J.OC = nullptr; J.G = nullptr; }
                attn_job(J, A, lds, lam, wave, lane, tid); }
        }
    }
    SEAM(7);
    if (IN(8)) for (int rep = 0; rep < NREP(8); ++rep) { if (rep) xcd_barrier(bar);
        float lam;
        { const float s1 = A.in[I_LQ1][lane] * A.in[I_LK1][lane] + A.in[I_LQ1][lane + 64] * A.in[I_LK1][lane + 64], s2 = A.in[I_LQ2][lane] * A.in[I_LK2][lane] + A.in[I_LQ2][lane + 64] * A.in[I_LK2][lane + 64];
          lam = __expf(wave_sum(s1)) - __expf(wave_sum(s2)) + LAM_INIT; }
        for (int wt = gw; wt < MS * 8; wt += NGW) p6_task(A, wt >> 3, wt & 7, lam, lane);
    }
    SEAM(8);
    if (IN(9)) for (int rep = 0; rep < NREP(9); ++rep) { if (rep) xcd_barrier(bar);
        pg8::Gemm g{(const bf16*)(ws + WS_XB), (const bf16*)(ws + WS_WTCOUT), MT, DM, DM}; pg8::StaticOrder S; S.init(MT, DM, G, bx);
        pg8::EpiZ2 E{(const float*)(ws + OFF_STATS1), (const bf16*)(ws + WS_Z1), A.in[I_LNG], A.in[I_LNB], A.out};
        pg8::gemm_phase<pg8::EpiZ2, pg8::StaticOrder, true, true>(lds, g, S, E);
    }
    SEAM(9);
    if (IN(10)) { for (int m = gw; m < MT; m += NGW) p8_row(A, m, lane); }
#undef IN
#undef SEAM
}

extern "C" void kernel_launch(void* const* d_in, const int* in_sizes, int n_in, void* d_out, int out_size, void* d_ws, size_t ws_size, hipStream_t stream) {
    static int grid = 0;
    if (grid == 0) {
        if (n_in != 33 || (size_t)out_size != OUT_TOTAL || ws_size < WS_END) { fprintf(stderr, "kernel_launch: unexpected shapes: n_in %d out %d ws %zu (need %zu)\n", n_in, out_size, ws_size, (size_t)WS_END); grid = -1; return; }
        int dev = 0, cus = 0;
        if (hipGetDevice(&dev) != hipSuccess || hipDeviceGetAttribute(&cus, hipDeviceAttributeMultiprocessorCount, dev) != hipSuccess) { grid = -1; return; }
        if (hipFuncSetAttribute((const void*)mega_fwd, hipFuncAttributeMaxDynamicSharedMemorySize, LDS_BYTES) != hipSuccess) { fprintf(stderr, "kernel_launch: hipFuncSetAttribute failed\n"); grid = -1; return; }
        (void)hipGetLastError();
        grid = cus;
        if (grid != 256) fprintf(stderr, "kernel_launch: %d CUs; this kernel is laid out for 256\n", grid);
    }
    if (grid < 0) return;
    (void)hipMemsetAsync((char*)d_ws + WS_CTL, 0, CTL_ZERO_BYTES, stream);
    Args a{};
    for (int i = 0; i < 33; ++i) a.in[i] = (const float*)d_in[i];
    a.out = (float*)d_out; a.ws = (unsigned char*)d_ws;
#if STAGE == 1
    const int nph = 3;
#elif STAGE == 2
    const int nph = 4;
#elif STAGE == 3
    const int nph = 7;
#else
    const int nph = N_PHASES;
#endif
#if STAGE < 9
    (void)hipMemsetAsync(d_out, 0, (size_t)out_size * 4, stream);
#endif
#ifdef MULTI_LAUNCH
    for (int p = 0; p < nph; ++p) { a.ph_lo = p; a.ph_hi = p + 1; hipLaunchKernelGGL(mega_fwd, dim3(grid), dim3(512), LDS_BYTES, stream, a); }
#else
    a.ph_lo = 0; a.ph_hi = nph;
    hipLaunchKernelGGL(mega_fwd, dim3(grid), dim3(512), LDS_BYTES, stream, a);
#endif
}
```

```cpp
#include <hip/hip_runtime.h>
#include <cstdio>
#include <cstdint>
#ifndef STAGE
#define STAGE 9
#endif
namespace pg8 {
#define PG8_LAS __attribute__((address_space(3)))
typedef unsigned short bf16_t;
typedef short bf16x8 __attribute__((ext_vector_type(8)));
typedef float f32x4 __attribute__((ext_vector_type(4)));
typedef unsigned u32x4 __attribute__((ext_vector_type(4)));
constexpr int BM = 256, BK = 64, HALF = 128, HTB = HALF * BK * 2  , STAGE_BYTES = 8 * HTB, NXCD = 8, WGM = 8;

__host__ __device__ __forceinline__ int lds_byte(int r, int c) { const int st = (r >> 4) * 2 + (c >> 5), rr = r & 15, cc = c & 31, ob = rr * 64 + cc * 2; return st * 1024 + (ob ^ (((ob >> 9) & 1) << 5)); }
__host__ __device__ __forceinline__ void stage_rc(int b, int& R, int& C) { const int st = b / 1024, sb = b % 1024, swz = sb ^ (((sb >> 9) & 1) << 5); R = (st >> 1) * 16 + swz / 64; C = (st & 1) * 32 + (swz % 64) / 2; }
__host__ __device__ __forceinline__ int perm32(int rho) { const int n = rho >> 4, i = rho & 15; return 8 * (i >> 2) + 4 * n + (i & 3); }

struct Unit { int pm, pn, ko; };
struct Gemm { const bf16_t* A; const bf16_t* Bt; int M, N, K, ld; };

struct StaticOrder {
    int nM, nN, nwg, G, c;
    __host__ __device__ void init(int M, int N, int G_, int c_) { nM = M / BM; nN = N / BM; nwg = nM * nN; G = G_; c = c_; }
    __host__ __device__ bool next(int i, Unit& u) const {
        const long L = (long)i * G + c; if (L >= nwg) return false;
        int wgid = (int)L; { const int q = nwg / NXCD, r = nwg % NXCD, xcd = wgid % NXCD, off = wgid / NXCD; wgid = (xcd < r ? xcd * (q + 1) : r * (q + 1) + (xcd - r) * q) + off; }
        const int nig = WGM * nN, gid = wgid / nig, fm = gid * WGM, gsz = (nM - fm) < WGM ? (nM - fm) : WGM;
        u.pm = fm + ((wgid % nig) % gsz); u.pn = (wgid % nig) / gsz; u.ko = 0; return true;
    }
    __device__ __forceinline__ void a_ready(const Unit&) const {}
    __device__ __forceinline__ void done(const Unit&) const {}
};

__device__ __forceinline__ unsigned cvt_pk_bf16(float lo, float hi) { unsigned r; asm volatile("v_cvt_pk_bf16_f32 %0, %1, %2" : "=v"(r) : "v"(lo), "v"(hi)); return r; }
typedef float f32x2 __attribute__((ext_vector_type(2)));
template <class Epi, class Sched, bool ALIGN_EPI = false, bool SP2 = false>
__device__ __forceinline__ void gemm_phase(PG8_LAS unsigned char* lds, const Gemm g, const Sched& S, const Epi& E) {
    const int tid = threadIdx.x, wid = __builtin_amdgcn_readfirstlane(tid >> 6), lane = tid & 63, wr = wid >> 2, wc = wid & 3, fr = lane & 15, fq = lane >> 4;
    const int K = g.K, nt = K / BK, LD = g.ld;
    unsigned voffA[2], voffB[2];
#pragma unroll
    for (int i = 0; i < 2; ++i) { int R, C; stage_rc(tid * 16 + i * 8192, R, C); const int Rb = Epi::PERM ? ((R & ~31) + perm32(R & 31)) : R;
        voffA[i] = (unsigned)(R * LD + C) * 2u; voffB[i] = (unsigned)(Rb * LD + C) * 2u; }
    const size_t kstep = (size_t)(BK * 2);
    const size_t hstep = (size_t)HALF * LD * 2;
    const size_t tstep = 2 * hstep;
    const unsigned ldsw = (unsigned)wid * 1024u;
    const int aoff = lds_byte(wr * 64 + fr, fq * 8), boff = lds_byte(wc * 32 + fr, fq * 8);
#define PG8_SA(b, h) (((b) * 2 + (h)) * HTB)
#define PG8_SB(b, h) ((4 + (b) * 2 + (h)) * HTB)
#define PG8_STAGE(bufoff, gbase, voff) do { _Pragma("unroll") for (int _i = 0; _i < 2; ++_i) \
        __builtin_amdgcn_global_load_lds((const unsigned*)((const char*)(gbase) + (voff)[_i]), (PG8_LAS unsigned*)(lds + (bufoff) + ldsw + _i * 8192), 16, 0, 0); } while (0)
#define PG8_LDA(dst, b, h) do { _Pragma("unroll") for (int m = 0; m < 4; ++m) _Pragma("unroll") for (int k = 0; k < 2; ++k) dst[m][k] = *(const PG8_LAS bf16x8*)(lds + PG8_SA(b, h) + aoff + m * 2048 + k * 1024); } while (0)
#define PG8_LDB(dst, b, h) do { _Pragma("unroll") for (int n = 0; n < 2; ++n) _Pragma("unroll") for (int k = 0; k < 2; ++k) dst[n][k] = *(const PG8_LAS bf16x8*)(lds + PG8_SB(b, h) + boff + n * 2048 + k * 1024); } while (0)
#define PG8_MMA(ai, bj, At, Bt) do { __builtin_amdgcn_s_setprio(1); _Pragma("unroll") for (int m = 0; m < 4; ++m) _Pragma("unroll") for (int n = 0; n < 2; ++n) _Pragma("unroll") for (int k = 0; k < 2; ++k) \
        acc[ai][bj][m][n] = __builtin_amdgcn_mfma_f32_16x16x32_bf16(Bt[n][k], At[m][k], acc[ai][bj][m][n], 0, 0, 0); __builtin_amdgcn_s_setprio(0); } while (0)
#define PG8_WAIT_V(n) asm volatile("s_waitcnt vmcnt(" #n ")" ::: "memory")
#define PG8_WAIT_L(n) asm volatile("s_waitcnt lgkmcnt(" #n ")" ::: "memory")
#define PG8_BAR __builtin_amdgcn_s_barrier()
#define PG8_SCHED __builtin_amdgcn_sched_barrier(0)
    Unit cur, nxt; int ui = 0;
    if (!S.next(0, cur)) return;
    f32x4 acc[2][2][4][2];
#pragma unroll
    for (int a = 0; a < 2; ++a)
#pragma unroll
        for (int b = 0; b < 2; ++b)
#pragma unroll
            for (int m = 0; m < 4; ++m)
#pragma unroll
                for (int n = 0; n < 2; ++n) acc[a][b][m][n] = (f32x4){0.f, 0.f, 0.f, 0.f};
    bf16x8 At[4][2], B0[2][2], B1[2][2];
    const char* cA = (const char*)g.A + (size_t)cur.pm * tstep + (size_t)cur.ko * 2; const char* cB = (const char*)g.Bt + (size_t)cur.pn * tstep + (size_t)cur.ko * 2;
    S.a_ready(cur);
    if constexpr (SP2) {
        PG8_STAGE(PG8_SB(0, 0), cB, voffB); PG8_STAGE(PG8_SB(0, 1), cB + hstep, voffB); PG8_STAGE(PG8_SA(0, 0), cA, voffA); PG8_STAGE(PG8_SA(0, 1), cA + hstep, voffA);
        if (wr == 1) PG8_BAR;
        PG8_WAIT_V(2); PG8_BAR;
        PG8_STAGE(PG8_SB(1, 0), cB + kstep, voffB); PG8_STAGE(PG8_SA(1, 0), cA + kstep, voffA); PG8_STAGE(PG8_SB(1, 1), cB + hstep + kstep, voffB);
        PG8_WAIT_V(6); PG8_BAR;
    } else {
        PG8_STAGE(PG8_SB(0, 0), cB, voffB); PG8_STAGE(PG8_SA(0, 0), cA, voffA); PG8_STAGE(PG8_SB(0, 1), cB + hstep, voffB); PG8_STAGE(PG8_SA(0, 1), cA + hstep, voffA);
        if (wr == 1) PG8_BAR;
        PG8_WAIT_V(4); PG8_BAR;
        PG8_STAGE(PG8_SB(1, 0), cB + kstep, voffB); PG8_STAGE(PG8_SA(1, 0), cA + kstep, voffA); PG8_STAGE(PG8_SB(1, 1), cB + hstep + kstep, voffB);
        PG8_WAIT_V(6); PG8_BAR;
    }
    for (;;) {
        const bool has_next = S.next(ui + 1, nxt);
        const char* nA = has_next ? (const char*)g.A + (size_t)nxt.pm * tstep + (size_t)nxt.ko * 2 : cA; const char* nB = has_next ? (const char*)g.Bt + (size_t)nxt.pn * tstep + (size_t)nxt.ko * 2 : cB;
        for (int t = 0; t < nt; t += 2) {
            const bool last = (t == nt - 2);
            const char* a1 = cA + (size_t)(t + 1) * kstep;
            const char* a2 = last ? nA : cA + (size_t)(t + 2) * kstep; const char* b2 = last ? nB : cB + (size_t)(t + 2) * kstep;
            const char* a3 = a2 + kstep; const char* b3 = b2 + kstep;
            if (last && has_next) S.a_ready(nxt);
            if constexpr (SP2) {
            PG8_LDB(B0, 0, 0); PG8_LDB(B1, 0, 1); PG8_SCHED; PG8_LDA(At, 0, 0); PG8_STAGE(PG8_SA(1, 1), a1 + hstep, voffA);
            PG8_WAIT_V(8); PG8_WAIT_L(0); PG8_BAR; PG8_MMA(0, 0, At, B0); PG8_MMA(0, 1, At, B1); PG8_BAR; PG8_SCHED;
            PG8_LDA(At, 0, 1); PG8_STAGE(PG8_SB(0, 0), b2, voffB); PG8_STAGE(PG8_SB(0, 1), b2 + hstep, voffB); PG8_STAGE(PG8_SA(0, 0), a2, voffA);
            PG8_WAIT_V(8); PG8_WAIT_L(0); PG8_BAR; PG8_MMA(1, 0, At, B0); PG8_MMA(1, 1, At, B1); PG8_BAR; PG8_SCHED;
            PG8_LDB(B0, 1, 0); PG8_LDB(B1, 1, 1); PG8_SCHED; PG8_LDA(At, 1, 0); PG8_STAGE(PG8_SA(0, 1), a2 + hstep, voffA);
            PG8_WAIT_V(8); PG8_WAIT_L(0); PG8_BAR; PG8_MMA(0, 0, At, B0); PG8_MMA(0, 1, At, B1); PG8_BAR; PG8_SCHED;
            PG8_LDA(At, 1, 1); PG8_STAGE(PG8_SB(1, 0), b3, voffB); PG8_STAGE(PG8_SB(1, 1), b3 + hstep, voffB); PG8_STAGE(PG8_SA(1, 0), a3, voffA);
            PG8_WAIT_V(8); PG8_WAIT_L(0); PG8_BAR; PG8_MMA(1, 0, At, B0); PG8_MMA(1, 1, At, B1); PG8_BAR; PG8_SCHED;
            } else {
            PG8_LDB(B0, 0, 0); PG8_SCHED; PG8_LDA(At, 0, 0); PG8_STAGE(PG8_SA(1, 1), a1 + hstep, voffA);
            PG8_WAIT_L(8); PG8_BAR; PG8_WAIT_L(0); PG8_MMA(0, 0, At, B0); PG8_BAR; PG8_SCHED;
            PG8_LDB(B1, 0, 1); PG8_STAGE(PG8_SB(0, 0), b2, voffB);
            PG8_BAR; PG8_WAIT_L(0); PG8_MMA(0, 1, At, B1); PG8_BAR;
            PG8_LDA(At, 0, 1); PG8_STAGE(PG8_SA(0, 0), a2, voffA);
            PG8_BAR; PG8_WAIT_L(0); PG8_MMA(1, 0, At, B0); PG8_BAR; PG8_SCHED;
            PG8_STAGE(PG8_SB(0, 1), b2 + hstep, voffB);
            PG8_WAIT_V(6); PG8_BAR; PG8_MMA(1, 1, At, B1); PG8_BAR;
            PG8_LDB(B0, 1, 0); PG8_SCHED; PG8_LDA(At, 1, 0); PG8_STAGE(PG8_SA(0, 1), a2 + hstep, voffA);
            PG8_WAIT_L(8); PG8_BAR; PG8_WAIT_L(0); PG8_MMA(0, 0, At, B0); PG8_BAR; PG8_SCHED;
            PG8_LDB(B1, 1, 1); PG8_STAGE(PG8_SB(1, 0), b3, voffB);
            PG8_BAR; PG8_WAIT_L(0); PG8_MMA(0, 1, At, B1); PG8_BAR;
            PG8_LDA(At, 1, 1); PG8_STAGE(PG8_SA(1, 0), a3, voffA);
            PG8_BAR; PG8_WAIT_L(0); PG8_MMA(1, 0, At, B0); PG8_BAR; PG8_SCHED;
            PG8_STAGE(PG8_SB(1, 1), b3 + hstep, voffB);
            PG8_WAIT_V(6); PG8_BAR; PG8_MMA(1, 1, At, B1); PG8_BAR;
            }
        }
        if constexpr (ALIGN_EPI) { if (wr == 0) PG8_BAR; }
        if constexpr (!Epi::AFTER_DRAIN) { E(acc, cur, wr, wc, fr, fq); S.done(cur); }
        if (!has_next) break;
#pragma unroll
        for (int a = 0; a < 2; ++a)
#pragma unroll
            for (int b = 0; b < 2; ++b)
#pragma unroll
                for (int m = 0; m < 4; ++m)
#pragma unroll
                    for (int n = 0; n < 2; ++n) acc[a][b][m][n] = (f32x4){0.f, 0.f, 0.f, 0.f};
        cur = nxt; cA = nA; cB = nB; ++ui;
        if constexpr (ALIGN_EPI) { if (wr == 1) PG8_BAR; }
    }
    PG8_WAIT_V(0);
    if constexpr (!ALIGN_EPI) { if (wr == 0) PG8_BAR; }
    PG8_BAR;
    if constexpr (Epi::AFTER_DRAIN) { E.fused(acc, cur, wr, wc, fr, fq, lds, wid, lane); S.done(cur); }
#undef PG8_SA
#undef PG8_SB
#undef PG8_STAGE
#undef PG8_LDA
#undef PG8_LDB
#undef PG8_MMA
#undef PG8_WAIT_V
#undef PG8_WAIT_L
#undef PG8_BAR
#undef PG8_SCHED
}
}
constexpr int DM = 2048, NBP = 4, SEQ = 4096, NBS = 8, DSQ = 64, PAST = 4096;
constexpr int MP = NBP * SEQ, MS = NBS * DSQ, MT = MP + MS;
constexpr int PAB = 7296, PABP = 7424, PCN = 8192, DSH = 3200, KVROWS = PAST + DSQ;
constexpr int COL_VA = 1024, COL_GA = 2048, COL_HB = 3072, COL_GB = 6272;
constexpr float ALPHA = 1.41421356237f;
constexpr float LAM_INIT = 0.35550906759f;
constexpr float QSCALE = 0.08838834764831845f * 1.4426950408889634f;
constexpr size_t O0 = 0, O1 = 33554432, O2 = 34603008, O3 = 34615808, O4 = 34877952, O5 = 34903552, O6 = 35427840, O7 = 35952128, O8 = 69506560, O9 = 103060992, O10 = 104109568, OUT_TOTAL = 105158144;
constexpr size_t MiB = 1u << 20;
constexpr size_t WS_CTL = 0, CTL_ZERO_BYTES = 1 * MiB;
constexpr size_t OFF_STATS1 = 131072, OFF_COLSUM = 393216, OFF_BW = 458752;
constexpr size_t WS_W2T = 4 * MiB, WS_A2T = WS_W2T + 131072, WS_WSB = WS_W2T + 262144;
constexpr size_t WS_WTIN = 8 * MiB, WS_WTOUT = 37 * MiB, WS_WTCIN = 45 * MiB, WS_WTCOUT = 77 * MiB;
constexpr size_t WS_XB = 85 * MiB, WS_Z1 = 151 * MiB;
constexpr size_t WS_PROJ = 477 * MiB, WS_SCANIN = 717 * MiB, WS_Y = 915 * MiB;
constexpr size_t WS_QB = 477 * MiB, WS_GB = 543 * MiB, WS_KBP = 609 * MiB, WS_VBP = 673 * MiB, WS_PARTP = 737 * MiB, WS_MLP = 993 * MiB;
constexpr size_t WS_PARTS = 217 * MiB, WS_MLS = 281 * MiB, WS_SLAB = 981 * MiB, WS_SLAB3 = 300 * MiB, WS_END = 1024 * MiB;
constexpr int CW_TMO = 0, CW_CODE = 1, CW_BAR = 4096;
constexpr size_t SCAN_SBASE = (size_t)NBP * 16 * SEQ * 384;
constexpr int RING_BYTES = 147456, LDSCTL_OFF = RING_BYTES, MISC_OFF = LDSCTL_OFF + 320, LDS_BYTES = 148480;

#define LAS __attribute__((address_space(3)))
typedef unsigned short bf16;
typedef short bf16x8 __attribute__((ext_vector_type(8)));
typedef short s16x4 __attribute__((ext_vector_type(4)));
typedef float f32x4 __attribute__((ext_vector_type(4)));
typedef float f32x2 __attribute__((ext_vector_type(2)));
typedef float f32x16 __attribute__((ext_vector_type(16)));
typedef unsigned u32x4 __attribute__((ext_vector_type(4)));
typedef unsigned u32x2 __attribute__((ext_vector_type(2)));
using pg8::cvt_pk_bf16;

__device__ __forceinline__ unsigned f2bf(float f) { unsigned u = __builtin_bit_cast(unsigned, f); return (u + 0x7fffu + ((u >> 16) & 1u)) >> 16; }
__device__ __forceinline__ unsigned pk2(float lo, float hi) { return f2bf(lo) | (f2bf(hi) << 16); }
__device__ __forceinline__ float bflo(unsigned w) { return __builtin_bit_cast(float, w << 16); }
__device__ __forceinline__ float bfhi(unsigned w) { return __builtin_bit_cast(float, w & 0xffff0000u); }
__device__ __forceinline__ float bf1(bf16 h) { return __builtin_bit_cast(float, (unsigned)h << 16); }
__device__ __forceinline__ float sigmoidf_(float x) { return __builtin_amdgcn_rcpf(1.f + __expf(-x)); }
__device__ __forceinline__ float siluf_(float x) { return x * sigmoidf_(x); }
__device__ __forceinline__ float wave_sum(float v) {
#pragma unroll
    for (int o = 1; o < 64; o <<= 1) v += __shfl_xor(v, o);
    return v;
}
__device__ __forceinline__ void unpack8(u32x4 w, float (&f)[8]) { f[0] = bflo(w.x); f[1] = bfhi(w.x); f[2] = bflo(w.y); f[3] = bfhi(w.y); f[4] = bflo(w.z); f[5] = bfhi(w.z); f[6] = bflo(w.w); f[7] = bfhi(w.w); }

namespace pg8 {
struct EpiPlainBf16 {
    static constexpr bool PERM = true, AFTER_DRAIN = false;
    bf16_t* O; int ldc;
    __device__ __forceinline__ void operator()(const f32x4 (&acc)[2][2][4][2], const Unit& u, int wr, int wc, int fr, int fq) const {
        const int row0 = u.pm * BM + wr * 64 + fr, col0 = u.pn * BM + wc * 32 + 8 * fq;
#pragma unroll
        for (int ai = 0; ai < 2; ++ai)
#pragma unroll
            for (int m = 0; m < 4; ++m) { bf16_t* rowp = O + (size_t)(row0 + ai * HALF + m * 16) * ldc + col0;
#pragma unroll
                for (int bj = 0; bj < 2; ++bj) { const f32x4 v0 = acc[ai][bj][m][0], v1 = acc[ai][bj][m][1];
                    u32x4 w; w.x = cvt_pk_bf16(v0[0], v0[1]); w.y = cvt_pk_bf16(v0[2], v0[3]); w.z = cvt_pk_bf16(v1[0], v1[1]); w.w = cvt_pk_bf16(v1[2], v1[3]);
                    *(u32x4*)(rowp + bj * HALF) = w; } }
    }
};
struct EpiZ1 {
    static constexpr bool PERM = true, AFTER_DRAIN = false;
    const float* xp; const float* xs; bf16_t* Z; float* stats;
    __device__ __forceinline__ void operator()(const f32x4 (&acc)[2][2][4][2], const Unit& u, int wr, int wc, int fr, int fq) const {
        const int row0 = u.pm * BM + wr * 64 + fr, col0 = u.pn * BM + wc * 32 + 8 * fq;
        f32x4 xn[2][2];
#define EPZ1_LOAD(i_) do { const int row_ = row0 + ((i_) >> 2) * HALF + ((i_) & 3) * 16; const float* xr_ = (row_ < ::MP ? xp + (size_t)row_ * ::DM : xs + (size_t)(row_ - ::MP) * ::DM) + col0; \
            _Pragma("unroll") for (int bj = 0; bj < 2; ++bj) { xn[bj][0] = *(const f32x4*)(xr_ + bj * HALF); xn[bj][1] = *(const f32x4*)(xr_ + bj * HALF + 4); } } while (0)
        EPZ1_LOAD(0);
#pragma unroll
        for (int i = 0; i < 8; ++i) { const int ai = i >> 2, m = i & 3; const int row = row0 + ai * HALF + m * 16;
            f32x4 xc[2][2];
#pragma unroll
            for (int bj = 0; bj < 2; ++bj) { xc[bj][0] = xn[bj][0]; xc[bj][1] = xn[bj][1]; }
            if (i + 1 < 8) EPZ1_LOAD(i + 1);
            bf16_t* zr = Z + (size_t)row * ::DM + col0; float s = 0.f, ss = 0.f;
#pragma unroll
            for (int bj = 0; bj < 2; ++bj) { const f32x4 v0 = acc[ai][bj][m][0] + xc[bj][0] * ::ALPHA, v1 = acc[ai][bj][m][1] + xc[bj][1] * ::ALPHA;
                u32x4 w; w.x = cvt_pk_bf16(v0[0], v0[1]); w.y = cvt_pk_bf16(v0[2], v0[3]); w.z = cvt_pk_bf16(v1[0], v1[1]); w.w = cvt_pk_bf16(v1[2], v1[3]);
                *(u32x4*)(zr + bj * HALF) = w;
                float f[8]; ::unpack8(w, f);
#pragma unroll
                for (int q = 0; q < 8; ++q) { s += f[q]; ss += f[q] * f[q]; } }
            s += __shfl_xor(s, 16); s += __shfl_xor(s, 32); ss += __shfl_xor(ss, 16); ss += __shfl_xor(ss, 32);
            if (fq == 0) { unsafeAtomicAdd(stats + 2 * row, s); unsafeAtomicAdd(stats + 2 * row + 1, ss); } }
#undef EPZ1_LOAD
    }
};
struct EpiQKVG {
    static constexpr bool PERM = true, AFTER_DRAIN = false;
    const float* stats; const float* colsum; const float* bw; bf16_t* QB; bf16_t* GB; bf16_t* KBP; bf16_t* VBP; float* out;
    __device__ __forceinline__ void operator()(const f32x4 (&acc)[2][2][4][2], const Unit& u, int wr, int wc, int fr, int fq) const {
        const int kind = u.pn >> 3;
        const int row0 = u.pm * BM + wr * 64 + fr, col0 = (u.pn & 7) * BM + wc * 32 + 8 * fq, gcol0 = u.pn * BM + wc * 32 + 8 * fq;
        f32x4 cs[2][2], bb[2][2];
#pragma unroll
        for (int bj = 0; bj < 2; ++bj)
#pragma unroll
            for (int n = 0; n < 2; ++n) { cs[bj][n] = *(const f32x4*)(colsum + gcol0 + bj * HALF + 4 * n); bb[bj][n] = *(const f32x4*)(bw + gcol0 + bj * HALF + 4 * n); }
        float mean_[8], rstd_[8];
#pragma unroll
        for (int i = 0; i < 8; ++i) { const int row = row0 + (i >> 2) * HALF + (i & 3) * 16; const f32x2 st = *(const f32x2*)(stats + 2 * row);
            mean_[i] = st[0] * (1.f / 2048.f); rstd_[i] = st[1]; }
#pragma unroll
        for (int i = 0; i < 8; ++i) rstd_[i] = __builtin_amdgcn_rsqf(rstd_[i] * (1.f / 2048.f) - mean_[i] * mean_[i] + 1e-5f);
#pragma unroll
        for (int ai = 0; ai < 2; ++ai)
#pragma unroll
            for (int m = 0; m < 4; ++m) { const int row = row0 + ai * HALF + m * 16;
                const float mean = mean_[ai * 4 + m], rstd = rstd_[ai * 4 + m];
                const bool prompt = row < ::MP; const int rs = row - ::MP;
#pragma unroll
                for (int bj = 0; bj < 2; ++bj) { const int col = col0 + bj * HALF;
                    f32x4 v0 = (acc[ai][bj][m][0] - cs[bj][0] * mean) * rstd + bb[bj][0], v1 = (acc[ai][bj][m][1] - cs[bj][1] * mean) * rstd + bb[bj][1];
                    if (kind == 0) { v0 = v0 * ::QSCALE; v1 = v1 * ::QSCALE; }
                    if (kind == 3) {
#pragma unroll
                        for (int i = 0; i < 4; ++i) { v0[i] = ::siluf_(v0[i]); v1[i] = ::siluf_(v1[i]); } }
                    u32x4 w; w.x = cvt_pk_bf16(v0[0], v0[1]); w.y = cvt_pk_bf16(v0[2], v0[3]); w.z = cvt_pk_bf16(v1[0], v1[1]); w.w = cvt_pk_bf16(v1[2], v1[3]);
                    if (kind == 0) *(u32x4*)(QB + (size_t)row * ::DM + col) = w;
                    else if (kind == 3) *(u32x4*)(GB + (size_t)row * ::DM + col) = w;
                    else {
                        float* fo = out + (kind == 1 ? (prompt ? ::O7 : ::O9) : (prompt ? ::O8 : ::O10)) + (size_t)(prompt ? row : rs) * ::DM + col;
#if STAGE == 3
                        *(f32x4*)fo = v0 * 3.f; *(f32x4*)(fo + 4) = v1 * 3.f;
#else
                        *(f32x4*)fo = v0; *(f32x4*)(fo + 4) = v1;
#endif
                        if (prompt) *(u32x4*)((kind == 1 ? KBP : VBP) + (size_t)row * ::DM + col) = w; } } }
    }
};
struct EpiZ2 {
    static constexpr bool PERM = false, AFTER_DRAIN = false;
    const float* stats; const bf16_t* Z; const float* g1; const float* b1; bf16_t* z2b;
    __device__ __forceinline__ void operator()(const f32x4 (&acc)[2][2][4][2], const Unit& u, int wr, int wc, int fr, int fq) const {
        const int row0 = u.pm * BM + wr * 64 + fr, col0 = u.pn * BM + wc * 32 + 4 * fq;
        f32x4 gg[2][2], bb[2][2];
#pragma unroll
        for (int bj = 0; bj < 2; ++bj)
#pragma unroll
            for (int n = 0; n < 2; ++n) { gg[bj][n] = *(const f32x4*)(g1 + col0 + bj * HALF + 16 * n); bb[bj][n] = *(const f32x4*)(b1 + col0 + bj * HALF + 16 * n); }
        float mean_[8], rstd_[8];
#pragma unroll
        for (int i = 0; i < 8; ++i) { const int row = row0 + (i >> 2) * HALF + (i & 3) * 16; const f32x2 st = *(const f32x2*)(stats + 2 * row);
            mean_[i] = st[0] * (1.f / 2048.f); rstd_[i] = st[1]; }
#pragma unroll
        for (int i = 0; i < 8; ++i) rstd_[i] = __builtin_amdgcn_rsqf(rstd_[i] * (1.f / 2048.f) - mean_[i] * mean_[i] + 1e-5f);
        u32x2 zn[2][2];
#define EPZ2_LOAD(i_) do { const bf16_t* zr_ = Z + (size_t)(row0 + ((i_) >> 2) * HALF + ((i_) & 3) * 16) * ::DM + col0; \
            _Pragma("unroll") for (int bj = 0; bj < 2; ++bj) _Pragma("unroll") for (int n = 0; n < 2; ++n) zn[bj][n] = *(const u32x2*)(zr_ + bj * HALF + 16 * n); } while (0)
        EPZ2_LOAD(0);
#pragma unroll
        for (int i = 0; i < 8; ++i) { const int ai = i >> 2, m = i & 3; const int row = row0 + ai * HALF + m * 16;
            u32x2 zc[2][2];
#pragma unroll
            for (int bj = 0; bj < 2; ++bj)
#pragma unroll
                for (int n = 0; n < 2; ++n) zc[bj][n] = zn[bj][n];
            if (i + 1 < 8) EPZ2_LOAD(i + 1);
            const float mean = mean_[i], rstd = rstd_[i];
#pragma unroll
            for (int bj = 0; bj < 2; ++bj)
#pragma unroll
                for (int n = 0; n < 2; ++n) { const u32x2 zw = zc[bj][n];
                    f32x4 z; z[0] = ::bflo(zw.x); z[1] = ::bfhi(zw.x); z[2] = ::bflo(zw.y); z[3] = ::bfhi(zw.y);
                    const f32x4 x1 = (z - mean) * rstd * gg[bj][n] + bb[bj][n];
                    const f32x4 z2 = acc[ai][bj][m][n] + x1 * ::ALPHA; u32x2 pw; pw.x = cvt_pk_bf16(z2[0], z2[1]); pw.y = cvt_pk_bf16(z2[2], z2[3]);
                    *(u32x2*)(z2b + (size_t)row * ::DM + col0 + bj * HALF + 16 * n) = pw; } }
#undef EPZ2_LOAD
    }
};
struct SliceOrder {
    int G, c, nN, nS, KS;
    __host__ __device__ void init(int N, int nslices, int kslice, int G_, int c_) { nN = N / BM; nS = nslices; KS = kslice; G = G_; c = c_; }
    __host__ __device__ bool next(int i, Unit& u) const { const int L = i * G + c; if (L >= 2 * nN * nS) return false; const int tile = L / nS; u.ko = (L % nS) * KS; u.pm = 64 + tile / nN; u.pn = tile % nN; return true; }
    __device__ __forceinline__ void a_ready(const Unit&) const {}
    __device__ __forceinline__ void done(const Unit&) const {}
};
struct EpiSlab {
    static constexpr bool PERM = false, AFTER_DRAIN = false;
    float* slab; int N, KS;
    __device__ __forceinline__ void operator()(const f32x4 (&acc)[2][2][4][2], const Unit& u, int wr, int wc, int fr, int fq) const {
        const int row0 = (u.pm - 64) * BM + wr * 64 + fr, col0 = u.pn * BM + wc * 32 + 4 * fq;
        float* base = slab + (size_t)(u.ko / KS) * ::MS * N;
#pragma unroll
        for (int ai = 0; ai < 2; ++ai)
#pragma unroll
            for (int m = 0; m < 4; ++m) { float* rp = base + (size_t)(row0 + ai * HALF + m * 16) * N + col0;
#pragma unroll
                for (int bj = 0; bj < 2; ++bj)
#pragma unroll
                    for (int n = 0; n < 2; ++n) *(f32x4*)(rp + bj * HALF + 16 * n) = acc[ai][bj][m][n]; }
    }
};
}

#define XB_TMO      128
#define XB_XCNT(j)  (256  + 64 * (j))
#define XB_XSUB(j)  (1280 + 64 * (j))
#define XB_XGEN(j)  (2304 + 64 * (j))
#define XB_TOP      3328
#define XB_TOPGEN   3392
#define XCD_BAR_WORDS 3456
#define XB_SPIN_CAP (1u << 22)

__device__ __forceinline__ unsigned xb_ld(unsigned* p)              { return __hip_atomic_load(p, __ATOMIC_RELAXED, __HIP_MEMORY_SCOPE_AGENT); }
__device__ __forceinline__ unsigned xb_add(unsigned* p, unsigned v) { return __hip_atomic_fetch_add(p, v, __ATOMIC_RELAXED, __HIP_MEMORY_SCOPE_AGENT); }
__device__ __forceinline__ unsigned xb_xcc_id() { return (unsigned)__builtin_amdgcn_s_getreg((3 << 11) | 20) & 0xFu; }
#define XB_SPIN(cond, bar) do { unsigned _sp = 0; while (cond) { __builtin_amdgcn_s_sleep(1); \
    if ((++_sp & 255u) == 0u) { if (xb_ld(&(bar)[XB_TMO])) break; if (_sp > XB_SPIN_CAP) { atomicAdd(&(bar)[XB_TMO], 1u); break; } } } } while (0)

struct XcdBarrier {
    unsigned* bar; unsigned x;
    volatile LAS unsigned* st;
};

__device__ __forceinline__ XcdBarrier xcd_barrier_post(unsigned* bar, volatile LAS unsigned* st) {
    XcdBarrier b; b.bar = bar; b.x = xb_xcc_id(); b.st = st;
    if (threadIdx.x == 0) (void)xb_add(&bar[XB_XCNT(b.x)], 1u);
    return b;
}
__device__ __forceinline__ void xcd_barrier_complete(unsigned* bar, unsigned x, unsigned& nloc, unsigned& nx) {
    const unsigned G = gridDim.x * gridDim.y * gridDim.z;
    unsigned sum, cnt, mine, sp = 0u;
    for (;;) {
        sum = 0u; cnt = 0u; mine = 0u;
#pragma unroll
        for (unsigned j = 0; j < 16; ++j) { const unsigned c = xb_ld(&bar[XB_XCNT(j)]); sum += c; cnt += (c > 0u) ? 1u : 0u; mine = (j == x) ? c : mine; }
        if (sum == G) break;
        __builtin_amdgcn_s_sleep(1);
        if ((++sp & 255u) == 0u) { if (xb_ld(&bar[XB_TMO])) break; if (sp > XB_SPIN_CAP) { atomicAdd(&bar[XB_TMO], 1u); break; } }
    }
    nloc = mine > 0u ? mine : 1u; nx = cnt > 0u ? cnt : 1u;
}

__device__ __forceinline__ void xcd_barrier(const XcdBarrier& b) {
    asm volatile("s_waitcnt vmcnt(0)" ::: "memory");
    __syncthreads();
    if (threadIdx.x == 0) {
        unsigned* bar = b.bar;
        __builtin_amdgcn_s_waitcnt(0);
        unsigned nloc = b.st[0], nx = b.st[1];
        if (nloc == 0u) { xcd_barrier_complete(bar, b.x, nloc, nx); b.st[0] = nloc; b.st[1] = nx; }
        const unsigned old = xb_add(&bar[XB_XSUB(b.x)], 1u);
        const unsigned gen = old / nloc;
        if (old + 1u == (gen + 1u) * nloc) {
            __builtin_amdgcn_fence(__ATOMIC_RELEASE, "agent");
            asm volatile("s_waitcnt vmcnt(0)" ::: "memory");
            const unsigned og = xb_add(&bar[XB_TOP], 1u);
            const unsigned tg = og / nx;
            if (og + 1u == (tg + 1u) * nx) xb_add(&bar[XB_TOPGEN], 1u);
            else XB_SPIN(xb_ld(&bar[XB_TOPGEN]) == tg, bar);
            __builtin_amdgcn_fence(__ATOMIC_ACQUIRE, "agent");
            xb_add(&bar[XB_XGEN(b.x)], 1u);
            asm volatile("s_waitcnt vmcnt(0)" ::: "memory");
        } else {
            XB_SPIN(xb_ld(&bar[XB_XGEN(b.x)]) == gen, bar);
            __builtin_amdgcn_fence(__ATOMIC_ACQUIRE, "agent");
            asm volatile("s_waitcnt vmcnt(0)" ::: "memory");
        }
    }
    __syncthreads();
}
struct Args { const float* in[33]; float* out; unsigned char* ws; int ph_lo, ph_hi; };
enum { I_XP = 0, I_XS, I_SHIFT, I_WKV, I_CK, I_CV, I_WIN, I_ALNG, I_ALNB, I_AWS, I_ABS, I_MU, I_W0, I_W2, I_A0, I_A2, I_KK, I_KA, I_RK, I_LNXG, I_LNXB, I_WOUT, I_LNG, I_LNB,
       I_CWIN, I_LQ1, I_LK1, I_LQ2, I_LK2, I_SUBG, I_CWOUT, I_CLNG, I_CLNB };

__device__ __forceinline__ void p0_transpose_item(const float* W, int K, int N, bf16* WT, LAS float* scr, int item, int lane, const float* kscale, const float* kbias, float* colsum, float* bwsum) {
    const int nblk = N / 64, kb = item / nblk, nb = item % nblk, k0 = 64 * kb, n0 = 64 * nb;
    const int r = lane >> 4, c4 = lane & 15;
    f32x4 cs = (f32x4){0.f, 0.f, 0.f, 0.f}, bs = (f32x4){0.f, 0.f, 0.f, 0.f};
    f32x4 v[16];
#pragma unroll
    for (int i = 0; i < 16; ++i) v[i] = *(const f32x4*)(W + (size_t)(k0 + 4 * i + r) * N + n0 + 4 * c4);
#pragma unroll
    for (int i = 0; i < 16; ++i) { const int kk = 4 * i + r; f32x4 x = v[i];
        if (kscale) { bs += x * kbias[k0 + kk]; x = x * kscale[k0 + kk];
#pragma unroll
            for (int q = 0; q < 4; ++q) x[q] = __builtin_bit_cast(float, f2bf(x[q]) << 16);
            cs += x; }
#pragma unroll
        for (int q = 0; q < 4; ++q) scr[kk * 65 + 4 * c4 + q] = x[q]; }
    if (kscale) {
#pragma unroll
        for (int q = 0; q < 4; ++q) { float a = cs[q], b = bs[q]; a += __shfl_xor(a, 16); a += __shfl_xor(a, 32); b += __shfl_xor(b, 16); b += __shfl_xor(b, 32);
            if (lane < 16) { unsafeAtomicAdd(colsum + n0 + 4 * c4 + q, a); unsafeAtomicAdd(bwsum + n0 + 4 * c4 + q, b); } } }
    asm volatile("s_waitcnt lgkmcnt(0)" ::: "memory");
    const int c = lane & 7, nr = lane >> 3;
#pragma unroll
    for (int j = 0; j < 8; ++j) { const int n = nr + 8 * j; const LAS float* s = scr + (8 * c) * 65 + n;
        u32x4 o; o.x = pk2(s[0 * 65], s[1 * 65]); o.y = pk2(s[2 * 65], s[3 * 65]); o.z = pk2(s[4 * 65], s[5 * 65]); o.w = pk2(s[6 * 65], s[7 * 65]);
        *(u32x4*)(WT + (size_t)(n0 + n) * K + k0 + 8 * c) = o; }
    asm volatile("s_waitcnt lgkmcnt(0)" ::: "memory");
}
__device__ __forceinline__ void row_f32_to_bf16(const float* src, bf16* dst, int lane) {
#pragma unroll
    for (int j = 0; j < 8; ++j) { const f32x4 v = ((const f32x4*)src)[lane + 64 * j]; u32x2 o; o.x = pk2(v[0], v[1]); o.y = pk2(v[2], v[3]); ((u32x2*)dst)[lane + 64 * j] = o; }
}
__device__ __forceinline__ void late_transposes(const Args& A, LAS unsigned char* lds, int w, int nw, int wave, int lane, float* colsum, float* bwsum) {
    unsigned char* ws = A.ws; LAS float* scr = (LAS float*)(lds + wave * 16640);
    constexpr int I2 = 32 * 32, I3 = 32 * (PCN / 64), I4 = 32 * 32;
    for (int it = w; it < I2 + I3 + I4; it += nw) {
        if (it < I2) p0_transpose_item(A.in[I_WOUT], DM, DM, (bf16*)(ws + WS_WTOUT), scr, it, lane, nullptr, nullptr, nullptr, nullptr);
        else if (it < I2 + I3) p0_transpose_item(A.in[I_CWIN], DM, PCN, (bf16*)(ws + WS_WTCIN), scr, it - I2, lane, A.in[I_LNG], A.in[I_LNB], colsum, bwsum);
        else p0_transpose_item(A.in[I_CWOUT], DM, DM, (bf16*)(ws + WS_WTCOUT), scr, it - I2 - I3, lane, nullptr, nullptr, nullptr, nullptr); }
}
__device__ __forceinline__ void p0_prologue(const Args& A, LAS unsigned char* lds, int vcu, int G, int wave, int lane, int tid, float* colsum, float* bwsum) {
    unsigned char* ws = A.ws;
    LAS float* scr = (LAS float*)(lds + wave * 16640);
    const int gw = vcu * 8 + wave, NGW = G * 8;
    constexpr int I1 = 32 * (PAB / 64), I2 = 32 * 32, I3 = 32 * (PCN / 64), I4 = 32 * 32;
    for (int it = gw; it < I1; it += NGW) p0_transpose_item(A.in[I_WIN], DM, PAB, (bf16*)(ws + WS_WTIN), scr, it, lane, nullptr, nullptr, nullptr, nullptr);
    { f32x4 nx[8];
#define P0_XROW(m_) ((m_) < MP ? A.in[I_XP] + (size_t)(m_) * DM : A.in[I_XS] + (size_t)((m_) - MP) * DM)
      if (gw < MT) {
#pragma unroll
          for (int j = 0; j < 8; ++j) nx[j] = ((const f32x4*)P0_XROW(gw))[lane + 64 * j]; }
      for (int m = gw; m < MT; m += NGW) { f32x4 cx[8];
#pragma unroll
          for (int j = 0; j < 8; ++j) cx[j] = nx[j];
          if (m + NGW < MT) {
#pragma unroll
              for (int j = 0; j < 8; ++j) nx[j] = ((const f32x4*)P0_XROW(m + NGW))[lane + 64 * j]; }
          bf16* dst = (bf16*)(ws + WS_XB) + (size_t)m * DM;
#pragma unroll
          for (int j = 0; j < 8; ++j) { u32x2 o; o.x = cvt_pk_bf16(cx[j][0], cx[j][1]); o.y = cvt_pk_bf16(cx[j][2], cx[j][3]); ((u32x2*)dst)[lane + 64 * j] = o; } }
#undef P0_XROW
    }
    const int gt = vcu * 512 + tid, NT = G * 512;
    for (int idx = gt; idx < 65536; idx += NT) { const int n = idx >> 6, k = idx & 63;
        ((bf16*)(ws + WS_W2T))[idx] = (bf16)f2bf(A.in[I_W2][k * 1024 + n]); ((bf16*)(ws + WS_A2T))[idx] = (bf16)f2bf(A.in[I_A2][k * 1024 + n]);
        const int t = (idx >> 7) & 127, s = idx & 127; ((bf16*)(ws + WS_WSB))[idx] = (s <= t) ? (bf16)f2bf(A.in[I_AWS][idx]) : (bf16)0; }
    for (int idx = gt; idx < 32768; idx += NT) ((u32x4*)((bf16*)(ws + WS_WTIN) + (size_t)PAB * DM))[idx] = (u32x4){0u, 0u, 0u, 0u};
}
constexpr int VN_ROW = 576, MO_ROW = 1040;
__device__ __forceinline__ s16x4 vtr(const LAS unsigned char* p) { typedef short v4i16_t __attribute__((ext_vector_type(4))); return __builtin_bit_cast(s16x4, __builtin_amdgcn_ds_read_tr16_b64_v4i16((LAS v4i16_t*)p)); }
__device__ __forceinline__ void mixer_a_unit(const Args& A, LAS unsigned char* lds, int ci, int g, int wave, int lane, int tid) {
    const bf16* PROJ = (const bf16*)(A.ws + WS_PROJ);
    bf16* OA = (bf16*)(A.ws + WS_XB);
    const bool prompt = ci < 128; const int m0 = prompt ? ci * 128 : MP + (ci - 128) * 64, L = prompt ? 128 : 64;
    LAS float* st = (LAS float*)lds; LAS unsigned char* vn = lds + 1024;
    for (int i0 = 0; i0 < 16; i0 += 4) { const int tokb = wave * 16 + i0; if (tokb < L) {
        u32x4 ra[4], rb[4];
#pragma unroll
        for (int i = 0; i < 4; ++i) { const bf16* row = PROJ + (size_t)(m0 + tokb + i) * PABP + COL_VA + lane * 16; ra[i] = *(const u32x4*)row; rb[i] = *(const u32x4*)(row + 8); }
#pragma unroll
        for (int i = 0; i < 4; ++i) { float a[8], b[8]; unpack8(ra[i], a); unpack8(rb[i], b); float s = 0.f;
#pragma unroll
            for (int j = 0; j < 8; ++j) s += a[j] + b[j];
            const float mean = wave_sum(s) * (1.f / 1024.f); float q = 0.f;
#pragma unroll
            for (int j = 0; j < 8; ++j) { const float d0 = a[j] - mean, d1 = b[j] - mean; q += d0 * d0 + d1 * d1; }
            const float rstd = 1.0f / sqrtf(wave_sum(q) * (1.f / 1024.f) + 1e-5f);
            if (lane == 0) { st[2 * (tokb + i)] = mean; st[2 * (tokb + i) + 1] = rstd; } } } }
    __syncthreads();
    { const int s = tid & 127, og = tid >> 7;
      if (s < L) { const float mean = st[2 * s], rstd = st[2 * s + 1];
        u32x4 xr[8];
#pragma unroll
        for (int it = 0; it < 8; ++it) xr[it] = *(const u32x4*)(PROJ + (size_t)(m0 + s) * PABP + COL_VA + g * 256 + (it * 4 + og) * 8);
#pragma unroll
        for (int it = 0; it < 8; ++it) { const int oct = it * 4 + og, c0 = g * 256 + oct * 8;
            float x[8]; unpack8(xr[it], x);
            const f32x4 g0 = *(const f32x4*)(A.in[I_ALNG] + c0), g1 = *(const f32x4*)(A.in[I_ALNG] + c0 + 4), b0 = *(const f32x4*)(A.in[I_ALNB] + c0), b1 = *(const f32x4*)(A.in[I_ALNB] + c0 + 4);
            float v[8];
#pragma unroll
            for (int j = 0; j < 4; ++j) { v[j] = (x[j] - mean) * rstd * g0[j] + b0[j]; v[4 + j] = (x[4 + j] - mean) * rstd * g1[j] + b1[j]; }
            if (!prompt) { float* o = A.out + O6 + (size_t)((ci - 128) * 64 + s) * 1024 + c0;
                *(f32x4*)o = (f32x4){v[0], v[1], v[2], v[3]}; *(f32x4*)(o + 4) = (f32x4){v[4], v[5], v[6], v[7]}; }
            u32x4 w; w.x = pk2(v[0], v[1]); w.y = pk2(v[2], v[3]); w.z = pk2(v[4], v[5]); w.w = pk2(v[6], v[7]);
            *(LAS u32x4*)(vn + s * VN_ROW + oct * 16) = w; } } }
    __syncthreads();
    const int ti = wave & 3, ch = wave >> 2, r32 = lane & 31, hi = lane >> 5;
    const bool active = ti * 32 < L;
    f32x16 acc[4];
#pragma unroll
    for (int c = 0; c < 4; ++c) acc[c] = (f32x16){0.f};
    if (active) {
        const bf16* Wg = (const bf16*)(A.ws + WS_WSB) + g * 16384 + (32 * ti + r32) * 128 + 4 * hi;
        const LAS unsigned char* vb = vn + (4 * hi + ((lane & 15) >> 2)) * VN_ROW + (ch * 128 + ((lane >> 4) & 1) * 16 + (lane & 3) * 4) * 2;
        for (int ks = 0; ks <= 2 * ti + 1; ++ks) {
            const u32x2 w0 = *(const u32x2*)(Wg + 16 * ks), w1 = *(const u32x2*)(Wg + 16 * ks + 8);
            const bf16x8 af = __builtin_bit_cast(bf16x8, (u32x4){w0.x, w0.y, w1.x, w1.y});
#pragma unroll
            for (int c = 0; c < 4; ++c) { const s16x4 lo = vtr(vb + (16 * ks) * VN_ROW + c * 64), hh = vtr(vb + (16 * ks + 8) * VN_ROW + c * 64);
                const bf16x8 bfr = (bf16x8){lo[0], lo[1], lo[2], lo[3], hh[0], hh[1], hh[2], hh[3]};
                acc[c] = __builtin_amdgcn_mfma_f32_32x32x16_bf16(af, bfr, acc[c], 0, 0, 0); } }
    }
    __syncthreads();
    if (active) {
        LAS unsigned char* ob = vn;
#pragma unroll
        for (int reg = 0; reg < 16; ++reg) { const int t = 32 * ti + (reg & 3) + 8 * (reg >> 2) + 4 * hi;
#pragma unroll
            for (int c = 0; c < 4; ++c) *(LAS float*)(ob + t * MO_ROW + (32 * (ch * 4 + c) + r32) * 4) = acc[c][reg]; }
    }
    __syncthreads();
    for (int it = 0; it < 8; ++it) { const int item = tid + 512 * it, t = item >> 5, oc = item & 31;
        if (t < L) { const size_t m = (size_t)(m0 + t); const int col = g * 256 + oc * 8;
            const f32x4 o0 = *(const LAS f32x4*)(vn + t * MO_ROW + oc * 32), o1 = *(const LAS f32x4*)(vn + t * MO_ROW + oc * 32 + 16);
            float u[8], ga[8]; unpack8(*(const u32x4*)(PROJ + m * PABP + col), u); unpack8(*(const u32x4*)(PROJ + m * PABP + COL_GA + col), ga);
            const float bias = A.in[I_ABS][g * 128 + t]; float r[8];
#pragma unroll
            for (int j = 0; j < 4; ++j) { r[j] = u[j] * (o0[j] + bias) * siluf_(ga[j]); r[4 + j] = u[4 + j] * (o1[j] + bias) * siluf_(ga[4 + j]); }
            u32x4 w; w.x = pk2(r[0], r[1]); w.y = pk2(r[2], r[3]); w.z = pk2(r[4], r[5]); w.w = pk2(r[6], r[7]);
            *(u32x4*)(OA + m * DM + col) = w; } }
    __syncthreads();
}
constexpr int SCAN_TS = 32, SCAN_BUF = 45184, SCAN_SCR = 2 * SCAN_BUF, SCAN_SCRW = 6400;
__device__ __forceinline__ float dpp_add16(float x) {
    x += __builtin_bit_cast(float, __builtin_amdgcn_update_dpp(0, __builtin_bit_cast(int, x), 0xB1, 0xF, 0xF, true));
    x += __builtin_bit_cast(float, __builtin_amdgcn_update_dpp(0, __builtin_bit_cast(int, x), 0x4E, 0xF, 0xF, true));
    x += __builtin_bit_cast(float, __builtin_amdgcn_update_dpp(0, __builtin_bit_cast(int, x), 0x124, 0xF, 0xF, true));
    x += __builtin_bit_cast(float, __builtin_amdgcn_update_dpp(0, __builtin_bit_cast(int, x), 0x128, 0xF, 0xF, true));
    return x;
}
struct PrepRegs { u32x4 cur[5], prv[5]; };
struct ScanCtx { const bf16* rowbase; const float* shift; float* bon; int T; int hd; int qr; };
__device__ __forceinline__ void prep_load(PrepRegs& R, const ScanCtx& C, int t, int oc) {
    const bf16* cur = C.rowbase + (size_t)t * PABP;
    const int o0 = C.hd * 64 + oc * 8;
    R.cur[0] = *(const u32x4*)(cur + o0); R.cur[1] = *(const u32x4*)(cur + 1024 + o0); R.cur[2] = *(const u32x4*)(cur + 2048 + o0);
    R.cur[3] = *(const u32x4*)(cur + 3072 + oc * 8); R.cur[4] = *(const u32x4*)(cur + 3136 + oc * 8);
    if (t > 0) { const bf16* p = cur - PABP;
        R.prv[0] = *(const u32x4*)(p + o0); R.prv[1] = *(const u32x4*)(p + 1024 + o0); R.prv[2] = *(const u32x4*)(p + 2048 + o0);
        R.prv[3] = *(const u32x4*)(p + 3072 + oc * 8); R.prv[4] = *(const u32x4*)(p + 3136 + oc * 8); }
}
__device__ __forceinline__ void lerp8(const u32x4 cur, const u32x4 prv, bool first, const float* shift, const f32x4 m0, const f32x4 m1, float (&o)[8]) {
    float c[8], p[8]; unpack8(cur, c);
    if (!first) unpack8(prv, p);
    else if (shift) { const f32x4 a = *(const f32x4*)shift, b = *(const f32x4*)(shift + 4);
#pragma unroll
        for (int j = 0; j < 4; ++j) { p[j] = a[j]; p[4 + j] = b[j]; } }
    else {
#pragma unroll
        for (int j = 0; j < 8; ++j) p[j] = 0.f; }
#pragma unroll
    for (int j = 0; j < 4; ++j) { o[j] = c[j] + (p[j] - c[j]) * m0[j]; o[4 + j] = c[4 + j] + (p[4 + j] - c[4 + j]) * m1[j]; }
}
constexpr int CH_T = 32;
#ifndef S1_X2
#define S1_X2 1
#endif
#ifndef S1_PF
#define S1_PF 1
#endif
constexpr size_t WS_CHGC = 217 * MiB, WS_CHMCT = 220 * MiB, WS_CHNN = 286 * MiB, WS_CHQ1 = 352 * MiB, WS_CHQ2 = 385 * MiB;
constexpr int S1_TOT = 20992, S1_HALF0 = 23040, S1_HSZ = 59392;
constexpr int S1_KKP = 0, S1_RP = 4608, S1_BM = 9216, S1_KM = 13824, S1_VT = 18432, S1_BST = 23552, S1_KST = 28672, S1_R2 = 33792;
constexpr int S1_U = S1_BM;
constexpr int S1_AAB = S1_R2, S1_AKK = S1_R2 + 4608, S1_ARB = S1_AKK + 2560, S1_ARK = S1_ARB + 2560, S1_P1T = S1_ARK + 2560, S1_P2T = S1_P1T + 5120;
__device__ __forceinline__ f32x16 mm32(const LAS unsigned char* a, int astride, const LAS unsigned char* b, int bstride, int ksteps, int r32, int hi, f32x16 acc) {
    for (int ks = 0; ks < ksteps; ++ks) acc = __builtin_amdgcn_mfma_f32_32x32x16_bf16(*(const LAS bf16x8*)(a + r32 * astride + (16 * ks + 8 * hi) * 2), *(const LAS bf16x8*)(b + r32 * bstride + (16 * ks + 8 * hi) * 2), acc, 0, 0, 0);
    return acc;
}
__device__ __forceinline__ void s1_subst(LAS unsigned char* H, int lane, int SRC) {
    f32x2 z[16];
    if (SRC == 0) {
#pragma unroll
        for (int tt = 0; tt < 32; ++tt) z[tt >> 1][tt & 1] = bf1(*(const LAS bf16*)(H + S1_KKP + tt * 144 + lane * 2)); }
    else {
#pragma unroll
        for (int tt = 0; tt < 32; ++tt) z[tt >> 1][tt & 1] = *(const LAS float*)(H + S1_U + tt * 272 + lane * 4); }
#pragma unroll
    for (int j = 0; j < 31; ++j) {
        const float zj = z[j >> 1][j & 1]; const f32x2 zz = (f32x2){zj, zj};
        int dep = 0; if (j >= 1) asm volatile("" : "+v"(dep) : "v"(z[(j - 1) >> 1][(j - 1) & 1]));
#pragma unroll
        for (int i4 = (j + 1) >> 2; i4 < 8; ++i4) { const f32x4 a4 = *(const LAS f32x4*)(H + S1_AAB + j * 144 + i4 * 16 + dep);
#pragma unroll
            for (int h = 0; h < 2; ++h) { const int p = 2 * i4 + h, r0 = 2 * p;
                if (r0 > j) z[p] -= (f32x2){a4[2 * h], a4[2 * h + 1]} * zz;
                else if (r0 + 1 > j) z[p][1] -= a4[2 * h + 1] * zj; } }
    }
    LAS unsigned char* dst = H + (SRC == 0 ? S1_P1T : S1_P2T) + lane * 80;
#pragma unroll
    for (int q = 0; q < 4; ++q) *(LAS u32x4*)(dst + q * 16) = (u32x4){cvt_pk_bf16(z[4 * q][0], z[4 * q][1]), cvt_pk_bf16(z[4 * q + 1][0], z[4 * q + 1][1]), cvt_pk_bf16(z[4 * q + 2][0], z[4 * q + 2][1]), cvt_pk_bf16(z[4 * q + 3][0], z[4 * q + 3][1])};
}
__device__ __forceinline__ void s1_consts(const Args& A, LAS unsigned char* lds, int hd, int tid) {
    const int n = tid >> 3, chk = tid & 7;
    *(LAS u32x4*)(lds + n * 144 + chk * 16) = *(const u32x4*)((const bf16*)(A.ws + WS_W2T) + (size_t)(hd * 64 + n) * 64 + chk * 8);
    *(LAS u32x4*)(lds + 9216 + n * 144 + chk * 16) = *(const u32x4*)((const bf16*)(A.ws + WS_A2T) + (size_t)(hd * 64 + n) * 64 + chk * 8);
    for (int i = tid; i < 640; i += 512) { const int which = i >> 6, chn = i & 63; float v;
        if (which < 3) v = A.in[I_MU][which * 1024 + hd * 64 + chn]; else if (which == 3) v = A.in[I_MU][3072 + chn]; else if (which == 4) v = A.in[I_MU][3136 + chn];
        else v = A.in[which == 5 ? I_KK : which == 6 ? I_KA : which == 7 ? I_RK : which == 8 ? I_W0 : I_A0][hd * 64 + chn];
        ((LAS float*)(lds + 18432))[i] = v; }
}
__device__ __forceinline__ void s1_unit(const Args& A, LAS unsigned char* lds, int seq, int hd, int cpair, PrepRegs& R, bool preloaded, bool more, int wave, int lane, int tid
#ifdef S1_SEC
    , unsigned long long (&s1ts)[8], unsigned long long& s1tl
#endif
    ) {
    const bool prompt = seq < NBP; const int bs = prompt ? seq : seq - NBP;
    const int mbase = prompt ? bs * SEQ : MP + bs * DSQ, nchunk = prompt ? SEQ / CH_T : DSQ / CH_T;
    const int half = wave >> 2, hw = wave & 3, chunk = 2 * cpair + half, t0 = chunk * CH_T;
    const size_t cid = (prompt ? (size_t)(bs * 16 + hd) * (SEQ / CH_T) : (size_t)NBP * 16 * (SEQ / CH_T) + (size_t)(bs * 16 + hd) * (DSQ / CH_T)) + chunk;
    ScanCtx C; C.rowbase = (const bf16*)(A.ws + WS_PROJ) + (size_t)mbase * PABP + COL_HB; C.shift = prompt ? nullptr : A.in[I_SHIFT] + (size_t)bs * DSH; C.T = nchunk * CH_T; C.hd = hd; C.qr = 0;
    C.bon = (float*)(A.ws + WS_SCANIN) + (size_t)mbase * 16 + hd;
    const LAS unsigned char* cst = lds; LAS unsigned char* H = lds + S1_HALF0 + half * S1_HSZ;
    const int r32 = lane & 31, hi = lane >> 5;
    const int tl8 = lane >> 3, oc = lane & 7, tl = hw * 8 + tl8, t = t0 + tl, c0 = hd * 64 + oc * 8;
    if (!preloaded) prep_load(R, C, t, oc);
    const LAS float* cf = (const LAS float*)(cst + 18432); const bool first = (t == 0);
#define CF8(w) *(const LAS f32x4*)(cf + (w) * 64 + oc * 8), *(const LAS f32x4*)(cf + (w) * 64 + oc * 8 + 4)
    float hr[8], hk[8], hv[8], hwl[8], ha[8];
    lerp8(R.cur[0], R.prv[0], first, C.shift ? C.shift + c0 : nullptr, CF8(0), hr);
    lerp8(R.cur[1], R.prv[1], first, C.shift ? C.shift + 1024 + c0 : nullptr, CF8(1), hk);
    lerp8(R.cur[2], R.prv[2], first, C.shift ? C.shift + 2048 + c0 : nullptr, CF8(2), hv);
    lerp8(R.cur[3], R.prv[3], first, C.shift ? C.shift + 3072 + oc * 8 : nullptr, CF8(3), hwl);
    lerp8(R.cur[4], R.prv[4], first, C.shift ? C.shift + 3136 + oc * 8 : nullptr, CF8(4), ha);
    LAS unsigned char* scr = H + S1_R2 + hw * 6400;
    LAS unsigned char* wl = scr, * al = scr + 1152; LAS float* ea = (LAS float*)(scr + 2304);
    { u32x4 w;
#pragma unroll
      for (int j = 0; j < 8; ++j) hwl[j] = 1.f - 2.f * __builtin_amdgcn_rcpf(__expf(2.f * hwl[j]) + 1.f);
      w.x = cvt_pk_bf16(hwl[0], hwl[1]); w.y = cvt_pk_bf16(hwl[2], hwl[3]); w.z = cvt_pk_bf16(hwl[4], hwl[5]); w.w = cvt_pk_bf16(hwl[6], hwl[7]); *(LAS u32x4*)(wl + tl8 * 144 + oc * 16) = w;
      w.x = cvt_pk_bf16(ha[0], ha[1]); w.y = cvt_pk_bf16(ha[2], ha[3]); w.z = cvt_pk_bf16(ha[4], ha[5]); w.w = cvt_pk_bf16(ha[6], ha[7]); *(LAS u32x4*)(al + tl8 * 144 + oc * 16) = w; }
    { const int row = lane & 15, kg = lane >> 4; typedef float f32x4_t __attribute__((ext_vector_type(4)));
      const LAS unsigned char* w2t = cst + row * 144 + 16 * kg; const LAS unsigned char* a2t = cst + 9216 + row * 144 + 16 * kg;
      const bf16x8 aw0 = *(const LAS bf16x8*)(wl + (row & 7) * 144 + (8 * kg) * 2), aw1 = *(const LAS bf16x8*)(wl + (row & 7) * 144 + (32 + 8 * kg) * 2);
      const bf16x8 aa0 = *(const LAS bf16x8*)(al + (row & 7) * 144 + (8 * kg) * 2), aa1 = *(const LAS bf16x8*)(al + (row & 7) * 144 + (32 + 8 * kg) * 2);
#pragma unroll
      for (int nb = 0; nb < 4; ++nb) { f32x4_t dw = (f32x4_t){0.f, 0.f, 0.f, 0.f}, da = (f32x4_t){0.f, 0.f, 0.f, 0.f};
          dw = __builtin_amdgcn_mfma_f32_16x16x32_bf16(aw0, *(const LAS bf16x8*)(w2t + nb * 2304), dw, 0, 0, 0); dw = __builtin_amdgcn_mfma_f32_16x16x32_bf16(aw1, *(const LAS bf16x8*)(w2t + nb * 2304 + 64), dw, 0, 0, 0);
          da = __builtin_amdgcn_mfma_f32_16x16x32_bf16(aa0, *(const LAS bf16x8*)(a2t + nb * 2304), da, 0, 0, 0); da = __builtin_amdgcn_mfma_f32_16x16x32_bf16(aa1, *(const LAS bf16x8*)(a2t + nb * 2304 + 64), da, 0, 0, 0);
          if (lane < 32) { const int n = nb * 16 + row;
#pragma unroll
              for (int r = 0; r < 4; ++r) { const int tok = 4 * kg + r; ea[(tok * 2 + 0) * 64 + n] = dw[r]; ea[(tok * 2 + 1) * 64 + n] = da[r]; } } } }
    float ev[8], av[8];
    { const f32x4 e0 = *(const LAS f32x4*)(ea + (tl8 * 2 + 0) * 64 + oc * 8), e1 = *(const LAS f32x4*)(ea + (tl8 * 2 + 0) * 64 + oc * 8 + 4);
      const f32x4 a0 = *(const LAS f32x4*)(ea + (tl8 * 2 + 1) * 64 + oc * 8), a1 = *(const LAS f32x4*)(ea + (tl8 * 2 + 1) * 64 + oc * 8 + 4);
      const f32x4 w00 = *(const LAS f32x4*)(cf + 512 + oc * 8), w01 = *(const LAS f32x4*)(cf + 512 + oc * 8 + 4), a00 = *(const LAS f32x4*)(cf + 576 + oc * 8), a01 = *(const LAS f32x4*)(cf + 576 + oc * 8 + 4);
#pragma unroll
      for (int j = 0; j < 4; ++j) { ev[j] = 0.60653065971f * sigmoidf_(e0[j] + w00[j]); ev[4 + j] = 0.60653065971f * sigmoidf_(e1[j] + w01[j]); av[j] = sigmoidf_(a0[j] + a00[j]); av[4 + j] = sigmoidf_(a1[j] + a01[j]); } }
    const f32x4 kks0 = *(const LAS f32x4*)(cf + 320 + oc * 8), kks1 = *(const LAS f32x4*)(cf + 320 + oc * 8 + 4), ka0 = *(const LAS f32x4*)(cf + 384 + oc * 8), ka1 = *(const LAS f32x4*)(cf + 384 + oc * 8 + 4);
    const f32x4 rk0 = *(const LAS f32x4*)(cf + 448 + oc * 8), rk1 = *(const LAS f32x4*)(cf + 448 + oc * 8 + 4);
#undef CF8
    float kkv[8], km[8], bb[8], ssq = 0.f, bon = 0.f, Lc[8];
#pragma unroll
    for (int j = 0; j < 8; ++j) { const float kks = j < 4 ? kks0[j & 3] : kks1[j & 3], ka = j < 4 ? ka0[j & 3] : ka1[j & 3], rk = j < 4 ? rk0[j & 3] : rk1[j & 3];
        kkv[j] = hk[j] * kks; ssq += kkv[j] * kkv[j]; km[j] = hk[j] * (1.f + (av[j] - 1.f) * ka); bon += hr[j] * km[j] * rk; }
    ssq += __shfl_xor(ssq, 1); ssq += __shfl_xor(ssq, 2); ssq += __shfl_xor(ssq, 4);
    bon += __shfl_xor(bon, 1); bon += __shfl_xor(bon, 2); bon += __shfl_xor(bon, 4);
    if (oc == 0) C.bon[(size_t)t * 16] = bon;
    const float inv = 1.0f / fmaxf(sqrtf(ssq), 1e-12f);
#pragma unroll
    for (int j = 0; j < 8; ++j) { kkv[j] *= inv; bb[j] = kkv[j] * av[j];
        float s = -ev[j]; float u;
        u = __shfl_up(s, 8); if (tl8 >= 1) s += u;
        u = __shfl_up(s, 16); if (tl8 >= 2) s += u;
        u = __shfl_up(s, 32); if (tl8 >= 4) s += u;
        Lc[j] = s; }
    LAS float* tot = (LAS float*)(lds + S1_TOT) + half * 256;
    if (tl8 == 7) { *(LAS f32x4*)(tot + hw * 64 + oc * 8) = (f32x4){Lc[0], Lc[1], Lc[2], Lc[3]}; *(LAS f32x4*)(tot + hw * 64 + oc * 8 + 4) = (f32x4){Lc[4], Lc[5], Lc[6], Lc[7]}; }
    __syncthreads();
#ifdef S1_SEC
    { const unsigned long long t_ = __builtin_amdgcn_s_memrealtime(); s1ts[0] += t_ - s1tl; s1tl = t_; }
#endif
    float LC[8];
    { float pre[8];
#pragma unroll
      for (int j = 0; j < 8; ++j) { pre[j] = 0.f; LC[j] = 0.f; }
#pragma unroll
      for (int w2 = 0; w2 < 4; ++w2) { const f32x4 x0 = *(const LAS f32x4*)(tot + w2 * 64 + oc * 8), x1 = *(const LAS f32x4*)(tot + w2 * 64 + oc * 8 + 4);
#pragma unroll
          for (int j = 0; j < 4; ++j) { LC[j] += x0[j]; LC[4 + j] += x1[j]; if (w2 < hw) { pre[j] += x0[j]; pre[4 + j] += x1[j]; } } }
#pragma unroll
      for (int j = 0; j < 8; ++j) Lc[j] += pre[j]; }
    { float kkp[8], rp[8], bm[8], kmm[8], bsv[8], ksv[8];
#pragma unroll
      for (int j = 0; j < 8; ++j) { const float g = __expf(Lc[j]), ig = __builtin_amdgcn_rcpf(g), gp = g * __expf(ev[j]), gr = __expf(LC[j]) * ig;
          kkp[j] = kkv[j] * gp; rp[j] = hr[j] * g; bm[j] = bb[j] * ig; kmm[j] = km[j] * ig; bsv[j] = bb[j] * gr; ksv[j] = km[j] * gr; }
      *(LAS u32x4*)(H + S1_KKP + tl * 144 + oc * 16) = (u32x4){cvt_pk_bf16(kkp[0], kkp[1]), cvt_pk_bf16(kkp[2], kkp[3]), cvt_pk_bf16(kkp[4], kkp[5]), cvt_pk_bf16(kkp[6], kkp[7])};
      *(LAS u32x4*)(H + S1_RP + tl * 144 + oc * 16) = (u32x4){cvt_pk_bf16(rp[0], rp[1]), cvt_pk_bf16(rp[2], rp[3]), cvt_pk_bf16(rp[4], rp[5]), cvt_pk_bf16(rp[6], rp[7])};
      *(LAS u32x4*)(H + S1_BM + tl * 144 + oc * 16) = (u32x4){cvt_pk_bf16(bm[0], bm[1]), cvt_pk_bf16(bm[2], bm[3]), cvt_pk_bf16(bm[4], bm[5]), cvt_pk_bf16(bm[6], bm[7])};
      *(LAS u32x4*)(H + S1_KM + tl * 144 + oc * 16) = (u32x4){cvt_pk_bf16(kmm[0], kmm[1]), cvt_pk_bf16(kmm[2], kmm[3]), cvt_pk_bf16(kmm[4], kmm[5]), cvt_pk_bf16(kmm[6], kmm[7])};
#pragma unroll
      for (int j = 0; j < 8; ++j) { const int ch = oc * 8 + j;
          *(LAS bf16*)(H + S1_VT + ch * 80 + tl * 2) = (bf16)f2bf(hv[j]); *(LAS bf16*)(H + S1_BST + ch * 80 + tl * 2) = (bf16)f2bf(bsv[j]); *(LAS bf16*)(H + S1_KST + ch * 80 + tl * 2) = (bf16)f2bf(ksv[j]); }
      if (tl == CH_T - 1) { float* gc = (float*)(A.ws + WS_CHGC) + cid * 64 + oc * 8;
          *(f32x4*)gc = (f32x4){__expf(LC[0]), __expf(LC[1]), __expf(LC[2]), __expf(LC[3])}; *(f32x4*)(gc + 4) = (f32x4){__expf(LC[4]), __expf(LC[5]), __expf(LC[6]), __expf(LC[7])}; } }
    if (more) prep_load(R, C, t + 2 * CH_T, oc);
    __syncthreads();
#ifdef S1_SEC
    { const unsigned long long t_ = __builtin_amdgcn_s_memrealtime(); s1ts[1] += t_ - s1tl; s1tl = t_; }
#endif
    { f32x16 acc = (f32x16){0.f};
      acc = mm32(H + ((hw & 2) ? S1_RP : S1_KKP), 144, H + ((hw & 1) ? S1_KM : S1_BM), 144, 4, r32, hi, acc);
      const bool strict = hw < 2;
#pragma unroll
      for (int r = 0; r < 16; ++r) { const int tt = (r & 3) + 8 * (r >> 2) + 4 * hi; acc[r] = (r32 < tt + (strict ? 0 : 1)) ? acc[r] : 0.f; }
      if (hw == 0) {
#pragma unroll
          for (int g = 0; g < 4; ++g) *(LAS f32x4*)(H + S1_AAB + r32 * 144 + (8 * g + 4 * hi) * 4) = (f32x4){acc[4 * g], acc[4 * g + 1], acc[4 * g + 2], acc[4 * g + 3]}; }
      else {
#pragma unroll
          for (int r = 0; r < 16; ++r) { const int tt = (r & 3) + 8 * (r >> 2) + 4 * hi; *(LAS bf16*)(H + (hw == 1 ? S1_AKK : hw == 2 ? S1_ARB : S1_ARK) + tt * 80 + r32 * 2) = (bf16)f2bf(acc[r]); } } }
    __syncthreads();
#ifdef S1_SEC
    { const unsigned long long t_ = __builtin_amdgcn_s_memrealtime(); s1ts[2] += t_ - s1tl; s1tl = t_; }
#endif
    if (hw < 2) { f32x16 acc = (f32x16){0.f};
      acc = mm32(H + S1_AKK, 80, H + S1_VT + hw * 32 * 80, 80, 2, r32, hi, acc);
#pragma unroll
      for (int r = 0; r < 16; ++r) { const int tt = (r & 3) + 8 * (r >> 2) + 4 * hi; *(LAS float*)(H + S1_U + tt * 272 + (hw * 32 + r32) * 4) = acc[r]; } }
    __syncthreads();
#ifdef S1_SEC
    { const unsigned long long t_ = __builtin_amdgcn_s_memrealtime(); s1ts[3] += t_ - s1tl; s1tl = t_; }
#endif
#if defined(S1_CUT) && S1_CUT == 2
    return;
#endif
    if (hw < 2) s1_subst(H, lane, hw);
    __syncthreads();
#ifdef S1_SEC
    { const unsigned long long t_ = __builtin_amdgcn_s_memrealtime(); s1ts[4] += t_ - s1tl; s1tl = t_; }
#endif
#if defined(S1_CUT) && S1_CUT == 3
    return;
#endif
    { const int mb = hw >> 1, nb = hw & 1;
      { f32x16 acc = (f32x16){0.f};
        acc = mm32(H + S1_BST + mb * 32 * 80, 80, H + S1_P1T + nb * 32 * 80, 80, 2, r32, hi, acc);
        bf16* o = (bf16*)(A.ws + WS_CHMCT) + cid * 4096;
#pragma unroll
        for (int r = 0; r < 16; ++r) o[(mb * 32 + (r & 3) + 8 * (r >> 2) + 4 * hi) * 64 + nb * 32 + r32] = (bf16)f2bf(acc[r]); }
      { f32x16 acc = (f32x16){0.f}, acc2 = (f32x16){0.f};
        acc = mm32(H + S1_VT + mb * 32 * 80, 80, H + S1_KST + nb * 32 * 80, 80, 2, r32, hi, acc);
        acc2 = mm32(H + S1_P2T + mb * 32 * 80, 80, H + S1_BST + nb * 32 * 80, 80, 2, r32, hi, acc2);
        u32x4* o = (u32x4*)((bf16*)(A.ws + WS_CHNN) + cid * 4096 + (size_t)((mb * 2 + nb) * 64 + lane) * 16);
        o[0] = (u32x4){cvt_pk_bf16(acc[0] - acc2[0], acc[1] - acc2[1]), cvt_pk_bf16(acc[2] - acc2[2], acc[3] - acc2[3]), cvt_pk_bf16(acc[4] - acc2[4], acc[5] - acc2[5]), cvt_pk_bf16(acc[6] - acc2[6], acc[7] - acc2[7])};
        o[1] = (u32x4){cvt_pk_bf16(acc[8] - acc2[8], acc[9] - acc2[9]), cvt_pk_bf16(acc[10] - acc2[10], acc[11] - acc2[11]), cvt_pk_bf16(acc[12] - acc2[12], acc[13] - acc2[13]), cvt_pk_bf16(acc[14] - acc2[14], acc[15] - acc2[15])}; }
      if (hw < 2) { f32x16 acc = (f32x16){0.f};
        acc = mm32(H + S1_ARB, 80, H + S1_P1T + hw * 32 * 80, 80, 2, r32, hi, acc);
        bf16* o = (bf16*)(A.ws + WS_CHQ1) + cid * 2048;
#pragma unroll
        for (int r = 0; r < 16; ++r) { const int tt = (r & 3) + 8 * (r >> 2) + 4 * hi; o[tt * 64 + hw * 32 + r32] = (bf16)f2bf(bf1(*(const LAS bf16*)(H + S1_RP + tt * 144 + (hw * 32 + r32) * 2)) - acc[r]); } }
      else { const int vb = hw - 2; f32x16 acc = (f32x16){0.f}, acc2 = (f32x16){0.f};
        acc = mm32(H + S1_ARK, 80, H + S1_VT + vb * 32 * 80, 80, 2, r32, hi, acc);
        acc2 = mm32(H + S1_ARB, 80, H + S1_P2T + vb * 32 * 80, 80, 2, r32, hi, acc2);
        f32x4* o = (f32x4*)((float*)(A.ws + WS_CHQ2) + cid * 2048 + (size_t)(vb * 64 + lane) * 16);
#pragma unroll
        for (int q = 0; q < 4; ++q) o[q] = (f32x4){acc[4 * q] - acc2[4 * q], acc[4 * q + 1] - acc2[4 * q + 1], acc[4 * q + 2] - acc2[4 * q + 2], acc[4 * q + 3] - acc2[4 * q + 3]}; } }
    __syncthreads();
#ifdef S1_SEC
    { const unsigned long long t_ = __builtin_amdgcn_s_memrealtime(); s1ts[5] += t_ - s1tl; s1tl = t_; }
#endif
}
__device__ __forceinline__ void s2_put(const f32x16& S, LAS unsigned char* buf, int vb, int kb, int r32, int hi) {
#pragma unroll
    for (int r = 0; r < 16; r += 2) { const unsigned ph = cvt_pk_bf16(S[r], S[r + 1]);
        const float r0 = S[r] - __builtin_bit_cast(float, ph << 16), r1 = S[r + 1] - __builtin_bit_cast(float, ph & 0xffff0000u);
        const unsigned pl = cvt_pk_bf16(r0, r1);
        const int v0 = vb * 32 + (r & 3) + 8 * (r >> 2) + 4 * hi; LAS unsigned char* p = buf + v0 * 144 + (kb * 32 + r32) * 2;
        *(LAS bf16*)p = (bf16)(ph & 0xffffu); *(LAS bf16*)(p + 144) = (bf16)(ph >> 16); *(LAS bf16*)(p + 9216) = (bf16)(pl & 0xffffu); *(LAS bf16*)(p + 9216 + 144) = (bf16)(pl >> 16); }
}
constexpr int S2_BUF = 18432;
typedef __attribute__((address_space(1))) float gfloat_t;
__device__ __forceinline__ void s2_unit(const Args& A, LAS unsigned char* lds, int seq, int hd, int wave, int lane) {
    const bool prompt = seq < NBP; const int bs = prompt ? seq : seq - NBP;
    const int mbase = prompt ? bs * SEQ : MP + bs * DSQ, nchunk = prompt ? SEQ / CH_T : DSQ / CH_T;
    const size_t cid0 = prompt ? (size_t)(bs * 16 + hd) * (SEQ / CH_T) : (size_t)NBP * 16 * (SEQ / CH_T) + (size_t)(bs * 16 + hd) * (DSQ / CH_T);
    const int r32 = lane & 31, hi = lane >> 5;
    const int vb = wave >> 1, kb = wave & 1;
    f32x16 S = (f32x16){0.f};
    if (wave < 4) {
        if (!prompt) {
#pragma unroll
            for (int r = 0; r < 16; ++r) S[r] = A.in[I_WKV][((size_t)(bs * 16 + hd) * 64 + vb * 32 + (r & 3) + 8 * (r >> 2) + 4 * hi) * 64 + kb * 32 + r32]; }
        s2_put(S, lds, vb, kb, r32, hi);
    }
    __syncthreads();
#define S2_BAR() do { asm volatile("s_waitcnt lgkmcnt(0)" ::: "memory"); __builtin_amdgcn_s_barrier(); } while (0)
    struct S2Ops { bf16x8 fr[4]; float gc; float blk[16]; u32x4 nb0, nb1; };
#ifdef S2_AMP
    const unsigned long long tamp0 = __builtin_amdgcn_s_memrealtime();
#endif
#ifdef S2_SEC
    unsigned long long tsec[5] = {0, 0, 0, 0, 0}; unsigned long long tlast = __builtin_amdgcn_s_memrealtime();
#endif
    if (wave < 4) {
#define S2_LOAD(O_, n_) do { const size_t cid_ = cid0 + (n_); const bf16* mct = (const bf16*)(A.ws + WS_CHMCT) + cid_ * 4096 + (size_t)(kb * 32 + r32) * 64 + 8 * hi; \
            _Pragma("unroll") for (int ks = 0; ks < 4; ++ks) O_.fr[ks] = *(const bf16x8*)(mct + 16 * ks); \
            O_.gc = ((const float*)(A.ws + WS_CHGC))[cid_ * 64 + kb * 32 + r32]; \
            const u32x4* nn = (const u32x4*)((const bf16*)(A.ws + WS_CHNN) + cid_ * 4096 + (size_t)((vb * 2 + kb) * 64 + lane) * 16); \
            O_.nb0 = nn[0]; O_.nb1 = nn[1]; } while (0)
#ifdef S2_SEC
#define S2_TS(k) do { const unsigned long long t_ = __builtin_amdgcn_s_memrealtime(); tsec[k] += t_ - tlast; tlast = t_; } while (0)
#else
#define S2_TS(k) do {} while (0)
#endif
#define S2_STEP(O_, n_) do { const LAS unsigned char* sb = lds + ((n_) & 1) * S2_BUF; f32x16 acc = (f32x16){0.f}, acc2 = (f32x16){0.f}; \
            asm volatile("" : "+v"(O_.nb0), "+v"(O_.nb1), "+v"(O_.gc), "+v"(O_.fr[0]), "+v"(O_.fr[1]), "+v"(O_.fr[2]), "+v"(O_.fr[3])); S2_TS(0);     \
            _Pragma("unroll") for (int ks = 0; ks < 4; ++ks) { acc = __builtin_amdgcn_mfma_f32_32x32x16_bf16(*(const LAS bf16x8*)(sb + (vb * 32 + r32) * 144 + (16 * ks + 8 * hi) * 2), O_.fr[ks], acc, 0, 0, 0); \
                acc2 = __builtin_amdgcn_mfma_f32_32x32x16_bf16(*(const LAS bf16x8*)(sb + 9216 + (vb * 32 + r32) * 144 + (16 * ks + 8 * hi) * 2), O_.fr[ks], acc2, 0, 0, 0); } \
            asm volatile("" :: "v"(acc[0]), "v"(acc2[0])); S2_TS(1); \
            { float nv_[16]; unpack8(O_.nb0, *(float(*)[8])&nv_[0]); unpack8(O_.nb1, *(float(*)[8])&nv_[8]); \
              _Pragma("unroll") for (int r = 0; r < 16; ++r) S[r] = S[r] * O_.gc - (acc[r] + acc2[r]) + nv_[r]; } \
            s2_put(S, lds + (((n_) + 1) & 1) * S2_BUF, vb, kb, r32, hi); asm volatile("s_waitcnt lgkmcnt(0)" ::: "memory"); S2_TS(2); } while (0)
        S2Ops OA_, OB_;
        S2_LOAD(OA_, 0); S2_LOAD(OB_, 1);
        __builtin_amdgcn_s_setprio(3);
        for (int n = 0; n < nchunk; n += 2) {
            S2_STEP(OA_, n); S2_LOAD(OA_, min(n + 2, nchunk - 1)); S2_TS(3); S2_BAR(); S2_TS(4);
            S2_STEP(OB_, n + 1); S2_LOAD(OB_, min(n + 3, nchunk - 1)); S2_TS(3); S2_BAR(); S2_TS(4); }
        __builtin_amdgcn_s_setprio(0);
#undef S2_LOAD
#undef S2_STEP
    } else if (wave < 6) {
        const int yb = wave & 1;
#define S2_LOAD(O_, n_) do { const size_t cid_ = cid0 + (n_); const bf16* q1 = (const bf16*)(A.ws + WS_CHQ1) + cid_ * 2048 + (size_t)r32 * 64 + 8 * hi; \
            _Pragma("unroll") for (int ks = 0; ks < 4; ++ks) O_.fr[ks] = *(const bf16x8*)(q1 + 16 * ks); \
            const f32x4* q2 = (const f32x4*)((const float*)(A.ws + WS_CHQ2) + cid_ * 2048 + (size_t)(yb * 64 + lane) * 16); \
            _Pragma("unroll") for (int q = 0; q < 4; ++q) { const f32x4 t_ = q2[q]; O_.blk[4 * q] = t_[0]; O_.blk[4 * q + 1] = t_[1]; O_.blk[4 * q + 2] = t_[2]; O_.blk[4 * q + 3] = t_[3]; } } while (0)
#define S2_STEP(O_, n_) do { const LAS unsigned char* sb = lds + ((n_) & 1) * S2_BUF; f32x16 acc, acc2 = (f32x16){0.f}; \
            _Pragma("unroll") for (int r = 0; r < 16; ++r) acc[r] = O_.blk[r]; \
            _Pragma("unroll") for (int ks = 0; ks < 4; ++ks) { acc = __builtin_amdgcn_mfma_f32_32x32x16_bf16(O_.fr[ks], *(const LAS bf16x8*)(sb + (yb * 32 + r32) * 144 + (16 * ks + 8 * hi) * 2), acc, 0, 0, 0); \
                acc2 = __builtin_amdgcn_mfma_f32_32x32x16_bf16(O_.fr[ks], *(const LAS bf16x8*)(sb + 9216 + (yb * 32 + r32) * 144 + (16 * ks + 8 * hi) * 2), acc2, 0, 0, 0); } \
            acc += acc2; \
            LAS float* yt = (LAS float*)(lds + 2 * S2_BUF) + (((n_) & 1) * 2 + yb) * 1056 + r32; \
            _Pragma("unroll") for (int r = 0; r < 16; ++r) yt[((r & 3) + 8 * (r >> 2) + 4 * hi) * 33] = acc[r]; } while (0)
        S2Ops OA_, OB_;
        S2_LOAD(OA_, 0); S2_LOAD(OB_, 1);
        for (int n = 0; n < nchunk; n += 2) {
            S2_STEP(OA_, n); S2_LOAD(OA_, min(n + 2, nchunk - 1)); S2_BAR();
            S2_STEP(OB_, n + 1); S2_LOAD(OB_, min(n + 3, nchunk - 1)); S2_BAR(); }
#undef S2_LOAD
#undef S2_STEP
    } else {
        const int yb = wave & 1;
#define S2_YST(n_) do { const LAS float* yt = (const LAS float*)(lds + 2 * S2_BUF) + (((n_) & 1) * 2 + yb) * 1056 + r32; \
            gfloat_t* Y = (gfloat_t*)((float*)(A.ws + WS_Y) + (size_t)(mbase + (n_) * CH_T) * 1024 + hd * 64 + yb * 32 + r32);   \
            Y += hi * 1024; yt += hi * 33; float yv_[16]; _Pragma("unroll") for (int i = 0; i < 16; ++i) yv_[i] = yt[i * 66]; \
            _Pragma("unroll") for (int i = 0; i < 16; ++i) { *Y = yv_[i]; Y += 2048; asm volatile("" : "+v"(Y)); } } while (0)
        for (int n = 0; n < nchunk; n += 2) { if (n > 0) S2_YST(n - 1); S2_BAR(); S2_YST(n); S2_BAR(); }
        S2_YST(nchunk - 1);
#undef S2_YST
    }
#undef S2_BAR
#ifdef S2_SEC
    if (seq == 0 && wave == 0) { const unsigned long long tamp1 = __builtin_amdgcn_s_memrealtime(); while (__builtin_amdgcn_s_memrealtime() - tamp1 < 8 * tsec[S2_SEC]) __builtin_amdgcn_s_sleep(8); }
    __syncthreads();
#endif
#ifdef S2_AMP
    if (seq == 0 && wave == 0) { const unsigned long long tamp1 = __builtin_amdgcn_s_memrealtime(); while (__builtin_amdgcn_s_memrealtime() - tamp1 < S2_AMP * (tamp1 - tamp0)) __builtin_amdgcn_s_sleep(8); }
    __syncthreads();
#endif
    if (wave < 4) { float* o = A.out + (prompt ? O3 : O5) + ((size_t)(bs * 16 + hd) * 64 + vb * 32) * 64 + kb * 32 + r32;
#pragma unroll
        for (int r = 0; r < 16; ++r) o[(size_t)((r & 3) + 8 * (r >> 2) + 4 * hi) * 64] = S[r]; }
    __syncthreads();
}

struct P2cIn { f32x4 y0, y1; u32x4 cur, prv, gb; float bon; };
__device__ __forceinline__ void p2c_load(const Args& A, int m, int half, int lane, P2cIn& I) {
    const bf16* PROJ = (const bf16*)(A.ws + WS_PROJ);
    const int C = half * 512 + lane * 8;
    const float* yp = (const float*)(A.ws + WS_Y) + (size_t)m * 1024 + C;
    I.y0 = *(const f32x4*)yp; I.y1 = *(const f32x4*)(yp + 4);
    const bf16* cur = PROJ + (size_t)m * PABP + COL_HB + 2048 + C;
    I.cur = *(const u32x4*)cur; I.prv = *(const u32x4*)(cur - (m > 0 ? PABP : 0));
    I.bon = ((const float*)(A.ws + WS_SCANIN))[(size_t)m * 16 + (C >> 6)];
    I.gb = *(const u32x4*)(PROJ + (size_t)m * PABP + COL_GB + C);
}
__device__ __forceinline__ void p2c_task(const Args& A, int m, int half, int lane, const P2cIn& I, const f32x4 (&cst)[6]) {
    const bool prompt = m < MP; const int bs = prompt ? (m >> 12) : ((m - MP) >> 6), t = prompt ? (m & 4095) : ((m - MP) & 63);
    const int C = half * 512 + lane * 8;
    float y[8];
#pragma unroll
    for (int j = 0; j < 4; ++j) { y[j] = I.y0[j]; y[4 + j] = I.y1[j]; }
    float s = 0.f;
#pragma unroll
    for (int j = 0; j < 8; ++j) s += y[j];
    s += __shfl_xor(s, 1); s += __shfl_xor(s, 2); s += __shfl_xor(s, 4);
    const float mean = s * (1.f / 64.f); float q = 0.f;
#pragma unroll
    for (int j = 0; j < 8; ++j) { y[j] -= mean; q += y[j] * y[j]; }
    q += __shfl_xor(q, 1); q += __shfl_xor(q, 2); q += __shfl_xor(q, 4);
    const float rstd = 1.0f / sqrtf(q * (1.f / 64.f) + 64e-5f);
    float hv[8]; lerp8(I.cur, I.prv, t == 0, prompt ? nullptr : A.in[I_SHIFT] + (size_t)bs * DSH + 2048 + C, cst[4], cst[5], hv);
    float gb[8]; unpack8(I.gb, gb);
    float r[8];
#pragma unroll
    for (int j = 0; j < 8; ++j) { const float gg = j < 4 ? cst[0][j & 3] : cst[1][j & 3], bb = j < 4 ? cst[2][j & 3] : cst[3][j & 3]; r[j] = (y[j] * rstd * gg + bb + I.bon * hv[j]) * siluf_(gb[j]); }
    u32x4 w; w.x = pk2(r[0], r[1]); w.y = pk2(r[2], r[3]); w.z = pk2(r[4], r[5]); w.w = pk2(r[6], r[7]);
    *(u32x4*)((bf16*)(A.ws + WS_XB) + (size_t)m * DM + 1024 + C) = w;
}
constexpr int AT_KROW = 272, AT_VROW = 576, AT_KMAP = 32 * AT_KROW, AT_STAGE = 2 * AT_KMAP + 32 * AT_VROW, AT_Q = 2 * AT_STAGE, AT_QMAP = 128 * AT_KROW, AT_SCR = AT_Q + 2 * AT_QMAP;
constexpr float ATT_THR = 6.0f;
constexpr int AT_XROW = 132;
struct AttnJob { const bf16* Q; const bf16* K; const bf16* V; const float* Kc; const float* Vc; const float* Kn; const float* Vn; int ntiles, tile0, sample; float* Op; float* ML; bf16* OC; const bf16* G; };
struct AtSet { u32x4 k[2], v[2]; };
__device__ __forceinline__ void at_ld(AtSet& S, const bf16* K, const bf16* V, int tile, unsigned goff) {
    const char* Kt = (const char*)K + (size_t)tile * 32 * DM * 2; const char* Vt = (const char*)V + (size_t)tile * 32 * DM * 2;
#pragma unroll
    for (int i = 0; i < 2; ++i) { S.k[i] = *(const u32x4*)(Kt + (size_t)i * 16 * DM * 2 + goff); S.v[i] = *(const u32x4*)(Vt + (size_t)i * 16 * DM * 2 + goff); }
}
__device__ __forceinline__ void at_st(const AtSet& S, LAS unsigned char* st, int kdst, int vdst) {
#pragma unroll
    for (int i = 0; i < 2; ++i) { *(LAS u32x4*)(st + kdst + i * 16 * AT_KROW) = S.k[i]; *(LAS u32x4*)(st + vdst + i * 16 * AT_VROW) = S.v[i]; }
}
struct AtSetF { f32x4 k[2][2], v[2][2]; };
__device__ __forceinline__ void at_ldf(AtSetF& S, const AttnJob& J, int j, unsigned goff) {
    const int T = J.tile0 + j;
    const char* Kt = (const char*)(T < 128 ? J.Kc + (size_t)T * 32 * DM : J.Kn + (size_t)(T - 128) * 32 * DM); const char* Vt = (const char*)(T < 128 ? J.Vc + (size_t)T * 32 * DM : J.Vn + (size_t)(T - 128) * 32 * DM);
#pragma unroll
    for (int i = 0; i < 2; ++i) { S.k[i][0] = *(const f32x4*)(Kt + (size_t)i * 16 * DM * 4 + 2 * goff); S.k[i][1] = *(const f32x4*)(Kt + (size_t)i * 16 * DM * 4 + 2 * goff + 16);
        S.v[i][0] = *(const f32x4*)(Vt + (size_t)i * 16 * DM * 4 + 2 * goff); S.v[i][1] = *(const f32x4*)(Vt + (size_t)i * 16 * DM * 4 + 2 * goff + 16); }
}
__device__ __forceinline__ void at_stf(const AtSetF& S, LAS unsigned char* st, int kdst, int vdst) {
#pragma unroll
    for (int i = 0; i < 2; ++i) { const f32x4 a = S.k[i][0], b = S.k[i][1], c = S.v[i][0], d = S.v[i][1];
        *(LAS u32x4*)(st + kdst + i * 16 * AT_KROW) = (u32x4){cvt_pk_bf16(a[0], a[1]), cvt_pk_bf16(a[2], a[3]), cvt_pk_bf16(b[0], b[1]), cvt_pk_bf16(b[2], b[3])};
        *(LAS u32x4*)(st + vdst + i * 16 * AT_VROW) = (u32x4){cvt_pk_bf16(c[0], c[1]), cvt_pk_bf16(c[2], c[3]), cvt_pk_bf16(d[0], d[1]), cvt_pk_bf16(d[2], d[3])}; }
}
__device__ __forceinline__ float at_max32(float x) { auto rr = __builtin_amdgcn_permlane32_swap(__float_as_uint(x), __float_as_uint(x), false, false); return fmaxf(__uint_as_float(rr[0]), __uint_as_float(rr[1])); }
__device__ __forceinline__ float at_sum32(float x) { auto rr = __builtin_amdgcn_permlane32_swap(__float_as_uint(x), __float_as_uint(x), false, false); return __uint_as_float(rr[0]) + __uint_as_float(rr[1]); }
__device__ __forceinline__ float at_rowsum32(float x) {
    x = dpp_add16(x);
    return x + __builtin_bit_cast(float, __builtin_amdgcn_ds_swizzle(__builtin_bit_cast(int, x), 0x401F)); }
struct AtState { f32x16 o[8]; float m_run, l_run;
#ifdef AT_SEC
    unsigned long long ts[6], tl;
#endif
};
#ifdef AT_SEC
#define AT_TS(Z_, k) do { const unsigned long long t_ = __builtin_amdgcn_s_memrealtime(); Z_.ts[k] += t_ - Z_.tl; Z_.tl = t_; } while (0)
#else
#define AT_TS(Z_, k) do {} while (0)
#endif
__device__ __forceinline__ void at_qk(f32x16& p, const LAS unsigned char* st, const LAS unsigned char* lds, int koff, int qoff) {
    p = (f32x16){0.f};
    __builtin_amdgcn_s_setprio(1);
    {
        const unsigned ka = (unsigned)(size_t)(st + koff), qa = (unsigned)(size_t)(lds + qoff);
        bf16x8 kf0, kf1, qf0, qf1;
#define AT_QKRD(KF, QF, ds_) asm volatile("ds_read_b128 %0, %2 offset:%c4\n\tds_read_b128 %1, %3 offset:%c4" : "=&v"(KF), "=&v"(QF) : "v"(ka), "v"(qa), "i"((ds_) * 32))
#define AT_QKW(KF, QF, n_) asm volatile("s_waitcnt lgkmcnt(" #n_ ")" : "+v"(KF), "+v"(QF))
#define AT_QKM(KF, QF) p = __builtin_amdgcn_mfma_f32_32x32x16_bf16(KF, QF, p, 0, 0, 0)
        AT_QKRD(kf0, qf0, 0); AT_QKRD(kf1, qf1, 1);
        AT_QKW(kf0, qf0, 2); AT_QKM(kf0, qf0); AT_QKRD(kf0, qf0, 2);
        AT_QKW(kf1, qf1, 2); AT_QKM(kf1, qf1); AT_QKRD(kf1, qf1, 3);
        AT_QKW(kf0, qf0, 2); AT_QKM(kf0, qf0); AT_QKRD(kf0, qf0, 4);
        AT_QKW(kf1, qf1, 2); AT_QKM(kf1, qf1); AT_QKRD(kf1, qf1, 5);
        AT_QKW(kf0, qf0, 2); AT_QKM(kf0, qf0); AT_QKRD(kf0, qf0, 6);
        AT_QKW(kf1, qf1, 2); AT_QKM(kf1, qf1); AT_QKRD(kf1, qf1, 7);
        AT_QKW(kf0, qf0, 2); AT_QKM(kf0, qf0);
        AT_QKW(kf1, qf1, 0); AT_QKM(kf1, qf1);
#undef AT_QKRD
#undef AT_QKW
#undef AT_QKM
    }
    __builtin_amdgcn_s_setprio(0);
}
__device__ __forceinline__ void at_softmax(AtState& Z, f32x16& p, u32x4 (&pw)[2], LAS float* scr, int r32, int hi) {
    float mx = fmaxf(p[0], p[1]);
#pragma unroll
    for (int r = 2; r < 16; ++r) mx = fmaxf(mx, p[r]);
    mx = at_max32(mx);
    if (__any(mx > Z.m_run + ATT_THR)) {
        const float mn = fmaxf(Z.m_run, mx), alpha = __builtin_amdgcn_exp2f(Z.m_run - mn);
        Z.m_run = mn; Z.l_run *= alpha;
        if (hi == 0) scr[r32] = alpha;
#pragma unroll
        for (int r = 0; r < 16; ++r) { const float al = scr[(r & 3) + 8 * (r >> 2) + 4 * hi];
#pragma unroll
            for (int d = 0; d < 8; ++d) Z.o[d][r] *= al; }
    }
    float ls = 0.f;
#pragma unroll
    for (int r = 0; r < 16; ++r) { p[r] = __builtin_amdgcn_exp2f(p[r] - Z.m_run); ls += p[r]; }
    Z.l_run += ls;
#pragma unroll
    for (int s = 0; s < 2; ++s) pw[s] = (u32x4){cvt_pk_bf16(p[8 * s], p[8 * s + 1]), cvt_pk_bf16(p[8 * s + 2], p[8 * s + 3]), cvt_pk_bf16(p[8 * s + 4], p[8 * s + 5]), cvt_pk_bf16(p[8 * s + 6], p[8 * s + 7])};
}
__device__ __forceinline__ void at_pv(AtState& Z, const u32x4 (&pw)[2], const LAS unsigned char* st, int voff) {
    __builtin_amdgcn_s_setprio(1);
    {
        const unsigned va = (unsigned)(size_t)(st + voff);
        s16x4 lo0, lo1, lo2, hh0, hh1, hh2;
#define AT_VRD(LO, HH, i_) asm volatile("ds_read_b64_tr_b16 %0, %2 offset:%c3\n\tds_read_b64_tr_b16 %1, %2 offset:%c4" : "=&v"(LO), "=&v"(HH) : "v"(va), "i"((16 * ((i_) >> 3)) * AT_VROW + ((i_) & 7) * 64), "i"((16 * ((i_) >> 3) + 8) * AT_VROW + ((i_) & 7) * 64))
#define AT_VW(LO, HH, n_) asm volatile("s_waitcnt lgkmcnt(" #n_ ")" : "+v"(LO), "+v"(HH))
#define AT_PVM(LO, HH, i_) do { const bf16x8 vf_ = (bf16x8){LO[0], LO[1], LO[2], LO[3], HH[0], HH[1], HH[2], HH[3]}; \
                                 Z.o[(i_) & 7] = __builtin_amdgcn_mfma_f32_32x32x16_bf16(__builtin_bit_cast(bf16x8, pw[(i_) >> 3]), vf_, Z.o[(i_) & 7], 0, 0, 0); } while (0)
        AT_VRD(lo0, hh0, 0); AT_VRD(lo1, hh1, 1); AT_VRD(lo2, hh2, 2);
#pragma unroll
        for (int i = 0; i < 12; i += 3) {
            AT_VW(lo0, hh0, 4); AT_PVM(lo0, hh0, i); AT_VRD(lo0, hh0, i + 3);
            AT_VW(lo1, hh1, 4); AT_PVM(lo1, hh1, i + 1); AT_VRD(lo1, hh1, i + 4);
            AT_VW(lo2, hh2, 4); AT_PVM(lo2, hh2, i + 2); AT_VRD(lo2, hh2, i + 5); }
        AT_VW(lo0, hh0, 4); AT_PVM(lo0, hh0, 12); AT_VRD(lo0, hh0, 15);
        AT_VW(lo1, hh1, 4); AT_PVM(lo1, hh1, 13);
        AT_VW(lo2, hh2, 2); AT_PVM(lo2, hh2, 14);
        AT_VW(lo0, hh0, 0); AT_PVM(lo0, hh0, 15);
#undef AT_VRD
#undef AT_VW
#undef AT_PVM
    }
    __builtin_amdgcn_s_setprio(0);
}
__device__ __forceinline__ void at_compute(AtState& Z, const LAS unsigned char* st, const LAS unsigned char* lds, int koff, int qoff, int voff, LAS float* scr, int r32, int hi) {
    f32x16 p; u32x4 pw[2];
    at_qk(p, st, lds, koff, qoff); at_softmax(Z, p, pw, scr, r32, hi); at_pv(Z, pw, st, voff);
}
__device__ __forceinline__ void attn_job(const AttnJob& J, const Args& A, LAS unsigned char* lds, float lam, int wave, int lane, int tid) {
    const int r32 = lane & 31, hi = lane >> 5, map = wave & 1;
    const int qg = J.sample ? ((wave >> 1) & 1) : (wave >> 1), khalf = wave >> 2;
    AtState Z;
#pragma unroll
    for (int d = 0; d < 8; ++d) Z.o[d] = (f32x16){0.f};
    Z.m_run = -1e30f; Z.l_run = 0.f;
#ifdef AT_SEC
    for (int i = 0; i < 6; ++i) Z.ts[i] = 0; Z.tl = __builtin_amdgcn_s_memrealtime();
#endif
    LAS float* scr = (LAS float*)(lds + AT_SCR) + wave * 64;
    const unsigned goff = (unsigned)(((tid >> 5) * DM + (tid & 31) * 8) * 2);
    const int kdst = ((tid & 31) >> 4) * AT_KMAP + (tid >> 5) * AT_KROW + (tid & 15) * 16, vdst = 2 * AT_KMAP + (tid >> 5) * AT_VROW + (tid & 31) * 16;
    const int koff = map * AT_KMAP + r32 * AT_KROW + hi * 16, qoff = AT_Q + map * AT_QMAP + (qg * 32 + r32) * AT_KROW + hi * 16;
    const int voff = 2 * AT_KMAP + (4 * hi + ((lane & 15) >> 2)) * AT_VROW + (((lane >> 4) & 1) * 16 + (lane & 3) * 4) * 2;
    { const int nq = J.sample ? 4 : 8;
      for (int i = 0; i < nq; ++i) { const int c = tid + 512 * i, row = c >> 5, cc = c & 31;
          *(LAS u32x4*)(lds + AT_Q + (cc >> 4) * AT_QMAP + row * AT_KROW + (cc & 15) * 16) = *(const u32x4*)(J.Q + (size_t)row * DM + cc * 8); } }
    const int NT = J.ntiles;
    if (!J.sample) {
        const int ntw = NT - ((qg < 2) ? 2 : 0);
        AtSet S;
        at_ld(S, J.K, J.V, 0, goff); at_st(S, lds, kdst, vdst); at_ld(S, J.K, J.V, 1, goff);
        __syncthreads();
        if (wave < 4) {
            for (int j = 0; j < NT; ++j) { const bool act = j < ntw; f32x16 p;
                if (act) at_qk(p, lds + (j & 1) * AT_STAGE, lds, koff, qoff);
                __syncthreads();
                if (act) { u32x4 pw[2]; at_softmax(Z, p, pw, scr, r32, hi); at_pv(Z, pw, lds + (j & 1) * AT_STAGE, voff); }
                if (j + 1 < NT) { at_st(S, lds + ((j + 1) & 1) * AT_STAGE, kdst, vdst); if (j + 2 < NT) at_ld(S, J.K, J.V, j + 2, goff); }
                __syncthreads(); }
        } else {
            u32x4 pw[2] = {(u32x4){0u, 0u, 0u, 0u}, (u32x4){0u, 0u, 0u, 0u}};
            for (int j = 0; j < NT; ++j) {
                if (j > 0) at_pv(Z, pw, lds + ((j - 1) & 1) * AT_STAGE, voff);
                __syncthreads();
                { f32x16 p; at_qk(p, lds + (j & 1) * AT_STAGE, lds, koff, qoff); at_softmax(Z, p, pw, scr, r32, hi); }
                if (j + 1 < NT) { at_st(S, lds + ((j + 1) & 1) * AT_STAGE, kdst, vdst); if (j + 2 < NT) at_ld(S, J.K, J.V, j + 2, goff); }
                __syncthreads(); }
            at_pv(Z, pw, lds + ((NT - 1) & 1) * AT_STAGE, voff);
        }
        __syncthreads();
    } else {
        AtSetF SF;
        at_ldf(SF, J, 0, goff); at_stf(SF, lds, kdst, vdst);
        __syncthreads();
        for (int j = 0; j < NT; ++j) {
            if (j + 1 < NT) at_ldf(SF, J, j + 1, goff);
            if ((j & 1) == khalf) at_compute(Z, lds + (j & 1) * AT_STAGE, lds, koff, qoff, voff, scr, r32, hi);
            if (j + 1 < NT) at_stf(SF, lds + ((j + 1) & 1) * AT_STAGE, kdst, vdst);
            __syncthreads();
        }
    }
    Z.l_run = at_sum32(Z.l_run);
    if (J.sample) {
        float* Op = J.Op + (size_t)khalf * 32768; float* ML = J.ML + khalf * 256;
        if (hi == 0) { ML[(map * 64 + qg * 32 + r32) * 2] = Z.m_run; ML[(map * 64 + qg * 32 + r32) * 2 + 1] = Z.l_run; }
#pragma unroll
        for (int d = 0; d < 8; ++d)
#pragma unroll
            for (int r = 0; r < 16; ++r) Op[(size_t)(map * 64 + qg * 32 + (r & 3) + 8 * (r >> 2) + 4 * hi) * 256 + d * 32 + r32] = Z.o[d][r];
        return;
    }
#ifdef NOEPI
    J.OC[tid] = (bf16)f2bf(Z.o[0][0] + Z.o[7][15] + Z.l_run); return;
#endif
    if (hi == 0) scr[r32] = 1.0f / Z.l_run;
    float il[16];
#pragma unroll
    for (int r = 0; r < 16; ++r) il[r] = scr[(r & 3) + 8 * (r >> 2) + 4 * hi];
    LAS float* xme = (LAS float*)lds + wave * (32 * AT_XROW);
#pragma unroll
    for (int d = 0; d < 4; ++d)
#pragma unroll
        for (int r = 0; r < 16; ++r) xme[((r & 3) + 8 * (r >> 2) + 4 * hi) * AT_XROW + d * 32 + r32] = (map ? Z.o[d][r] : Z.o[4 + d][r]) * il[r];
    __syncthreads();
    const float ca = map ? -lam : 1.f, cb = map ? 1.f : -lam;
    LAS float* xw = (LAS float*)lds + (wave ^ 1) * (32 * AT_XROW);
    LAS float* sx = (LAS float*)(lds + 8 * 32 * AT_XROW * 4);
#pragma unroll
    for (int r = 0; r < 16; ++r) { float s = 0.f; const int q = (r & 3) + 8 * (r >> 2) + 4 * hi;
#pragma unroll
        for (int d = 0; d < 4; ++d) { const float x = xw[q * AT_XROW + d * 32 + r32]; const float v = ca * il[r] * (map ? Z.o[4 + d][r] : Z.o[d][r]) + cb * x; xw[q * AT_XROW + d * 32 + r32] = v; s += v * v; }
        s = at_rowsum32(s);
        if (r32 == 0) sx[wave * 32 + q] = s;
        if (r & 1) __builtin_amdgcn_sched_barrier(0); }
    __syncthreads();
    { const int dvb = map * 128, oc = lane & 15;
      const f32x4 sg0 = *(const f32x4*)(A.in[I_SUBG] + dvb + oc * 8), sg1 = *(const f32x4*)(A.in[I_SUBG] + dvb + oc * 8 + 4);
      u32x4 gpre[8];
#pragma unroll
      for (int it = 0; it < 8; ++it) gpre[it] = *(const u32x4*)(J.G + (size_t)(qg * 32 + it * 4 + (lane >> 4)) * DM + dvb + oc * 8);
#pragma unroll
      for (int it = 0; it < 8; ++it) { const int q = it * 4 + (lane >> 4); const size_t o = (size_t)(qg * 32 + q) * DM + dvb + oc * 8;
          const float sc = (1.0f / sqrtf((sx[wave * 32 + q] + sx[(wave ^ 1) * 32 + q]) * (1.f / 256.f) + 1e-5f)) * (1.f - LAM_INIT);
          const f32x4 x0 = *(const LAS f32x4*)(xw + q * AT_XROW + oc * 8) * sc, x1 = *(const LAS f32x4*)(xw + q * AT_XROW + oc * 8 + 4) * sc;
          float g[8]; unpack8(gpre[it], g);
          u32x4 w; w.x = cvt_pk_bf16(x0[0] * sg0[0] * g[0], x0[1] * sg0[1] * g[1]); w.y = cvt_pk_bf16(x0[2] * sg0[2] * g[2], x0[3] * sg0[3] * g[3]);
          w.z = cvt_pk_bf16(x1[0] * sg1[0] * g[4], x1[1] * sg1[1] * g[5]); w.w = cvt_pk_bf16(x1[2] * sg1[2] * g[6], x1[3] * sg1[3] * g[7]);
          *(u32x4*)(J.OC + o) = w; } }
#ifdef AT_SEC
    if (wave == 0) { const unsigned long long t1 = __builtin_amdgcn_s_memrealtime(); while (__builtin_amdgcn_s_memrealtime() - t1 < 2 * Z.ts[AT_SEC]) __builtin_amdgcn_s_sleep(8); }
#endif
    __syncthreads();
}

__device__ __forceinline__ void p6_task(const Args& A, int ms, int h, float lam, int lane) {
    const int b = ms >> 6, q = ms & 63; const int m = MP + ms;
    f32x4 on[2];
#pragma unroll
    for (int j = 0; j < 2; ++j) { float mm[8], ll[8], M = -1e30f;
#pragma unroll
        for (int s = 0; s < 8; ++s) { const size_t base = (size_t)((b * 8 + h) * 8 + s); const float* ml = (const float*)(A.ws + WS_MLS) + ((base * 2 + j) * 64 + q) * 2; mm[s] = ml[0]; ll[s] = ml[1]; M = fmaxf(M, mm[s]); }
        f32x4 acc = (f32x4){0.f, 0.f, 0.f, 0.f}; float L = 0.f;
#pragma unroll
        for (int s = 0; s < 8; ++s) { const size_t base = (size_t)((b * 8 + h) * 8 + s); const float w = __builtin_amdgcn_exp2f(mm[s] - M); L += w * ll[s];
            acc += ((const f32x4*)((const float*)(A.ws + WS_PARTS) + ((base * 2 + j) * 64 + q) * 256))[lane] * w; }
        on[j] = acc * (1.0f / L); }
    const f32x4 of = on[0] - on[1] * lam;
    const float ss = wave_sum(of[0] * of[0] + of[1] * of[1] + of[2] * of[2] + of[3] * of[3]);
    const float rms = 1.0f / sqrtf(ss * (1.f / 256.f) + 1e-5f);
    const f32x4 sg = ((const f32x4*)A.in[I_SUBG])[lane];
    const u32x2 gw = *(const u32x2*)((const bf16*)(A.ws + WS_GB) + (size_t)m * DM + h * 256 + lane * 4);
    const float sc = rms * (1.f - LAM_INIT);
    u32x2 w; w.x = pk2(of[0] * sc * sg[0] * bflo(gw.x), of[1] * sc * sg[1] * bfhi(gw.x)); w.y = pk2(of[2] * sc * sg[2] * bflo(gw.y), of[3] * sc * sg[3] * bfhi(gw.y));
    *(u32x2*)((bf16*)(A.ws + WS_XB) + (size_t)m * DM + h * 256 + lane * 4) = w;
}
__device__ __forceinline__ void p8_row(const Args& A, int m, int m_next, u32x2 (&pre)[8], int lane) {
    float* y = A.out + (m < MP ? O0 + (size_t)m * DM : O1 + (size_t)(m - MP) * DM);
    f32x4 v[8]; float s = 0.f;
    u32x2 cur[8];
#pragma unroll
    for (int j = 0; j < 8; ++j) cur[j] = pre[j];
    if (m_next < MP) {
#pragma unroll
        for (int j = 0; j < 8; ++j) pre[j] = ((const u32x2*)((const bf16*)(A.ws + WS_QB) + (size_t)m_next * DM))[lane + 64 * j]; }
#pragma unroll
    for (int j = 0; j < 8; ++j) {
        if (m < MP) { const u32x2 zw = cur[j]; v[j] = (f32x4){bflo(zw.x), bfhi(zw.x), bflo(zw.y), bfhi(zw.y)}; }
        else {
            const int ms = m - MP; const float* st = (const float*)(A.ws + OFF_STATS1) + 2 * m;
            const float mean = st[0] * (1.f / 2048.f), var = st[1] * (1.f / 2048.f) - mean * mean, rstd = 1.0f / sqrtf(var + 1e-5f);
            const u32x2 zw = ((const u32x2*)((const bf16*)(A.ws + WS_Z1) + (size_t)m * DM))[lane + 64 * j];
            const f32x4 z = (f32x4){bflo(zw.x), bfhi(zw.x), bflo(zw.y), bfhi(zw.y)};
            f32x4 a = ((z - mean) * rstd * ((const f32x4*)A.in[I_LNG])[lane + 64 * j] + ((const f32x4*)A.in[I_LNB])[lane + 64 * j]) * ALPHA;
#pragma unroll
            for (int k2 = 0; k2 < 8; ++k2) a += ((const f32x4*)((const float*)(A.ws + WS_SLAB) + ((size_t)k2 * MS + ms) * DM))[lane + 64 * j];
            v[j] = a; }
        s += (v[j][0] + v[j][1]) + (v[j][2] + v[j][3]); }
    const float mean = wave_sum(s) * (1.f / 2048.f); float q = 0.f;
#pragma unroll
    for (int j = 0; j < 8; ++j) { v[j] = v[j] - mean; q += (v[j][0] * v[j][0] + v[j][1] * v[j][1]) + (v[j][2] * v[j][2] + v[j][3] * v[j][3]); }
    const float rstd = 1.0f / sqrtf(wave_sum(q) * (1.f / 2048.f) + 1e-5f);
#pragma unroll
    for (int j = 0; j < 8; ++j) { const f32x4 g = ((const f32x4*)A.in[I_CLNG])[lane + 64 * j], b = ((const f32x4*)A.in[I_CLNB])[lane + 64 * j];
        ((f32x4*)y)[lane + 64 * j] = v[j] * rstd * g + b; }
}
constexpr int N_PHASES = 11;
__global__ void __launch_bounds__(512, 2) mega_fwd(Args A) {
    extern __shared__ __attribute__((aligned(16))) unsigned char lds_raw[];
    LAS unsigned char* lds = (LAS unsigned char*)lds_raw;
    const int tid = threadIdx.x, lane = tid & 63, wave = __builtin_amdgcn_readfirstlane(tid >> 6);
    const int G = gridDim.x, bx = blockIdx.x, vcu = (G % 8 == 0) ? (bx % 8) * (G / 8) + bx / 8 : bx;
    unsigned char* ws = A.ws;
    unsigned* ctl = (unsigned*)(ws + WS_CTL);
    for (int u = tid; u < (LDS_BYTES - LDSCTL_OFF) / 4; u += 512) ((LAS unsigned*)(lds + LDSCTL_OFF))[u] = 0u;
    __syncthreads();
    XcdBarrier bar = xcd_barrier_post(ctl + CW_BAR, (volatile LAS unsigned*)(lds + MISC_OFF) + 8);
    const int lo = A.ph_lo, hi = A.ph_hi;
#ifndef PH_MASK
#define PH_MASK 0x7ff
#endif
#define IN(k) (((PH_MASK >> (k)) & 1) && lo <= (k) && (k) < hi)
#define SEAM(k) do { if (IN(k) && IN((k) + 1)) xcd_barrier(bar); } while (0)
#ifndef REPEAT_PH
#define REPEAT_PH -1
#endif
#define NREP(k) ((REPEAT_PH == (k)) ? 2 : 1)
#ifdef AMP_PH
    unsigned long long amp_t0 = 0;
#define AMP_BEGIN(k) do { if ((k) == AMP_PH || ((k) == 2 && (AMP_PH == 3 || AMP_PH == 31)) || ((k) == 4 && AMP_PH == 5)) amp_t0 = __builtin_amdgcn_s_memrealtime(); } while (0)
#define AMP_END(k) do { if ((k) == AMP_PH || ((k) == 3 && AMP_PH == 32)) { __syncthreads(); if (wave == 0) { const unsigned long long t1_ = __builtin_amdgcn_s_memrealtime(); while (__builtin_amdgcn_s_memrealtime() - t1_ < t1_ - amp_t0) __builtin_amdgcn_s_sleep(8); } __syncthreads(); } } while (0)
#else
#define AMP_BEGIN(k) do {} while (0)
#define AMP_END(k) do {} while (0)
#endif
    float* const dummyf = (float*)(ws + 5 * MiB);
    const int gw = vcu * 8 + wave, NGW = G * 8;

    if (IN(0)) for (int rep = 0; rep < NREP(0); ++rep) { if (rep) xcd_barrier(bar); p0_prologue(A, lds, vcu, G, wave, lane, tid, rep ? dummyf : (float*)(ws + OFF_COLSUM), rep ? dummyf + 8192 : (float*)(ws + OFF_BW)); }
    AMP_END(0);
    SEAM(0);
    AMP_BEGIN(1);
    if (IN(1)) for (int rep = 0; rep < NREP(1); ++rep) { if (rep) xcd_barrier(bar);
        pg8::Gemm g{(const bf16*)(ws + WS_XB), (const bf16*)(ws + WS_WTIN), MT, PABP, DM, DM}; pg8::StaticOrder S; S.init(MT, PABP, G, bx);
        pg8::EpiPlainBf16 E{(bf16*)(ws + WS_PROJ), PABP};
        pg8::gemm_phase<pg8::EpiPlainBf16, pg8::StaticOrder, true, true>(lds, g, S, E);
        { const int nun = (MT / 256) * (PABP / 256), tail = nun % G;
          if (rep == 0 && tail != 0 && bx >= tail) { __syncthreads(); late_transposes(A, lds, (bx - tail) * 8 + wave, (G - tail) * 8, wave, lane, (float*)(ws + OFF_COLSUM), (float*)(ws + OFF_BW)); } }
    }
    AMP_END(1);
    SEAM(1);
    AMP_BEGIN(2);
    if (IN(2)) for (int rep = 0; rep < NREP(2); ++rep) { if (rep) xcd_barrier(bar);
        const bf16* PROJ = (const bf16*)(ws + WS_PROJ);
        for (int idx = vcu * 512 + tid; idx < 12 * DSH; idx += G * 512) { const int s = idx / DSH, c = idx % DSH;
            const int m = s < 4 ? s * SEQ + SEQ - 1 : MP + (s - 4) * DSQ + DSQ - 1;
            float v = bf1(PROJ[(size_t)m * PABP + COL_HB + c]);
#if STAGE == 1
            v *= 3.f;
#endif
            A.out[(s < 4 ? O2 + (size_t)s * DSH : O4 + (size_t)(s - 4) * DSH) + c] = v; }
    }
    if (IN(3)) for (int rep = 0; rep < NREP(3); ++rep) { if (rep) xcd_barrier(bar);
#ifndef REP_S1
#define REP_S1 1
#endif
#ifndef REP_S2
#define REP_S2 1
#endif
        for (int rr = 0; rr < REP_S1; ++rr) { if (rr) xcd_barrier(bar);
        for (int v0 = vcu; v0 < 256; v0 += G) { PrepRegs R; int cur_hd = -1;
#ifdef S1_SEC
            unsigned long long s1ts[8] = {0,0,0,0,0,0,0,0}; unsigned long long s1tl = __builtin_amdgcn_s_memrealtime();
#endif
            const int nu = v0 < 128 ? 17 : 16;
            for (int i = 0; i < nu; ++i) { const int sh = v0 >> 2; const int sq = i < 16 ? (sh >> 4) : NBP + (v0 >> 4), hd = i < 16 ? (sh & 15) : (v0 & 15), cp = i < 16 ? (v0 & 3) * 16 + i : 0;
                if (hd != cur_hd) { s1_consts(A, lds, hd, tid); __syncthreads(); cur_hd = hd; }
                s1_unit(A, lds, sq, hd, cp, R, S1_PF && i > 0 && i < 16, S1_PF && i < 15, wave, lane, tid
#ifdef S1_SEC
                    , s1ts, s1tl
#endif
                    ); }
#ifdef S1_SEC
            if (wave == 0) { const unsigned long long t1 = __builtin_amdgcn_s_memrealtime(); while (__builtin_amdgcn_s_memrealtime() - t1 < 2 * s1ts[S1_SEC]) __builtin_amdgcn_s_sleep(8); }
            __syncthreads();
#endif
            } }
        AMP_END(31);
        xcd_barrier(bar);
        AMP_BEGIN(32);
        for (int rr = 0; rr < REP_S2; ++rr) { if (rr) xcd_barrier(bar);
        for (int v0 = vcu; v0 < 256; v0 += G) {
            if ((v0 & 3) == 0) s2_unit(A, lds, v0 >> 6, (v0 >> 2) & 15, wave, lane);
            else { const int su = (v0 >> 2) * 3 + (v0 & 3) - 1; if (su < 128) s2_unit(A, lds, NBP + (su >> 4), su & 15, wave, lane); } } }
        for (int v0 = vcu; v0 < 256; v0 += G) if ((v0 & 3) != 0)
            for (int u = (v0 >> 2) * 3 + (v0 & 3) - 1; u < 136 * 4; u += 192) mixer_a_unit(A, lds, u >> 2, u & 3, wave, lane, tid);

    }
    AMP_END(3);
    SEAM(3);
    AMP_BEGIN(4);
    if (IN(4)) for (int rep = 0; rep < NREP(4); ++rep) { if (rep) xcd_barrier(bar);
        const int half = gw & 1, C = half * 512 + lane * 8;
        f32x4 cst[6]; cst[0] = *(const f32x4*)(A.in[I_LNXG] + C); cst[1] = *(const f32x4*)(A.in[I_LNXG] + C + 4); cst[2] = *(const f32x4*)(A.in[I_LNXB] + C); cst[3] = *(const f32x4*)(A.in[I_LNXB] + C + 4);
        cst[4] = *(const f32x4*)(A.in[I_MU] + 2048 + C); cst[5] = *(const f32x4*)(A.in[I_MU] + 2048 + C + 4);
        P2cIn nx; p2c_load(A, min(gw >> 1, MT - 1), half, lane, nx);
        for (int wt = gw; wt < MT * 2; wt += NGW) { const P2cIn cu = nx; p2c_load(A, min((wt + NGW) >> 1, MT - 1), half, lane, nx); p2c_task(A, wt >> 1, half, lane, cu, cst); } }
    if (IN(4) && IN(5)) xcd_barrier(bar);
    if (IN(5)) for (int rep = 0; rep < NREP(5); ++rep) { if (rep) xcd_barrier(bar);
        pg8::Gemm g{(const bf16*)(ws + WS_XB), (const bf16*)(ws + WS_WTOUT), MP, DM, DM, DM}; pg8::StaticOrder S; S.init(MP, DM, G, bx);
        pg8::EpiZ1 E{A.in[I_XP], A.in[I_XS], (bf16*)(ws + WS_Z1), rep ? dummyf : (float*)(ws + OFF_STATS1)};
        pg8::gemm_phase<pg8::EpiZ1, pg8::StaticOrder, true, true>(lds, g, S, E);
        { pg8::Gemm g2{(const bf16*)(ws + WS_XB), (const bf16*)(ws + WS_WTOUT), MT, DM, 256, DM}; pg8::SliceOrder S2; S2.init(DM, 8, 256, G, bx);
          pg8::EpiSlab E2{(float*)(ws + WS_SLAB), DM, 256};
          pg8::gemm_phase<pg8::EpiSlab, pg8::SliceOrder, false, true>(lds, g2, S2, E2); }
        xcd_barrier(bar);
        for (int ms = gw; ms < MS; ms += NGW) {
            const float* xr = A.in[I_XS] + (size_t)ms * DM; const float* sl = (const float*)(ws + WS_SLAB) + (size_t)ms * DM; bf16* zr = (bf16*)(ws + WS_Z1) + (size_t)(MP + ms) * DM; float s_ = 0.f, ss_ = 0.f;
#pragma unroll
            for (int jb = 0; jb < 8; jb += 4) { f32x4 xv[4], sv[4][8];
#pragma unroll
                for (int j = 0; j < 4; ++j) { xv[j] = ((const f32x4*)xr)[lane + 64 * (jb + j)];
#pragma unroll
                    for (int k2 = 0; k2 < 8; ++k2) sv[j][k2] = ((const f32x4*)(sl + (size_t)k2 * MS * DM))[lane + 64 * (jb + j)]; }
#pragma unroll
                for (int j = 0; j < 4; ++j) { f32x4 v = xv[j] * ALPHA;
#pragma unroll
                    for (int k2 = 0; k2 < 8; ++k2) v += sv[j][k2];
                    u32x2 w; w.x = cvt_pk_bf16(v[0], v[1]); w.y = cvt_pk_bf16(v[2], v[3]); ((u32x2*)zr)[lane + 64 * (jb + j)] = w;
                    const float f0 = bflo(w.x), f1 = bfhi(w.x), f2 = bflo(w.y), f3 = bfhi(w.y); s_ += (f0 + f1) + (f2 + f3); ss_ += (f0 * f0 + f1 * f1) + (f2 * f2 + f3 * f3); } }
            s_ = wave_sum(s_); ss_ = wave_sum(ss_);
            if (lane == 0 && !rep) { ((float*)(ws + OFF_STATS1))[2 * (MP + ms)] = s_; ((float*)(ws + OFF_STATS1))[2 * (MP + ms) + 1] = ss_; } }
    }
    AMP_END(5);
    SEAM(5);
    AMP_BEGIN(6);
    if (IN(6)) for (int rep = 0; rep < NREP(6); ++rep) { if (rep) xcd_barrier(bar);
        pg8::Gemm g{(const bf16*)(ws + WS_Z1), (const bf16*)(ws + WS_WTCIN), MP, PCN, DM, DM}; pg8::StaticOrder S; S.init(MP, PCN, G, bx);
        pg8::EpiQKVG E{(const float*)(ws + OFF_STATS1), (const float*)(ws + OFF_COLSUM), (const float*)(ws + OFF_BW), (bf16*)(ws + WS_QB), (bf16*)(ws + WS_GB), (bf16*)(ws + WS_KBP), (bf16*)(ws + WS_VBP), A.out};
        pg8::gemm_phase<pg8::EpiQKVG, pg8::StaticOrder, true, true>(lds, g, S, E);
        { pg8::Gemm g2{(const bf16*)(ws + WS_Z1), (const bf16*)(ws + WS_WTCIN), MT, PCN, 512, DM}; pg8::SliceOrder S2; S2.init(PCN, 4, 512, G, bx);
          pg8::EpiSlab E2{(float*)(ws + WS_SLAB3), PCN, 512};
          pg8::gemm_phase<pg8::EpiSlab, pg8::SliceOrder, false, true>(lds, g2, S2, E2); }
        xcd_barrier(bar);
        for (int wt = gw; wt < MS * 4; wt += NGW) {
            const int ms = wt >> 2, kind = wt & 3, row = MP + ms;
            const float* st = (const float*)(ws + OFF_STATS1) + 2 * row;
            const float mean = st[0] * (1.f / 2048.f), var = st[1] * (1.f / 2048.f) - mean * mean, rstd = 1.0f / sqrtf(var + 1e-5f);
            const float* sl = (const float*)(ws + WS_SLAB3) + (size_t)ms * PCN + kind * DM;
#pragma unroll
            for (int jb = 0; jb < 8; jb += 4) { f32x4 av[4][4], cv[4], bv[4];
#pragma unroll
                for (int j = 0; j < 4; ++j) { const int c = (lane + 64 * (jb + j)) * 4;
#pragma unroll
                    for (int k2 = 0; k2 < 4; ++k2) av[j][k2] = *(const f32x4*)(sl + (size_t)k2 * MS * PCN + c);
                    cv[j] = *(const f32x4*)((const float*)(ws + OFF_COLSUM) + kind * DM + c); bv[j] = *(const f32x4*)((const float*)(ws + OFF_BW) + kind * DM + c); }
#pragma unroll
                for (int j = 0; j < 4; ++j) { const int c = (lane + 64 * (jb + j)) * 4;
                    const f32x4 a = (av[j][0] + av[j][1]) + (av[j][2] + av[j][3]);
                    f32x4 v = (a - cv[j] * mean) * rstd + bv[j];
                    if (kind == 0) { v = v * QSCALE; u32x2 w; w.x = cvt_pk_bf16(v[0], v[1]); w.y = cvt_pk_bf16(v[2], v[3]); *(u32x2*)((bf16*)(ws + WS_QB) + (size_t)row * DM + c) = w; }
                    else if (kind == 3) { u32x2 w; w.x = cvt_pk_bf16(siluf_(v[0]), siluf_(v[1])); w.y = cvt_pk_bf16(siluf_(v[2]), siluf_(v[3])); *(u32x2*)((bf16*)(ws + WS_GB) + (size_t)row * DM + c) = w; }
                    else *(f32x4*)(A.out + (kind == 1 ? O9 : O10) + (size_t)ms * DM + c) = v; } } }
    }
    AMP_END(6);
    SEAM(6);
    AMP_BEGIN(7);
    if (IN(7)) for (int rep = 0; rep < NREP(7); ++rep) { if (rep) xcd_barrier(bar);
        float lam;
        { const float s1 = A.in[I_LQ1][lane] * A.in[I_LK1][lane] + A.in[I_LQ1][lane + 64] * A.in[I_LK1][lane + 64], s2 = A.in[I_LQ2][lane] * A.in[I_LK2][lane] + A.in[I_LQ2][lane + 64] * A.in[I_LK2][lane + 64];
          lam = __expf(wave_sum(s1)) - __expf(wave_sum(s2)) + LAM_INIT; }
        if (wave >= 4) __builtin_amdgcn_s_setprio(2);
        for (int v0 = vcu; v0 < 256; v0 += G) {
            for (int i = 0; i < 5; ++i) {
                AttnJob J;
                if (i < 4) { const int bh = v0 >> 3, s = v0 & 7, b = bh >> 3, h = bh & 7; const int qb = (i & 1) ? (16 * (i >> 1) + 15 - s) : (16 * (i >> 1) + s);
                    J.Q = (const bf16*)(ws + WS_QB) + (size_t)(b * SEQ + qb * 128) * DM + h * 256; J.K = (const bf16*)(ws + WS_KBP) + (size_t)(b * SEQ) * DM + h * 256; J.V = (const bf16*)(ws + WS_VBP) + (size_t)(b * SEQ) * DM + h * 256;
                    J.Kc = J.Vc = J.Kn = J.Vn = nullptr; J.ntiles = 4 * qb + 4; J.tile0 = 0; J.sample = 0; J.Op = nullptr; J.ML = nullptr;
                    J.OC = (bf16*)(ws + WS_XB) + (size_t)(b * SEQ + qb * 128) * DM + h * 256; J.G = (const bf16*)(ws + WS_GB) + (size_t)(b * SEQ + qb * 128) * DM + h * 256;
                } else { const int bh2 = v0 >> 2, sp = v0 & 3, b2 = bh2 >> 3, h2 = bh2 & 7, start = sp < 2 ? 33 * sp : 66 + 32 * (sp - 2);
                    const size_t base = (size_t)((b2 * 8 + h2) * 8 + sp * 2);
                    J.Q = (const bf16*)(ws + WS_QB) + (size_t)(MP + b2 * DSQ) * DM + h2 * 256; J.K = J.V = nullptr;
                    J.Kc = A.in[I_CK] + (size_t)b2 * PAST * DM + h2 * 256; J.Vc = A.in[I_CV] + (size_t)b2 * PAST * DM + h2 * 256;
                    J.Kn = A.out + O9 + (size_t)b2 * DSQ * DM + h2 * 256; J.Vn = A.out + O10 + (size_t)b2 * DSQ * DM + h2 * 256;
                    J.ntiles = sp < 2 ? 33 : 32; J.tile0 = start; J.sample = 1; J.Op = (float*)(ws + WS_PARTS) + base * 32768; J.ML = (float*)(ws + WS_MLS) + base * 256; J.OC = nullptr; J.G = nullptr; }
                attn_job(J, A, lds, lam, wave, lane, tid); }
        }
        __builtin_amdgcn_s_setprio(0);
    }
    AMP_END(7);
    SEAM(7);
    AMP_BEGIN(8);
    if (IN(8)) for (int rep = 0; rep < NREP(8); ++rep) { if (rep) xcd_barrier(bar);
        float lam;
        { const float s1 = A.in[I_LQ1][lane] * A.in[I_LK1][lane] + A.in[I_LQ1][lane + 64] * A.in[I_LK1][lane + 64], s2 = A.in[I_LQ2][lane] * A.in[I_LK2][lane] + A.in[I_LQ2][lane + 64] * A.in[I_LK2][lane + 64];
          lam = __expf(wave_sum(s1)) - __expf(wave_sum(s2)) + LAM_INIT; }
        for (int wt = gw; wt < MS * 8; wt += NGW) p6_task(A, wt >> 3, wt & 7, lam, lane);
    }
    AMP_END(8);
    SEAM(8);
    AMP_BEGIN(9);
    if (IN(9)) for (int rep = 0; rep < NREP(9); ++rep) { if (rep) xcd_barrier(bar);
        pg8::Gemm g{(const bf16*)(ws + WS_XB), (const bf16*)(ws + WS_WTCOUT), MP, DM, DM, DM}; pg8::StaticOrder S; S.init(MP, DM, G, bx);
        pg8::EpiZ2 E{(const float*)(ws + OFF_STATS1), (const bf16*)(ws + WS_Z1), A.in[I_LNG], A.in[I_LNB], (bf16*)(ws + WS_QB)};
        pg8::gemm_phase<pg8::EpiZ2, pg8::StaticOrder, true, true>(lds, g, S, E);
        { pg8::Gemm g2{(const bf16*)(ws + WS_XB), (const bf16*)(ws + WS_WTCOUT), MT, DM, 256, DM}; pg8::SliceOrder S2; S2.init(DM, 8, 256, G, bx);
          pg8::EpiSlab E2{(float*)(ws + WS_SLAB), DM, 256};
          pg8::gemm_phase<pg8::EpiSlab, pg8::SliceOrder, false, true>(lds, g2, S2, E2); }
    }
    AMP_END(9);
    SEAM(9);
    AMP_BEGIN(10);
    if (IN(10)) { u32x2 pre[8];
#pragma unroll
        for (int j = 0; j < 8; ++j) pre[j] = (gw < MP) ? ((const u32x2*)((const bf16*)(ws + WS_QB) + (size_t)gw * DM))[lane + 64 * j] : (u32x2){0u, 0u};
        for (int m = gw; m < MT; m += NGW) p8_row(A, m, m + NGW, pre, lane); }
    AMP_END(10);
#undef IN
#undef SEAM
}

extern "C" void kernel_launch(void* const* d_in, const int* in_sizes, int n_in, void* d_out, int out_size, void* d_ws, size_t ws_size, hipStream_t stream) {
    static int grid = 0;
    if (grid == 0) {
        if (n_in != 33 || (size_t)out_size != OUT_TOTAL || ws_size < WS_END) { fprintf(stderr, "kernel_launch: unexpected shapes: n_in %d out %d ws %zu (need %zu)\n", n_in, out_size, ws_size, (size_t)WS_END); grid = -1; return; }
        int dev = 0, cus = 0;
        if (hipGetDevice(&dev) != hipSuccess || hipDeviceGetAttribute(&cus, hipDeviceAttributeMultiprocessorCount, dev) != hipSuccess) { grid = -1; return; }
        if (hipFuncSetAttribute((const void*)mega_fwd, hipFuncAttributeMaxDynamicSharedMemorySize, LDS_BYTES) != hipSuccess) { fprintf(stderr, "kernel_launch: hipFuncSetAttribute failed\n"); grid = -1; return; }
        (void)hipGetLastError();
        grid = cus;
        if (grid != 256) fprintf(stderr, "kernel_launch: %d CUs; this kernel is laid out for 256\n", grid);
    }
    if (grid < 0) return;
    (void)hipMemsetAsync((char*)d_ws + WS_CTL, 0, CTL_ZERO_BYTES, stream);
    Args a{};
    for (int i = 0; i < 33; ++i) a.in[i] = (const float*)d_in[i];
    a.out = (float*)d_out; a.ws = (unsigned char*)d_ws;
#if STAGE == 1
    const int nph = 3;
#elif STAGE == 2
    const int nph = 4;
#elif STAGE == 3
    const int nph = 7;
#else
    const int nph = N_PHASES;
#endif
#if STAGE < 9
    (void)hipMemsetAsync(d_out, 0, (size_t)out_size * 4, stream);
#endif
#ifdef MULTI_LAUNCH
    for (int p = 0; p < nph; ++p) { a.ph_lo = p; a.ph_hi = p + 1; hipLaunchKernelGGL(mega_fwd, dim3(grid), dim3(512), LDS_BYTES, stream, a); }
#else
    a.ph_lo = 0; a.ph_hi = nph;
    hipLaunchKernelGGL(mega_fwd, dim3(grid), dim3(512), LDS_BYTES, stream, a);
#endif
}
```

```cpp
#include <hip/hip_runtime.h>
#include <cstdio>
#include <cstdint>
#ifndef STAGE
#define STAGE 9
#endif
namespace pg8 {
#define PG8_LAS __attribute__((address_space(3)))
typedef unsigned short bf16_t;
typedef short bf16x8 __attribute__((ext_vector_type(8)));
typedef float f32x4 __attribute__((ext_vector_type(4)));
typedef unsigned u32x4 __attribute__((ext_vector_type(4)));
constexpr int BM = 256, BK = 64, HALF = 128, HTB = HALF * BK * 2  , STAGE_BYTES = 8 * HTB, NXCD = 8, WGM = 8;

__host__ __device__ __forceinline__ int lds_byte(int r, int c) { const int st = (r >> 4) * 2 + (c >> 5), rr = r & 15, cc = c & 31, ob = rr * 64 + cc * 2; return st * 1024 + (ob ^ (((ob >> 9) & 1) << 5)); }
__host__ __device__ __forceinline__ void stage_rc(int b, int& R, int& C) { const int st = b / 1024, sb = b % 1024, swz = sb ^ (((sb >> 9) & 1) << 5); R = (st >> 1) * 16 + swz / 64; C = (st & 1) * 32 + (swz % 64) / 2; }
__host__ __device__ __forceinline__ int perm32(int rho) { const int n = rho >> 4, i = rho & 15; return 8 * (i >> 2) + 4 * n + (i & 3); }

struct Unit { int pm, pn, ko; };
struct Gemm { const bf16_t* A; const bf16_t* Bt; int M, N, K, ld; };

struct StaticOrder {
    int nM, nN, nwg, G, c;
    __host__ __device__ void init(int M, int N, int G_, int c_) { nM = M / BM; nN = N / BM; nwg = nM * nN; G = G_; c = c_; }
    __host__ __device__ bool next(int i, Unit& u) const {
        const long L = (long)i * G + c; if (L >= nwg) return false;
        int wgid = (int)L; { const int q = nwg / NXCD, r = nwg % NXCD, xcd = wgid % NXCD, off = wgid / NXCD; wgid = (xcd < r ? xcd * (q + 1) : r * (q + 1) + (xcd - r) * q) + off; }
        const int nig = WGM * nN, gid = wgid / nig, fm = gid * WGM, gsz = (nM - fm) < WGM ? (nM - fm) : WGM;
        u.pm = fm + ((wgid % nig) % gsz); u.pn = (wgid % nig) / gsz; u.ko = 0; return true;
    }
    __device__ __forceinline__ void a_ready(const Unit&) const {}
    __device__ __forceinline__ void done(const Unit&) const {}
};

__device__ __forceinline__ unsigned cvt_pk_bf16(float lo, float hi) { unsigned r; asm volatile("v_cvt_pk_bf16_f32 %0, %1, %2" : "=v"(r) : "v"(lo), "v"(hi)); return r; }
typedef float f32x2 __attribute__((ext_vector_type(2)));
template <class Epi, class Sched, bool ALIGN_EPI = false, bool SP2 = false>
__device__ __forceinline__ void gemm_phase(PG8_LAS unsigned char* lds, const Gemm g, const Sched& S, const Epi& E) {
    const int tid = threadIdx.x, wid = __builtin_amdgcn_readfirstlane(tid >> 6), lane = tid & 63, wr = wid >> 2, wc = wid & 3, fr = lane & 15, fq = lane >> 4;
    const int K = g.K, nt = K / BK, LD = g.ld;
    unsigned voffA[2], voffB[2];
#pragma unroll
    for (int i = 0; i < 2; ++i) { int R, C; stage_rc(tid * 16 + i * 8192, R, C); const int Rb = Epi::PERM ? ((R & ~31) + perm32(R & 31)) : R;
        voffA[i] = (unsigned)(R * LD + C) * 2u; voffB[i] = (unsigned)(Rb * LD + C) * 2u; }
    const size_t kstep = (size_t)(BK * 2);
    const size_t hstep = (size_t)HALF * LD * 2;
    const size_t tstep = 2 * hstep;
    const unsigned ldsw = (unsigned)wid * 1024u;
    const int aoff = lds_byte(wr * 64 + fr, fq * 8), boff = lds_byte(wc * 32 + fr, fq * 8);
#define PG8_SA(b, h) (((b) * 2 + (h)) * HTB)
#define PG8_SB(b, h) ((4 + (b) * 2 + (h)) * HTB)
#define PG8_STAGE(bufoff, gbase, voff) do { _Pragma("unroll") for (int _i = 0; _i < 2; ++_i) \
        __builtin_amdgcn_global_load_lds((const unsigned*)((const char*)(gbase) + (voff)[_i]), (PG8_LAS unsigned*)(lds + (bufoff) + ldsw + _i * 8192), 16, 0, 0); } while (0)
#define PG8_LDA(dst, b, h) do { _Pragma("unroll") for (int m = 0; m < 4; ++m) _Pragma("unroll") for (int k = 0; k < 2; ++k) dst[m][k] = *(const PG8_LAS bf16x8*)(lds + PG8_SA(b, h) + aoff + m * 2048 + k * 1024); } while (0)
#define PG8_LDB(dst, b, h) do { _Pragma("unroll") for (int n = 0; n < 2; ++n) _Pragma("unroll") for (int k = 0; k < 2; ++k) dst[n][k] = *(const PG8_LAS bf16x8*)(lds + PG8_SB(b, h) + boff + n * 2048 + k * 1024); } while (0)
#define PG8_MMA(ai, bj, At, Bt) do { __builtin_amdgcn_s_setprio(1); _Pragma("unroll") for (int m = 0; m < 4; ++m) _Pragma("unroll") for (int n = 0; n < 2; ++n) _Pragma("unroll") for (int k = 0; k < 2; ++k) \
        acc[ai][bj][m][n] = __builtin_amdgcn_mfma_f32_16x16x32_bf16(Bt[n][k], At[m][k], acc[ai][bj][m][n], 0, 0, 0); __builtin_amdgcn_s_setprio(0); } while (0)
#define PG8_WAIT_V(n) asm volatile("s_waitcnt vmcnt(" #n ")" ::: "memory")
#define PG8_WAIT_L(n) asm volatile("s_waitcnt lgkmcnt(" #n ")" ::: "memory")
#define PG8_BAR __builtin_amdgcn_s_barrier()
#define PG8_SCHED __builtin_amdgcn_sched_barrier(0)
    Unit cur, nxt; int ui = 0;
    if (!S.next(0, cur)) return;
    f32x4 acc[2][2][4][2];
#pragma unroll
    for (int a = 0; a < 2; ++a)
#pragma unroll
        for (int b = 0; b < 2; ++b)
#pragma unroll
            for (int m = 0; m < 4; ++m)
#pragma unroll
                for (int n = 0; n < 2; ++n) acc[a][b][m][n] = (f32x4){0.f, 0.f, 0.f, 0.f};
    bf16x8 At[4][2], B0[2][2], B1[2][2];
    const char* cA = (const char*)g.A + (size_t)cur.pm * tstep + (size_t)cur.ko * 2; const char* cB = (const char*)g.Bt + (size_t)cur.pn * tstep + (size_t)cur.ko * 2;
    S.a_ready(cur);
    if constexpr (SP2) {
        PG8_STAGE(PG8_SB(0, 0), cB, voffB); PG8_STAGE(PG8_SB(0, 1), cB + hstep, voffB); PG8_STAGE(PG8_SA(0, 0), cA, voffA); PG8_STAGE(PG8_SA(0, 1), cA + hstep, voffA);
        if (wr == 1) PG8_BAR;
        PG8_WAIT_V(2); PG8_BAR;
        PG8_STAGE(PG8_SB(1, 0), cB + kstep, voffB); PG8_STAGE(PG8_SA(1, 0), cA + kstep, voffA); PG8_STAGE(PG8_SB(1, 1), cB + hstep + kstep, voffB);
        PG8_WAIT_V(6); PG8_BAR;
    } else {
        PG8_STAGE(PG8_SB(0, 0), cB, voffB); PG8_STAGE(PG8_SA(0, 0), cA, voffA); PG8_STAGE(PG8_SB(0, 1), cB + hstep, voffB); PG8_STAGE(PG8_SA(0, 1), cA + hstep, voffA);
        if (wr == 1) PG8_BAR;
        PG8_WAIT_V(4); PG8_BAR;
        PG8_STAGE(PG8_SB(1, 0), cB + kstep, voffB); PG8_STAGE(PG8_SA(1, 0), cA + kstep, voffA); PG8_STAGE(PG8_SB(1, 1), cB + hstep + kstep, voffB);
        PG8_WAIT_V(6); PG8_BAR;
    }
    for (;;) {
        const bool has_next = S.next(ui + 1, nxt);
        const char* nA = has_next ? (const char*)g.A + (size_t)nxt.pm * tstep + (size_t)nxt.ko * 2 : cA; const char* nB = has_next ? (const char*)g.Bt + (size_t)nxt.pn * tstep + (size_t)nxt.ko * 2 : cB;
        for (int t = 0; t < nt; t += 2) {
            const bool last = (t == nt - 2);
            const char* a1 = cA + (size_t)(t + 1) * kstep;
            const char* a2 = last ? nA : cA + (size_t)(t + 2) * kstep; const char* b2 = last ? nB : cB + (size_t)(t + 2) * kstep;
            const char* a3 = a2 + kstep; const char* b3 = b2 + kstep;
            if (last && has_next) S.a_ready(nxt);
            if constexpr (SP2) {
            PG8_LDB(B0, 0, 0); PG8_LDB(B1, 0, 1); PG8_SCHED; PG8_LDA(At, 0, 0); PG8_STAGE(PG8_SA(1, 1), a1 + hstep, voffA);
            PG8_WAIT_V(8); PG8_WAIT_L(0); PG8_BAR; PG8_MMA(0, 0, At, B0); PG8_MMA(0, 1, At, B1); PG8_BAR; PG8_SCHED;
            PG8_LDA(At, 0, 1); PG8_STAGE(PG8_SB(0, 0), b2, voffB); PG8_STAGE(PG8_SB(0, 1), b2 + hstep, voffB); PG8_STAGE(PG8_SA(0, 0), a2, voffA);
            PG8_WAIT_V(8); PG8_WAIT_L(0); PG8_BAR; PG8_MMA(1, 0, At, B0); PG8_MMA(1, 1, At, B1); PG8_BAR; PG8_SCHED;
            PG8_LDB(B0, 1, 0); PG8_LDB(B1, 1, 1); PG8_SCHED; PG8_LDA(At, 1, 0); PG8_STAGE(PG8_SA(0, 1), a2 + hstep, voffA);
            PG8_WAIT_V(8); PG8_WAIT_L(0); PG8_BAR; PG8_MMA(0, 0, At, B0); PG8_MMA(0, 1, At, B1); PG8_BAR; PG8_SCHED;
            PG8_LDA(At, 1, 1); PG8_STAGE(PG8_SB(1, 0), b3, voffB); PG8_STAGE(PG8_SB(1, 1), b3 + hstep, voffB); PG8_STAGE(PG8_SA(1, 0), a3, voffA);
            PG8_WAIT_V(8); PG8_WAIT_L(0); PG8_BAR; PG8_MMA(1, 0, At, B0); PG8_MMA(1, 1, At, B1); PG8_BAR; PG8_SCHED;
            } else {
            PG8_LDB(B0, 0, 0); PG8_SCHED; PG8_LDA(At, 0, 0); PG8_STAGE(PG8_SA(1, 1), a1 + hstep, voffA);
            PG8_WAIT_L(8); PG8_BAR; PG8_WAIT_L(0); PG8_MMA(0, 0, At, B0); PG8_BAR; PG8_SCHED;
            PG8_LDB(B1, 0, 1); PG8_STAGE(PG8_SB(0, 0), b2, voffB);
            PG8_BAR; PG8_WAIT_L(0); PG8_MMA(0, 1, At, B1); PG8_BAR;
            PG8_LDA(At, 0, 1); PG8_STAGE(PG8_SA(0, 0), a2, voffA);
            PG8_BAR; PG8_WAIT_L(0); PG8_MMA(1, 0, At, B0); PG8_BAR; PG8_SCHED;
            PG8_STAGE(PG8_SB(0, 1), b2 + hstep, voffB);
            PG8_WAIT_V(6); PG8_BAR; PG8_MMA(1, 1, At, B1); PG8_BAR;
            PG8_LDB(B0, 1, 0); PG8_SCHED; PG8_LDA(At, 1, 0); PG8_STAGE(PG8_SA(0, 1), a2 + hstep, voffA);
            PG8_WAIT_L(8); PG8_BAR; PG8_WAIT_L(0); PG8_MMA(0, 0, At, B0); PG8_BAR; PG8_SCHED;
            PG8_LDB(B1, 1, 1); PG8_STAGE(PG8_SB(1, 0), b3, voffB);
            PG8_BAR; PG8_WAIT_L(0); PG8_MMA(0, 1, At, B1); PG8_BAR;
            PG8_LDA(At, 1, 1); PG8_STAGE(PG8_SA(1, 0), a3, voffA);
            PG8_BAR; PG8_WAIT_L(0); PG8_MMA(1, 0, At, B0); PG8_BAR; PG8_SCHED;
            PG8_STAGE(PG8_SB(1, 1), b3 + hstep, voffB);
            PG8_WAIT_V(6); PG8_BAR; PG8_MMA(1, 1, At, B1); PG8_BAR;
            }
        }
        if constexpr (ALIGN_EPI) { if (wr == 0) PG8_BAR; }
        if constexpr (!Epi::AFTER_DRAIN) { E(acc, cur, wr, wc, fr, fq); S.done(cur); }
        if (!has_next) break;
#pragma unroll
        for (int a = 0; a < 2; ++a)
#pragma unroll
            for (int b = 0; b < 2; ++b)
#pragma unroll
                for (int m = 0; m < 4; ++m)
#pragma unroll
                    for (int n = 0; n < 2; ++n) acc[a][b][m][n] = (f32x4){0.f, 0.f, 0.f, 0.f};
        cur = nxt; cA = nA; cB = nB; ++ui;
        if constexpr (ALIGN_EPI) { if (wr == 1) PG8_BAR; }
    }
    PG8_WAIT_V(0);
    if constexpr (!ALIGN_EPI) { if (wr == 0) PG8_BAR; }
    PG8_BAR;
    if constexpr (Epi::AFTER_DRAIN) { E.fused(acc, cur, wr, wc, fr, fq, lds, wid, lane); S.done(cur); }
#undef PG8_SA
#undef PG8_SB
#undef PG8_STAGE
#undef PG8_LDA
#undef PG8_LDB
#undef PG8_MMA
#undef PG8_WAIT_V
#undef PG8_WAIT_L
#undef PG8_BAR
#undef PG8_SCHED
}
}
constexpr int DM = 2048, NBP = 4, SEQ = 4096, NBS = 8, DSQ = 64, PAST = 4096;
constexpr int MP = NBP * SEQ, MS = NBS * DSQ, MT = MP + MS;
constexpr int PAB = 7296, PABP = 7424, PCN = 8192, DSH = 3200, KVROWS = PAST + DSQ;
constexpr int COL_VA = 1024, COL_GA = 2048, COL_HB = 3072, COL_GB = 6272;
constexpr float ALPHA = 1.41421356237f;
constexpr float LAM_INIT = 0.35550906759f;
constexpr float QSCALE = 0.08838834764831845f * 1.4426950408889634f;
constexpr size_t O0 = 0, O1 = 33554432, O2 = 34603008, O3 = 34615808, O4 = 34877952, O5 = 34903552, O6 = 35427840, O7 = 35952128, O8 = 69506560, O9 = 103060992, O10 = 104109568, OUT_TOTAL = 105158144;
constexpr size_t MiB = 1u << 20;
constexpr size_t WS_CTL = 0, CTL_ZERO_BYTES = 1 * MiB;
constexpr size_t OFF_STATS1 = 131072, OFF_COLSUM = 393216, OFF_BW = 458752;
constexpr size_t WS_W2T = 4 * MiB, WS_A2T = WS_W2T + 131072, WS_WSB = WS_W2T + 262144;
constexpr size_t WS_WTIN = 8 * MiB, WS_WTOUT = 37 * MiB, WS_WTCIN = 45 * MiB, WS_WTCOUT = 77 * MiB;
constexpr size_t WS_XB = 85 * MiB, WS_Z1 = 151 * MiB;
constexpr size_t WS_PROJ = 477 * MiB, WS_SCANIN = 717 * MiB, WS_Y = 915 * MiB;
constexpr size_t WS_QB = 477 * MiB, WS_GB = 543 * MiB, WS_KBP = 609 * MiB, WS_VBP = 673 * MiB, WS_PARTP = 737 * MiB, WS_MLP = 993 * MiB;
constexpr size_t WS_PARTS = 217 * MiB, WS_MLS = 281 * MiB, WS_SLAB = 981 * MiB, WS_SLAB3 = 300 * MiB, WS_END = 1024 * MiB;
constexpr int CW_TMO = 0, CW_CODE = 1, CW_BAR = 4096;
constexpr size_t SCAN_SBASE = (size_t)NBP * 16 * SEQ * 384;
constexpr int RING_BYTES = 147456, LDSCTL_OFF = RING_BYTES, MISC_OFF = LDSCTL_OFF + 320, LDS_BYTES = 148480;

#define LAS __attribute__((address_space(3)))
typedef unsigned short bf16;
typedef short bf16x8 __attribute__((ext_vector_type(8)));
typedef short s16x4 __attribute__((ext_vector_type(4)));
typedef float f32x4 __attribute__((ext_vector_type(4)));
typedef float f32x2 __attribute__((ext_vector_type(2)));
typedef float f32x16 __attribute__((ext_vector_type(16)));
typedef unsigned u32x4 __attribute__((ext_vector_type(4)));
typedef unsigned u32x2 __attribute__((ext_vector_type(2)));
using pg8::cvt_pk_bf16;

__device__ __forceinline__ unsigned f2bf(float f) { unsigned u = __builtin_bit_cast(unsigned, f); return (u + 0x7fffu + ((u >> 16) & 1u)) >> 16; }
__device__ __forceinline__ unsigned pk2(float lo, float hi) { return f2bf(lo) | (f2bf(hi) << 16); }
__device__ __forceinline__ float bflo(unsigned w) { return __builtin_bit_cast(float, w << 16); }
__device__ __forceinline__ float bfhi(unsigned w) { return __builtin_bit_cast(float, w & 0xffff0000u); }
__device__ __forceinline__ float bf1(bf16 h) { return __builtin_bit_cast(float, (unsigned)h << 16); }
__device__ __forceinline__ float sigmoidf_(float x) { return __builtin_amdgcn_rcpf(1.f + __expf(-x)); }
__device__ __forceinline__ float siluf_(float x) { return x * sigmoidf_(x); }
__device__ __forceinline__ float wave_sum(float v) {
#pragma unroll
    for (int o = 1; o < 64; o <<= 1) v += __shfl_xor(v, o);
    return v;
}
__device__ __forceinline__ void unpack8(u32x4 w, float (&f)[8]) { f[0] = bflo(w.x); f[1] = bfhi(w.x); f[2] = bflo(w.y); f[3] = bfhi(w.y); f[4] = bflo(w.z); f[5] = bfhi(w.z); f[6] = bflo(w.w); f[7] = bfhi(w.w); }

namespace pg8 {
struct EpiPlainBf16 {
    static constexpr bool PERM = true, AFTER_DRAIN = false;
    bf16_t* O; int ldc;
    __device__ __forceinline__ void operator()(const f32x4 (&acc)[2][2][4][2], const Unit& u, int wr, int wc, int fr, int fq) const {
        const int row0 = u.pm * BM + wr * 64 + fr, col0 = u.pn * BM + wc * 32 + 8 * fq;
#pragma unroll
        for (int ai = 0; ai < 2; ++ai)
#pragma unroll
            for (int m = 0; m < 4; ++m) { bf16_t* rowp = O + (size_t)(row0 + ai * HALF + m * 16) * ldc + col0;
#pragma unroll
                for (int bj = 0; bj < 2; ++bj) { const f32x4 v0 = acc[ai][bj][m][0], v1 = acc[ai][bj][m][1];
                    u32x4 w; w.x = cvt_pk_bf16(v0[0], v0[1]); w.y = cvt_pk_bf16(v0[2], v0[3]); w.z = cvt_pk_bf16(v1[0], v1[1]); w.w = cvt_pk_bf16(v1[2], v1[3]);
                    *(u32x4*)(rowp + bj * HALF) = w; } }
    }
};
struct EpiZ1 {
    static constexpr bool PERM = true, AFTER_DRAIN = false;
    const float* xp; const float* xs; bf16_t* Z; float* stats;
    __device__ __forceinline__ void operator()(const f32x4 (&acc)[2][2][4][2], const Unit& u, int wr, int wc, int fr, int fq) const {
        const int row0 = u.pm * BM + wr * 64 + fr, col0 = u.pn * BM + wc * 32 + 8 * fq;
        f32x4 xn[2][2];
#define EPZ1_LOAD(i_) do { const int row_ = row0 + ((i_) >> 2) * HALF + ((i_) & 3) * 16; const float* xr_ = (row_ < ::MP ? xp + (size_t)row_ * ::DM : xs + (size_t)(row_ - ::MP) * ::DM) + col0; \
            _Pragma("unroll") for (int bj = 0; bj < 2; ++bj) { xn[bj][0] = *(const f32x4*)(xr_ + bj * HALF); xn[bj][1] = *(const f32x4*)(xr_ + bj * HALF + 4); } } while (0)
        EPZ1_LOAD(0);
#pragma unroll
        for (int i = 0; i < 8; ++i) { const int ai = i >> 2, m = i & 3; const int row = row0 + ai * HALF + m * 16;
            f32x4 xc[2][2];
#pragma unroll
            for (int bj = 0; bj < 2; ++bj) { xc[bj][0] = xn[bj][0]; xc[bj][1] = xn[bj][1]; }
            if (i + 1 < 8) EPZ1_LOAD(i + 1);
            bf16_t* zr = Z + (size_t)row * ::DM + col0; float s = 0.f, ss = 0.f;
#pragma unroll
            for (int bj = 0; bj < 2; ++bj) { const f32x4 v0 = acc[ai][bj][m][0] + xc[bj][0] * ::ALPHA, v1 = acc[ai][bj][m][1] + xc[bj][1] * ::ALPHA;
                u32x4 w; w.x = cvt_pk_bf16(v0[0], v0[1]); w.y = cvt_pk_bf16(v0[2], v0[3]); w.z = cvt_pk_bf16(v1[0], v1[1]); w.w = cvt_pk_bf16(v1[2], v1[3]);
                *(u32x4*)(zr + bj * HALF) = w;
                float f[8]; ::unpack8(w, f);
#pragma unroll
                for (int q = 0; q < 8; ++q) { s += f[q]; ss += f[q] * f[q]; } }
            s += __shfl_xor(s, 16); s += __shfl_xor(s, 32); ss += __shfl_xor(ss, 16); ss += __shfl_xor(ss, 32);
            if (fq == 0) { unsafeAtomicAdd(stats + 2 * row, s); unsafeAtomicAdd(stats + 2 * row + 1, ss); } }
#undef EPZ1_LOAD
    }
};
struct EpiQKVG {
    static constexpr bool PERM = true, AFTER_DRAIN = false;
    const float* stats; const float* colsum; const float* bw; bf16_t* QB; bf16_t* GB; bf16_t* KBP; bf16_t* VBP; float* out;
    __device__ __forceinline__ void operator()(const f32x4 (&acc)[2][2][4][2], const Unit& u, int wr, int wc, int fr, int fq) const {
        const int kind = u.pn >> 3;
        const int row0 = u.pm * BM + wr * 64 + fr, col0 = (u.pn & 7) * BM + wc * 32 + 8 * fq, gcol0 = u.pn * BM + wc * 32 + 8 * fq;
        f32x4 cs[2][2], bb[2][2];
#pragma unroll
        for (int bj = 0; bj < 2; ++bj)
#pragma unroll
            for (int n = 0; n < 2; ++n) { cs[bj][n] = *(const f32x4*)(colsum + gcol0 + bj * HALF + 4 * n); bb[bj][n] = *(const f32x4*)(bw + gcol0 + bj * HALF + 4 * n); }
        float mean_[8], rstd_[8];
#pragma unroll
        for (int i = 0; i < 8; ++i) { const int row = row0 + (i >> 2) * HALF + (i & 3) * 16; const f32x2 st = *(const f32x2*)(stats + 2 * row);
            mean_[i] = st[0] * (1.f / 2048.f); rstd_[i] = st[1]; }
#pragma unroll
        for (int i = 0; i < 8; ++i) rstd_[i] = __builtin_amdgcn_rsqf(rstd_[i] * (1.f / 2048.f) - mean_[i] * mean_[i] + 1e-5f);
#pragma unroll
        for (int ai = 0; ai < 2; ++ai)
#pragma unroll
            for (int m = 0; m < 4; ++m) { const int row = row0 + ai * HALF + m * 16;
                const float mean = mean_[ai * 4 + m], rstd = rstd_[ai * 4 + m];
                const bool prompt = row < ::MP; const int rs = row - ::MP;
#pragma unroll
                for (int bj = 0; bj < 2; ++bj) { const int col = col0 + bj * HALF;
                    f32x4 v0 = (acc[ai][bj][m][0] - cs[bj][0] * mean) * rstd + bb[bj][0], v1 = (acc[ai][bj][m][1] - cs[bj][1] * mean) * rstd + bb[bj][1];
                    if (kind == 0) { v0 = v0 * ::QSCALE; v1 = v1 * ::QSCALE; }
                    if (kind == 3) {
#pragma unroll
                        for (int i = 0; i < 4; ++i) { v0[i] = ::siluf_(v0[i]); v1[i] = ::siluf_(v1[i]); } }
                    u32x4 w; w.x = cvt_pk_bf16(v0[0], v0[1]); w.y = cvt_pk_bf16(v0[2], v0[3]); w.z = cvt_pk_bf16(v1[0], v1[1]); w.w = cvt_pk_bf16(v1[2], v1[3]);
                    if (kind == 0) *(u32x4*)(QB + (size_t)row * ::DM + col) = w;
                    else if (kind == 3) *(u32x4*)(GB + (size_t)row * ::DM + col) = w;
                    else {
                        float* fo = out + (kind == 1 ? (prompt ? ::O7 : ::O9) : (prompt ? ::O8 : ::O10)) + (size_t)(prompt ? row : rs) * ::DM + col;
#if STAGE == 3
                        *(f32x4*)fo = v0 * 3.f; *(f32x4*)(fo + 4) = v1 * 3.f;
#else
                        *(f32x4*)fo = v0; *(f32x4*)(fo + 4) = v1;
#endif
                        if (prompt) *(u32x4*)((kind == 1 ? KBP : VBP) + (size_t)row * ::DM + col) = w; } } }
    }
};
struct EpiZ2 {
    static constexpr bool PERM = false, AFTER_DRAIN = false;
    const float* stats; const bf16_t* Z; const float* g1; const float* b1; bf16_t* z2b;
    __device__ __forceinline__ void operator()(const f32x4 (&acc)[2][2][4][2], const Unit& u, int wr, int wc, int fr, int fq) const {
        const int row0 = u.pm * BM + wr * 64 + fr, col0 = u.pn * BM + wc * 32 + 4 * fq;
        f32x4 gg[2][2], bb[2][2];
#pragma unroll
        for (int bj = 0; bj < 2; ++bj)
#pragma unroll
            for (int n = 0; n < 2; ++n) { gg[bj][n] = *(const f32x4*)(g1 + col0 + bj * HALF + 16 * n); bb[bj][n] = *(const f32x4*)(b1 + col0 + bj * HALF + 16 * n); }
        float mean_[8], rstd_[8];
#pragma unroll
        for (int i = 0; i < 8; ++i) { const int row = row0 + (i >> 2) * HALF + (i & 3) * 16; const f32x2 st = *(const f32x2*)(stats + 2 * row);
            mean_[i] = st[0] * (1.f / 2048.f); rstd_[i] = st[1]; }
#pragma unroll
        for (int i = 0; i < 8; ++i) rstd_[i] = __builtin_amdgcn_rsqf(rstd_[i] * (1.f / 2048.f) - mean_[i] * mean_[i] + 1e-5f);
        u32x2 zn[2][2];
#define EPZ2_LOAD(i_) do { const bf16_t* zr_ = Z + (size_t)(row0 + ((i_) >> 2) * HALF + ((i_) & 3) * 16) * ::DM + col0; \
            _Pragma("unroll") for (int bj = 0; bj < 2; ++bj) _Pragma("unroll") for (int n = 0; n < 2; ++n) zn[bj][n] = *(const u32x2*)(zr_ + bj * HALF + 16 * n); } while (0)
        EPZ2_LOAD(0);
#pragma unroll
        for (int i = 0; i < 8; ++i) { const int ai = i >> 2, m = i & 3; const int row = row0 + ai * HALF + m * 16;
            u32x2 zc[2][2];
#pragma unroll
            for (int bj = 0; bj < 2; ++bj)
#pragma unroll
                for (int n = 0; n < 2; ++n) zc[bj][n] = zn[bj][n];
            if (i + 1 < 8) EPZ2_LOAD(i + 1);
            const float mean = mean_[i], rstd = rstd_[i];
#pragma unroll
            for (int bj = 0; bj < 2; ++bj)
#pragma unroll
                for (int n = 0; n < 2; ++n) { const u32x2 zw = zc[bj][n];
                    f32x4 z; z[0] = ::bflo(zw.x); z[1] = ::bfhi(zw.x); z[2] = ::bflo(zw.y); z[3] = ::bfhi(zw.y);
                    const f32x4 x1 = (z - mean) * rstd * gg[bj][n] + bb[bj][n];
                    const f32x4 z2 = acc[ai][bj][m][n] + x1 * ::ALPHA; u32x2 pw; pw.x = cvt_pk_bf16(z2[0], z2[1]); pw.y = cvt_pk_bf16(z2[2], z2[3]);
                    *(u32x2*)(z2b + (size_t)row * ::DM + col0 + bj * HALF + 16 * n) = pw; } }
#undef EPZ2_LOAD
    }
};
struct SliceOrder {
    int G, c, nN, nS, KS;
    __host__ __device__ void init(int N, int nslices, int kslice, int G_, int c_) { nN = N / BM; nS = nslices; KS = kslice; G = G_; c = c_; }
    __host__ __device__ bool next(int i, Unit& u) const { const int L = i * G + c; if (L >= 2 * nN * nS) return false; const int tile = L / nS; u.ko = (L % nS) * KS; u.pm = 64 + tile / nN; u.pn = tile % nN; return true; }
    __device__ __forceinline__ void a_ready(const Unit&) const {}
    __device__ __forceinline__ void done(const Unit&) const {}
};
struct EpiSlab {
    static constexpr bool PERM = false, AFTER_DRAIN = false;
    float* slab; int N, KS;
    __device__ __forceinline__ void operator()(const f32x4 (&acc)[2][2][4][2], const Unit& u, int wr, int wc, int fr, int fq) const {
        const int row0 = (u.pm - 64) * BM + wr * 64 + fr, col0 = u.pn * BM + wc * 32 + 4 * fq;
        float* base = slab + (size_t)(u.ko / KS) * ::MS * N;
#pragma unroll
        for (int ai = 0; ai < 2; ++ai)
#pragma unroll
            for (int m = 0; m < 4; ++m) { float* rp = base + (size_t)(row0 + ai * HALF + m * 16) * N + col0;
#pragma unroll
                for (int bj = 0; bj < 2; ++bj)
#pragma unroll
                    for (int n = 0; n < 2; ++n) *(f32x4*)(rp + bj * HALF + 16 * n) = acc[ai][bj][m][n]; }
    }
};
}

#define XB_TMO      128
#define XB_XCNT(j)  (256  + 64 * (j))
#define XB_XSUB(j)  (1280 + 64 * (j))
#define XB_XGEN(j)  (2304 + 64 * (j))
#define XB_TOP      3328
#define XB_TOPGEN   3392
#define XCD_BAR_WORDS 3456
#define XB_SPIN_CAP (1u << 22)

__device__ __forceinline__ unsigned xb_ld(unsigned* p)              { return __hip_atomic_load(p, __ATOMIC_RELAXED, __HIP_MEMORY_SCOPE_AGENT); }
__device__ __forceinline__ unsigned xb_add(unsigned* p, unsigned v) { return __hip_atomic_fetch_add(p, v, __ATOMIC_RELAXED, __HIP_MEMORY_SCOPE_AGENT); }
__device__ __forceinline__ unsigned xb_xcc_id() { return (unsigned)__builtin_amdgcn_s_getreg((3 << 11) | 20) & 0xFu; }
#define XB_SPIN(cond, bar) do { unsigned _sp = 0; while (cond) { __builtin_amdgcn_s_sleep(1); \
    if ((++_sp & 255u) == 0u) { if (xb_ld(&(bar)[XB_TMO])) break; if (_sp > XB_SPIN_CAP) { atomicAdd(&(bar)[XB_TMO], 1u); break; } } } } while (0)

struct XcdBarrier {
    unsigned* bar; unsigned x;
    volatile LAS unsigned* st;
};

__device__ __forceinline__ XcdBarrier xcd_barrier_post(unsigned* bar, volatile LAS unsigned* st) {
    XcdBarrier b; b.bar = bar; b.x = xb_xcc_id(); b.st = st;
    if (threadIdx.x == 0) (void)xb_add(&bar[XB_XCNT(b.x)], 1u);
    return b;
}
__device__ __forceinline__ void xcd_barrier_complete(unsigned* bar, unsigned x, unsigned& nloc, unsigned& nx) {
    const unsigned G = gridDim.x * gridDim.y * gridDim.z;
    unsigned sum, cnt, mine, sp = 0u;
    for (;;) {
        sum = 0u; cnt = 0u; mine = 0u;
#pragma unroll
        for (unsigned j = 0; j < 16; ++j) { const unsigned c = xb_ld(&bar[XB_XCNT(j)]); sum += c; cnt += (c > 0u) ? 1u : 0u; mine = (j == x) ? c : mine; }
        if (sum == G) break;
        __builtin_amdgcn_s_sleep(1);
        if ((++sp & 255u) == 0u) { if (xb_ld(&bar[XB_TMO])) break; if (sp > XB_SPIN_CAP) { atomicAdd(&bar[XB_TMO], 1u); break; } }
    }
    nloc = mine > 0u ? mine : 1u; nx = cnt > 0u ? cnt : 1u;
}

__device__ __forceinline__ void xcd_barrier(const XcdBarrier& b) {
    asm volatile("s_waitcnt vmcnt(0)" ::: "memory");
    __syncthreads();
    if (threadIdx.x == 0) {
        unsigned* bar = b.bar;
        __builtin_amdgcn_s_waitcnt(0);
        unsigned nloc = b.st[0], nx = b.st[1];
        if (nloc == 0u) { xcd_barrier_complete(bar, b.x, nloc, nx); b.st[0] = nloc; b.st[1] = nx; }
        const unsigned old = xb_add(&bar[XB_XSUB(b.x)], 1u);
        const unsigned gen = old / nloc;
        if (old + 1u == (gen + 1u) * nloc) {
            __builtin_amdgcn_fence(__ATOMIC_RELEASE, "agent");
            asm volatile("s_waitcnt vmcnt(0)" ::: "memory");
            const unsigned og = xb_add(&bar[XB_TOP], 1u);
            const unsigned tg = og / nx;
            if (og + 1u == (tg + 1u) * nx) xb_add(&bar[XB_TOPGEN], 1u);
            else XB_SPIN(xb_ld(&bar[XB_TOPGEN]) == tg, bar);
            __builtin_amdgcn_fence(__ATOMIC_ACQUIRE, "agent");
            xb_add(&bar[XB_XGEN(b.x)], 1u);
            asm volatile("s_waitcnt vmcnt(0)" ::: "memory");
        } else {
            XB_SPIN(xb_ld(&bar[XB_XGEN(b.x)]) == gen, bar);
            __builtin_amdgcn_fence(__ATOMIC_ACQUIRE, "agent");
            asm volatile("s_waitcnt vmcnt(0)" ::: "memory");
        }
    }
    __syncthreads();
}
struct Args { const float* in[33]; float* out; unsigned char* ws; int ph_lo, ph_hi; };
enum { I_XP = 0, I_XS, I_SHIFT, I_WKV, I_CK, I_CV, I_WIN, I_ALNG, I_ALNB, I_AWS, I_ABS, I_MU, I_W0, I_W2, I_A0, I_A2, I_KK, I_KA, I_RK, I_LNXG, I_LNXB, I_WOUT, I_LNG, I_LNB,
       I_CWIN, I_LQ1, I_LK1, I_LQ2, I_LK2, I_SUBG, I_CWOUT, I_CLNG, I_CLNB };

__device__ __forceinline__ void p0_transpose_item(const float* W, int K, int N, bf16* WT, LAS float* scr, int item, int lane, const float* kscale, const float* kbias, float* colsum, float* bwsum) {
    const int nblk = N / 64, kb = item / nblk, nb = item % nblk, k0 = 64 * kb, n0 = 64 * nb;
    const int r = lane >> 4, c4 = lane & 15;
    f32x4 cs = (f32x4){0.f, 0.f, 0.f, 0.f}, bs = (f32x4){0.f, 0.f, 0.f, 0.f};
    f32x4 v[16];
#pragma unroll
    for (int i = 0; i < 16; ++i) v[i] = *(const f32x4*)(W + (size_t)(k0 + 4 * i + r) * N + n0 + 4 * c4);
#pragma unroll
    for (int i = 0; i < 16; ++i) { const int kk = 4 * i + r; f32x4 x = v[i];
        if (kscale) { bs += x * kbias[k0 + kk]; x = x * kscale[k0 + kk];
#pragma unroll
            for (int q = 0; q < 4; ++q) x[q] = __builtin_bit_cast(float, f2bf(x[q]) << 16);
            cs += x; }
#pragma unroll
        for (int q = 0; q < 4; ++q) scr[kk * 65 + 4 * c4 + q] = x[q]; }
    if (kscale) {
#pragma unroll
        for (int q = 0; q < 4; ++q) { float a = cs[q], b = bs[q]; a += __shfl_xor(a, 16); a += __shfl_xor(a, 32); b += __shfl_xor(b, 16); b += __shfl_xor(b, 32);
            if (lane < 16) { unsafeAtomicAdd(colsum + n0 + 4 * c4 + q, a); unsafeAtomicAdd(bwsum + n0 + 4 * c4 + q, b); } } }
    asm volatile("s_waitcnt lgkmcnt(0)" ::: "memory");
    const int c = lane & 7, nr = lane >> 3;
#pragma unroll
    for (int j = 0; j < 8; ++j) { const int n = nr + 8 * j; const LAS float* s = scr + (8 * c) * 65 + n;
        u32x4 o; o.x = pk2(s[0 * 65], s[1 * 65]); o.y = pk2(s[2 * 65], s[3 * 65]); o.z = pk2(s[4 * 65], s[5 * 65]); o.w = pk2(s[6 * 65], s[7 * 65]);
        *(u32x4*)(WT + (size_t)(n0 + n) * K + k0 + 8 * c) = o; }
    asm volatile("s_waitcnt lgkmcnt(0)" ::: "memory");
}
__device__ __forceinline__ void row_f32_to_bf16(const float* src, bf16* dst, int lane) {
#pragma unroll
    for (int j = 0; j < 8; ++j) { const f32x4 v = ((const f32x4*)src)[lane + 64 * j]; u32x2 o; o.x = pk2(v[0], v[1]); o.y = pk2(v[2], v[3]); ((u32x2*)dst)[lane + 64 * j] = o; }
}
__device__ __forceinline__ void late_transposes(const Args& A, LAS unsigned char* lds, int w, int nw, int wave, int lane, float* colsum, float* bwsum) {
    unsigned char* ws = A.ws; LAS float* scr = (LAS float*)(lds + wave * 16640);
    constexpr int I2 = 32 * 32, I3 = 32 * (PCN / 64), I4 = 32 * 32;
    for (int it = w; it < I2 + I3 + I4; it += nw) {
        if (it < I2) p0_transpose_item(A.in[I_WOUT], DM, DM, (bf16*)(ws + WS_WTOUT), scr, it, lane, nullptr, nullptr, nullptr, nullptr);
        else if (it < I2 + I3) p0_transpose_item(A.in[I_CWIN], DM, PCN, (bf16*)(ws + WS_WTCIN), scr, it - I2, lane, A.in[I_LNG], A.in[I_LNB], colsum, bwsum);
        else p0_transpose_item(A.in[I_CWOUT], DM, DM, (bf16*)(ws + WS_WTCOUT), scr, it - I2 - I3, lane, nullptr, nullptr, nullptr, nullptr); }
}
__device__ __forceinline__ void p0_prologue(const Args& A, LAS unsigned char* lds, int vcu, int G, int wave, int lane, int tid, float* colsum, float* bwsum) {
    unsigned char* ws = A.ws;
    LAS float* scr = (LAS float*)(lds + wave * 16640);
    const int gw = vcu * 8 + wave, NGW = G * 8;
    constexpr int I1 = 32 * (PAB / 64), I2 = 32 * 32, I3 = 32 * (PCN / 64), I4 = 32 * 32;
    for (int it = gw; it < I1; it += NGW) p0_transpose_item(A.in[I_WIN], DM, PAB, (bf16*)(ws + WS_WTIN), scr, it, lane, nullptr, nullptr, nullptr, nullptr);
    { f32x4 nx[8];
#define P0_XROW(m_) ((m_) < MP ? A.in[I_XP] + (size_t)(m_) * DM : A.in[I_XS] + (size_t)((m_) - MP) * DM)
      if (gw < MT) {
#pragma unroll
          for (int j = 0; j < 8; ++j) nx[j] = ((const f32x4*)P0_XROW(gw))[lane + 64 * j]; }
      for (int m = gw; m < MT; m += NGW) { f32x4 cx[8];
#pragma unroll
          for (int j = 0; j < 8; ++j) cx[j] = nx[j];
          if (m + NGW < MT) {
#pragma unroll
              for (int j = 0; j < 8; ++j) nx[j] = ((const f32x4*)P0_XROW(m + NGW))[lane + 64 * j]; }
          bf16* dst = (bf16*)(ws + WS_XB) + (size_t)m * DM;
#pragma unroll
          for (int j = 0; j < 8; ++j) { u32x2 o; o.x = cvt_pk_bf16(cx[j][0], cx[j][1]); o.y = cvt_pk_bf16(cx[j][2], cx[j][3]); ((u32x2*)dst)[lane + 64 * j] = o; } }
#undef P0_XROW
    }
    const int gt = vcu * 512 + tid, NT = G * 512;
    for (int idx = gt; idx < 65536; idx += NT) { const int n = idx >> 6, k = idx & 63;
        ((bf16*)(ws + WS_W2T))[idx] = (bf16)f2bf(A.in[I_W2][k * 1024 + n]); ((bf16*)(ws + WS_A2T))[idx] = (bf16)f2bf(A.in[I_A2][k * 1024 + n]);
        const int t = (idx >> 7) & 127, s = idx & 127; ((bf16*)(ws + WS_WSB))[idx] = (s <= t) ? (bf16)f2bf(A.in[I_AWS][idx]) : (bf16)0; }
    for (int idx = gt; idx < 32768; idx += NT) ((u32x4*)((bf16*)(ws + WS_WTIN) + (size_t)PAB * DM))[idx] = (u32x4){0u, 0u, 0u, 0u};
}
constexpr int VN_ROW = 576, MO_ROW = 1040;
__device__ __forceinline__ s16x4 vtr(const LAS unsigned char* p) { typedef short v4i16_t __attribute__((ext_vector_type(4))); return __builtin_bit_cast(s16x4, __builtin_amdgcn_ds_read_tr16_b64_v4i16((LAS v4i16_t*)p)); }
__device__ __forceinline__ void mixer_a_unit(const Args& A, LAS unsigned char* lds, int ci, int g, int wave, int lane, int tid) {
    const bf16* PROJ = (const bf16*)(A.ws + WS_PROJ);
    bf16* OA = (bf16*)(A.ws + WS_XB);
    const bool prompt = ci < 128; const int m0 = prompt ? ci * 128 : MP + (ci - 128) * 64, L = prompt ? 128 : 64;
    LAS float* st = (LAS float*)lds; LAS unsigned char* vn = lds + 1024;
    for (int i0 = 0; i0 < 16; i0 += 4) { const int tokb = wave * 16 + i0; if (tokb < L) {
        u32x4 ra[4], rb[4];
#pragma unroll
        for (int i = 0; i < 4; ++i) { const bf16* row = PROJ + (size_t)(m0 + tokb + i) * PABP + COL_VA + lane * 16; ra[i] = *(const u32x4*)row; rb[i] = *(const u32x4*)(row + 8); }
#pragma unroll
        for (int i = 0; i < 4; ++i) { float a[8], b[8]; unpack8(ra[i], a); unpack8(rb[i], b); float s = 0.f;
#pragma unroll
            for (int j = 0; j < 8; ++j) s += a[j] + b[j];
            const float mean = wave_sum(s) * (1.f / 1024.f); float q = 0.f;
#pragma unroll
            for (int j = 0; j < 8; ++j) { const float d0 = a[j] - mean, d1 = b[j] - mean; q += d0 * d0 + d1 * d1; }
            const float rstd = 1.0f / sqrtf(wave_sum(q) * (1.f / 1024.f) + 1e-5f);
            if (lane == 0) { st[2 * (tokb + i)] = mean; st[2 * (tokb + i) + 1] = rstd; } } } }
    __syncthreads();
    { const int s = tid & 127, og = tid >> 7;
      if (s < L) { const float mean = st[2 * s], rstd = st[2 * s + 1];
        u32x4 xr[8];
#pragma unroll
        for (int it = 0; it < 8; ++it) xr[it] = *(const u32x4*)(PROJ + (size_t)(m0 + s) * PABP + COL_VA + g * 256 + (it * 4 + og) * 8);
#pragma unroll
        for (int it = 0; it < 8; ++it) { const int oct = it * 4 + og, c0 = g * 256 + oct * 8;
            float x[8]; unpack8(xr[it], x);
            const f32x4 g0 = *(const f32x4*)(A.in[I_ALNG] + c0), g1 = *(const f32x4*)(A.in[I_ALNG] + c0 + 4), b0 = *(const f32x4*)(A.in[I_ALNB] + c0), b1 = *(const f32x4*)(A.in[I_ALNB] + c0 + 4);
            float v[8];
#pragma unroll
            for (int j = 0; j < 4; ++j) { v[j] = (x[j] - mean) * rstd * g0[j] + b0[j]; v[4 + j] = (x[4 + j] - mean) * rstd * g1[j] + b1[j]; }
            if (!prompt) { float* o = A.out + O6 + (size_t)((ci - 128) * 64 + s) * 1024 + c0;
                *(f32x4*)o = (f32x4){v[0], v[1], v[2], v[3]}; *(f32x4*)(o + 4) = (f32x4){v[4], v[5], v[6], v[7]}; }
            u32x4 w; w.x = pk2(v[0], v[1]); w.y = pk2(v[2], v[3]); w.z = pk2(v[4], v[5]); w.w = pk2(v[6], v[7]);
            *(LAS u32x4*)(vn + s * VN_ROW + oct * 16) = w; } } }
    __syncthreads();
    const int ti = wave & 3, ch = wave >> 2, r32 = lane & 31, hi = lane >> 5;
    const bool active = ti * 32 < L;
    f32x16 acc[4];
#pragma unroll
    for (int c = 0; c < 4; ++c) acc[c] = (f32x16){0.f};
    if (active) {
        const bf16* Wg = (const bf16*)(A.ws + WS_WSB) + g * 16384 + (32 * ti + r32) * 128 + 4 * hi;
        const LAS unsigned char* vb = vn + (4 * hi + ((lane & 15) >> 2)) * VN_ROW + (ch * 128 + ((lane >> 4) & 1) * 16 + (lane & 3) * 4) * 2;
        for (int ks = 0; ks <= 2 * ti + 1; ++ks) {
            const u32x2 w0 = *(const u32x2*)(Wg + 16 * ks), w1 = *(const u32x2*)(Wg + 16 * ks + 8);
            const bf16x8 af = __builtin_bit_cast(bf16x8, (u32x4){w0.x, w0.y, w1.x, w1.y});
#pragma unroll
            for (int c = 0; c < 4; ++c) { const s16x4 lo = vtr(vb + (16 * ks) * VN_ROW + c * 64), hh = vtr(vb + (16 * ks + 8) * VN_ROW + c * 64);
                const bf16x8 bfr = (bf16x8){lo[0], lo[1], lo[2], lo[3], hh[0], hh[1], hh[2], hh[3]};
                acc[c] = __builtin_amdgcn_mfma_f32_32x32x16_bf16(af, bfr, acc[c], 0, 0, 0); } }
    }
    __syncthreads();
    if (active) {
        LAS unsigned char* ob = vn;
#pragma unroll
        for (int reg = 0; reg < 16; ++reg) { const int t = 32 * ti + (reg & 3) + 8 * (reg >> 2) + 4 * hi;
#pragma unroll
            for (int c = 0; c < 4; ++c) *(LAS float*)(ob + t * MO_ROW + (32 * (ch * 4 + c) + r32) * 4) = acc[c][reg]; }
    }
    __syncthreads();
    for (int it = 0; it < 8; ++it) { const int item = tid + 512 * it, t = item >> 5, oc = item & 31;
        if (t < L) { const size_t m = (size_t)(m0 + t); const int col = g * 256 + oc * 8;
            const f32x4 o0 = *(const LAS f32x4*)(vn + t * MO_ROW + oc * 32), o1 = *(const LAS f32x4*)(vn + t * MO_ROW + oc * 32 + 16);
            float u[8], ga[8]; unpack8(*(const u32x4*)(PROJ + m * PABP + col), u); unpack8(*(const u32x4*)(PROJ + m * PABP + COL_GA + col), ga);
            const float bias = A.in[I_ABS][g * 128 + t]; float r[8];
#pragma unroll
            for (int j = 0; j < 4; ++j) { r[j] = u[j] * (o0[j] + bias) * siluf_(ga[j]); r[4 + j] = u[4 + j] * (o1[j] + bias) * siluf_(ga[4 + j]); }
            u32x4 w; w.x = pk2(r[0], r[1]); w.y = pk2(r[2], r[3]); w.z = pk2(r[4], r[5]); w.w = pk2(r[6], r[7]);
            *(u32x4*)(OA + m * DM + col) = w; } }
    __syncthreads();
}
constexpr int SCAN_TS = 32, SCAN_BUF = 45184, SCAN_SCR = 2 * SCAN_BUF, SCAN_SCRW = 6400;
__device__ __forceinline__ float dpp_add16(float x) {
    x += __builtin_bit_cast(float, __builtin_amdgcn_update_dpp(0, __builtin_bit_cast(int, x), 0xB1, 0xF, 0xF, true));
    x += __builtin_bit_cast(float, __builtin_amdgcn_update_dpp(0, __builtin_bit_cast(int, x), 0x4E, 0xF, 0xF, true));
    x += __builtin_bit_cast(float, __builtin_amdgcn_update_dpp(0, __builtin_bit_cast(int, x), 0x124, 0xF, 0xF, true));
    x += __builtin_bit_cast(float, __builtin_amdgcn_update_dpp(0, __builtin_bit_cast(int, x), 0x128, 0xF, 0xF, true));
    return x;
}
struct PrepRegs { u32x4 cur[5], prv[5]; };
struct ScanCtx { const bf16* rowbase; const float* shift; float* bon; int T; int hd; int qr; };
__device__ __forceinline__ void prep_load(PrepRegs& R, const ScanCtx& C, int t, int oc) {
    const bf16* cur = C.rowbase + (size_t)t * PABP;
    const int o0 = C.hd * 64 + oc * 8;
    R.cur[0] = *(const u32x4*)(cur + o0); R.cur[1] = *(const u32x4*)(cur + 1024 + o0); R.cur[2] = *(const u32x4*)(cur + 2048 + o0);
    R.cur[3] = *(const u32x4*)(cur + 3072 + oc * 8); R.cur[4] = *(const u32x4*)(cur + 3136 + oc * 8);
    if (t > 0) { const bf16* p = cur - PABP;
        R.prv[0] = *(const u32x4*)(p + o0); R.prv[1] = *(const u32x4*)(p + 1024 + o0); R.prv[2] = *(const u32x4*)(p + 2048 + o0);
        R.prv[3] = *(const u32x4*)(p + 3072 + oc * 8); R.prv[4] = *(const u32x4*)(p + 3136 + oc * 8); }
}
__device__ __forceinline__ void lerp8(const u32x4 cur, const u32x4 prv, bool first, const float* shift, const f32x4 m0, const f32x4 m1, float (&o)[8]) {
    float c[8], p[8]; unpack8(cur, c);
    if (!first) unpack8(prv, p);
    else if (shift) { const f32x4 a = *(const f32x4*)shift, b = *(const f32x4*)(shift + 4);
#pragma unroll
        for (int j = 0; j < 4; ++j) { p[j] = a[j]; p[4 + j] = b[j]; } }
    else {
#pragma unroll
        for (int j = 0; j < 8; ++j) p[j] = 0.f; }
#pragma unroll
    for (int j = 0; j < 4; ++j) { o[j] = c[j] + (p[j] - c[j]) * m0[j]; o[4 + j] = c[4 + j] + (p[4 + j] - c[4 + j]) * m1[j]; }
}
constexpr int CH_T = 32;
#ifndef S1_X2
#define S1_X2 1
#endif
#ifndef S1_PF
#define S1_PF 1
#endif
constexpr size_t WS_CHGC = 217 * MiB, WS_CHMCT = 220 * MiB, WS_CHNN = 286 * MiB, WS_CHQ1 = 352 * MiB, WS_CHQ2 = 385 * MiB;
constexpr int S1_TOT = 20992, S1_HALF0 = 23040, S1_HSZ = 59392;
constexpr int S1_KKP = 0, S1_RP = 4608, S1_BM = 9216, S1_KM = 13824, S1_VT = 18432, S1_BST = 23552, S1_KST = 28672, S1_R2 = 33792;
constexpr int S1_U = S1_BM;
constexpr int S1_AAB = S1_R2, S1_AKK = S1_R2 + 4608, S1_ARB = S1_AKK + 2560, S1_ARK = S1_ARB + 2560, S1_P1T = S1_ARK + 2560, S1_P2T = S1_P1T + 5120;
__device__ __forceinline__ f32x16 mm32(const LAS unsigned char* a, int astride, const LAS unsigned char* b, int bstride, int ksteps, int r32, int hi, f32x16 acc) {
    for (int ks = 0; ks < ksteps; ++ks) acc = __builtin_amdgcn_mfma_f32_32x32x16_bf16(*(const LAS bf16x8*)(a + r32 * astride + (16 * ks + 8 * hi) * 2), *(const LAS bf16x8*)(b + r32 * bstride + (16 * ks + 8 * hi) * 2), acc, 0, 0, 0);
    return acc;
}
__device__ __forceinline__ void s1_subst(LAS unsigned char* H, int lane, int SRC) {
    f32x2 z[16];
    if (SRC == 0) {
#pragma unroll
        for (int tt = 0; tt < 32; ++tt) z[tt >> 1][tt & 1] = bf1(*(const LAS bf16*)(H + S1_KKP + tt * 144 + lane * 2)); }
    else {
#pragma unroll
        for (int tt = 0; tt < 32; ++tt) z[tt >> 1][tt & 1] = *(const LAS float*)(H + S1_U + tt * 272 + lane * 4); }
#pragma unroll
    for (int j = 0; j < 31; ++j) {
        const float zj = z[j >> 1][j & 1]; const f32x2 zz = (f32x2){zj, zj};
        int dep = 0; if (j >= 1) asm volatile("" : "+v"(dep) : "v"(z[(j - 1) >> 1][(j - 1) & 1]));
#pragma unroll
        for (int i4 = (j + 1) >> 2; i4 < 8; ++i4) { const f32x4 a4 = *(const LAS f32x4*)(H + S1_AAB + j * 144 + i4 * 16 + dep);
#pragma unroll
            for (int h = 0; h < 2; ++h) { const int p = 2 * i4 + h, r0 = 2 * p;
                if (r0 > j) z[p] -= (f32x2){a4[2 * h], a4[2 * h + 1]} * zz;
                else if (r0 + 1 > j) z[p][1] -= a4[2 * h + 1] * zj; } }
    }
    LAS unsigned char* dst = H + (SRC == 0 ? S1_P1T : S1_P2T) + lane * 80;
#pragma unroll
    for (int q = 0; q < 4; ++q) *(LAS u32x4*)(dst + q * 16) = (u32x4){cvt_pk_bf16(z[4 * q][0], z[4 * q][1]), cvt_pk_bf16(z[4 * q + 1][0], z[4 * q + 1][1]), cvt_pk_bf16(z[4 * q + 2][0], z[4 * q + 2][1]), cvt_pk_bf16(z[4 * q + 3][0], z[4 * q + 3][1])};
}
__device__ __forceinline__ void s1_consts(const Args& A, LAS unsigned char* lds, int hd, int tid) {
    const int n = tid >> 3, chk = tid & 7;
    *(LAS u32x4*)(lds + n * 144 + chk * 16) = *(const u32x4*)((const bf16*)(A.ws + WS_W2T) + (size_t)(hd * 64 + n) * 64 + chk * 8);
    *(LAS u32x4*)(lds + 9216 + n * 144 + chk * 16) = *(const u32x4*)((const bf16*)(A.ws + WS_A2T) + (size_t)(hd * 64 + n) * 64 + chk * 8);
    for (int i = tid; i < 640; i += 512) { const int which = i >> 6, chn = i & 63; float v;
        if (which < 3) v = A.in[I_MU][which * 1024 + hd * 64 + chn]; else if (which == 3) v = A.in[I_MU][3072 + chn]; else if (which == 4) v = A.in[I_MU][3136 + chn];
        else v = A.in[which == 5 ? I_KK : which == 6 ? I_KA : which == 7 ? I_RK : which == 8 ? I_W0 : I_A0][hd * 64 + chn];
        ((LAS float*)(lds + 18432))[i] = v; }
}
__device__ __forceinline__ void s1_unit(const Args& A, LAS unsigned char* lds, int seq, int hd, int cpair, PrepRegs& R, bool preloaded, bool more, int wave, int lane, int tid
#ifdef S1_SEC
    , unsigned long long (&s1ts)[8], unsigned long long& s1tl
#endif
    ) {
    const bool prompt = seq < NBP; const int bs = prompt ? seq : seq - NBP;
    const int mbase = prompt ? bs * SEQ : MP + bs * DSQ, nchunk = prompt ? SEQ / CH_T : DSQ / CH_T;
    const int half = wave >> 2, hw = wave & 3, chunk = 2 * cpair + half, t0 = chunk * CH_T;
    const size_t cid = (prompt ? (size_t)(bs * 16 + hd) * (SEQ / CH_T) : (size_t)NBP * 16 * (SEQ / CH_T) + (size_t)(bs * 16 + hd) * (DSQ / CH_T)) + chunk;
    ScanCtx C; C.rowbase = (const bf16*)(A.ws + WS_PROJ) + (size_t)mbase * PABP + COL_HB; C.shift = prompt ? nullptr : A.in[I_SHIFT] + (size_t)bs * DSH; C.T = nchunk * CH_T; C.hd = hd; C.qr = 0;
    C.bon = (float*)(A.ws + WS_SCANIN) + (size_t)mbase * 16 + hd;
    const LAS unsigned char* cst = lds; LAS unsigned char* H = lds + S1_HALF0 + half * S1_HSZ;
    const int r32 = lane & 31, hi = lane >> 5;
    const int tl8 = lane >> 3, oc = lane & 7, tl = hw * 8 + tl8, t = t0 + tl, c0 = hd * 64 + oc * 8;
    if (!preloaded) prep_load(R, C, t, oc);
    const LAS float* cf = (const LAS float*)(cst + 18432); const bool first = (t == 0);
#define CF8(w) *(const LAS f32x4*)(cf + (w) * 64 + oc * 8), *(const LAS f32x4*)(cf + (w) * 64 + oc * 8 + 4)
    float hr[8], hk[8], hv[8], hwl[8], ha[8];
    lerp8(R.cur[0], R.prv[0], first, C.shift ? C.shift + c0 : nullptr, CF8(0), hr);
    lerp8(R.cur[1], R.prv[1], first, C.shift ? C.shift + 1024 + c0 : nullptr, CF8(1), hk);
    lerp8(R.cur[2], R.prv[2], first, C.shift ? C.shift + 2048 + c0 : nullptr, CF8(2), hv);
    lerp8(R.cur[3], R.prv[3], first, C.shift ? C.shift + 3072 + oc * 8 : nullptr, CF8(3), hwl);
    lerp8(R.cur[4], R.prv[4], first, C.shift ? C.shift + 3136 + oc * 8 : nullptr, CF8(4), ha);
    LAS unsigned char* scr = H + S1_R2 + hw * 6400;
    LAS unsigned char* wl = scr, * al = scr + 1152; LAS float* ea = (LAS float*)(scr + 2304);
    { u32x4 w;
#pragma unroll
      for (int j = 0; j < 8; ++j) hwl[j] = 1.f - 2.f * __builtin_amdgcn_rcpf(__expf(2.f * hwl[j]) + 1.f);
      w.x = cvt_pk_bf16(hwl[0], hwl[1]); w.y = cvt_pk_bf16(hwl[2], hwl[3]); w.z = cvt_pk_bf16(hwl[4], hwl[5]); w.w = cvt_pk_bf16(hwl[6], hwl[7]); *(LAS u32x4*)(wl + tl8 * 144 + oc * 16) = w;
      w.x = cvt_pk_bf16(ha[0], ha[1]); w.y = cvt_pk_bf16(ha[2], ha[3]); w.z = cvt_pk_bf16(ha[4], ha[5]); w.w = cvt_pk_bf16(ha[6], ha[7]); *(LAS u32x4*)(al + tl8 * 144 + oc * 16) = w; }
    { const int row = lane & 15, kg = lane >> 4; typedef float f32x4_t __attribute__((ext_vector_type(4)));
      const LAS unsigned char* w2t = cst + row * 144 + 16 * kg; const LAS unsigned char* a2t = cst + 9216 + row * 144 + 16 * kg;
      const bf16x8 aw0 = *(const LAS bf16x8*)(wl + (row & 7) * 144 + (8 * kg) * 2), aw1 = *(const LAS bf16x8*)(wl + (row & 7) * 144 + (32 + 8 * kg) * 2);
      const bf16x8 aa0 = *(const LAS bf16x8*)(al + (row & 7) * 144 + (8 * kg) * 2), aa1 = *(const LAS bf16x8*)(al + (row & 7) * 144 + (32 + 8 * kg) * 2);
#pragma unroll
      for (int nb = 0; nb < 4; ++nb) { f32x4_t dw = (f32x4_t){0.f, 0.f, 0.f, 0.f}, da = (f32x4_t){0.f, 0.f, 0.f, 0.f};
          dw = __builtin_amdgcn_mfma_f32_16x16x32_bf16(aw0, *(const LAS bf16x8*)(w2t + nb * 2304), dw, 0, 0, 0); dw = __builtin_amdgcn_mfma_f32_16x16x32_bf16(aw1, *(const LAS bf16x8*)(w2t + nb * 2304 + 64), dw, 0, 0, 0);
          da = __builtin_amdgcn_mfma_f32_16x16x32_bf16(aa0, *(const LAS bf16x8*)(a2t + nb * 2304), da, 0, 0, 0); da = __builtin_amdgcn_mfma_f32_16x16x32_bf16(aa1, *(const LAS bf16x8*)(a2t + nb * 2304 + 64), da, 0, 0, 0);
          if (lane < 32) { const int n = nb * 16 + row;
#pragma unroll
              for (int r = 0; r < 4; ++r) { const int tok = 4 * kg + r; ea[(tok * 2 + 0) * 64 + n] = dw[r]; ea[(tok * 2 + 1) * 64 + n] = da[r]; } } } }
    float ev[8], av[8];
    { const f32x4 e0 = *(const LAS f32x4*)(ea + (tl8 * 2 + 0) * 64 + oc * 8), e1 = *(const LAS f32x4*)(ea + (tl8 * 2 + 0) * 64 + oc * 8 + 4);
      const f32x4 a0 = *(const LAS f32x4*)(ea + (tl8 * 2 + 1) * 64 + oc * 8), a1 = *(const LAS f32x4*)(ea + (tl8 * 2 + 1) * 64 + oc * 8 + 4);
      const f32x4 w00 = *(const LAS f32x4*)(cf + 512 + oc * 8), w01 = *(const LAS f32x4*)(cf + 512 + oc * 8 + 4), a00 = *(const LAS f32x4*)(cf + 576 + oc * 8), a01 = *(const LAS f32x4*)(cf + 576 + oc * 8 + 4);
#pragma unroll
      for (int j = 0; j < 4; ++j) { ev[j] = 0.60653065971f * sigmoidf_(e0[j] + w00[j]); ev[4 + j] = 0.60653065971f * sigmoidf_(e1[j] + w01[j]); av[j] = sigmoidf_(a0[j] + a00[j]); av[4 + j] = sigmoidf_(a1[j] + a01[j]); } }
    const f32x4 kks0 = *(const LAS f32x4*)(cf + 320 + oc * 8), kks1 = *(const LAS f32x4*)(cf + 320 + oc * 8 + 4), ka0 = *(const LAS f32x4*)(cf + 384 + oc * 8), ka1 = *(const LAS f32x4*)(cf + 384 + oc * 8 + 4);
    const f32x4 rk0 = *(const LAS f32x4*)(cf + 448 + oc * 8), rk1 = *(const LAS f32x4*)(cf + 448 + oc * 8 + 4);
#undef CF8
    float kkv[8], km[8], bb[8], ssq = 0.f, bon = 0.f, Lc[8];
#pragma unroll
    for (int j = 0; j < 8; ++j) { const float kks = j < 4 ? kks0[j & 3] : kks1[j & 3], ka = j < 4 ? ka0[j & 3] : ka1[j & 3], rk = j < 4 ? rk0[j & 3] : rk1[j & 3];
        kkv[j] = hk[j] * kks; ssq += kkv[j] * kkv[j]; km[j] = hk[j] * (1.f + (av[j] - 1.f) * ka); bon += hr[j] * km[j] * rk; }
    ssq += __shfl_xor(ssq, 1); ssq += __shfl_xor(ssq, 2); ssq += __shfl_xor(ssq, 4);
    bon += __shfl_xor(bon, 1); bon += __shfl_xor(bon, 2); bon += __shfl_xor(bon, 4);
    if (oc == 0) C.bon[(size_t)t * 16] = bon;
    const float inv = 1.0f / fmaxf(sqrtf(ssq), 1e-12f);
#pragma unroll
    for (int j = 0; j < 8; ++j) { kkv[j] *= inv; bb[j] = kkv[j] * av[j];
        float s = -ev[j]; float u;
        u = __shfl_up(s, 8); if (tl8 >= 1) s += u;
        u = __shfl_up(s, 16); if (tl8 >= 2) s += u;
        u = __shfl_up(s, 32); if (tl8 >= 4) s += u;
        Lc[j] = s; }
    LAS float* tot = (LAS float*)(lds + S1_TOT) + half * 256;
    if (tl8 == 7) { *(LAS f32x4*)(tot + hw * 64 + oc * 8) = (f32x4){Lc[0], Lc[1], Lc[2], Lc[3]}; *(LAS f32x4*)(tot + hw * 64 + oc * 8 + 4) = (f32x4){Lc[4], Lc[5], Lc[6], Lc[7]}; }
    __syncthreads();
#ifdef S1_SEC
    { const unsigned long long t_ = __builtin_amdgcn_s_memrealtime(); s1ts[0] += t_ - s1tl; s1tl = t_; }
#endif
    float LC[8];
    { float pre[8];
#pragma unroll
      for (int j = 0; j < 8; ++j) { pre[j] = 0.f; LC[j] = 0.f; }
#pragma unroll
      for (int w2 = 0; w2 < 4; ++w2) { const f32x4 x0 = *(const LAS f32x4*)(tot + w2 * 64 + oc * 8), x1 = *(const LAS f32x4*)(tot + w2 * 64 + oc * 8 + 4);
#pragma unroll
          for (int j = 0; j < 4; ++j) { LC[j] += x0[j]; LC[4 + j] += x1[j]; if (w2 < hw) { pre[j] += x0[j]; pre[4 + j] += x1[j]; } } }
#pragma unroll
      for (int j = 0; j < 8; ++j) Lc[j] += pre[j]; }
    { float kkp[8], rp[8], bm[8], kmm[8], bsv[8], ksv[8];
#pragma unroll
      for (int j = 0; j < 8; ++j) { const float g = __expf(Lc[j]), ig = __builtin_amdgcn_rcpf(g), gp = g * __expf(ev[j]), gr = __expf(LC[j]) * ig;
          kkp[j] = kkv[j] * gp; rp[j] = hr[j] * g; bm[j] = bb[j] * ig; kmm[j] = km[j] * ig; bsv[j] = bb[j] * gr; ksv[j] = km[j] * gr; }
      *(LAS u32x4*)(H + S1_KKP + tl * 144 + oc * 16) = (u32x4){cvt_pk_bf16(kkp[0], kkp[1]), cvt_pk_bf16(kkp[2], kkp[3]), cvt_pk_bf16(kkp[4], kkp[5]), cvt_pk_bf16(kkp[6], kkp[7])};
      *(LAS u32x4*)(H + S1_RP + tl * 144 + oc * 16) = (u32x4){cvt_pk_bf16(rp[0], rp[1]), cvt_pk_bf16(rp[2], rp[3]), cvt_pk_bf16(rp[4], rp[5]), cvt_pk_bf16(rp[6], rp[7])};
      *(LAS u32x4*)(H + S1_BM + tl * 144 + oc * 16) = (u32x4){cvt_pk_bf16(bm[0], bm[1]), cvt_pk_bf16(bm[2], bm[3]), cvt_pk_bf16(bm[4], bm[5]), cvt_pk_bf16(bm[6], bm[7])};
      *(LAS u32x4*)(H + S1_KM + tl * 144 + oc * 16) = (u32x4){cvt_pk_bf16(kmm[0], kmm[1]), cvt_pk_bf16(kmm[2], kmm[3]), cvt_pk_bf16(kmm[4], kmm[5]), cvt_pk_bf16(kmm[6], kmm[7])};
#pragma unroll
      for (int j = 0; j < 8; ++j) { const int ch = oc * 8 + j;
          *(LAS bf16*)(H + S1_VT + ch * 80 + tl * 2) = (bf16)f2bf(hv[j]); *(LAS bf16*)(H + S1_BST + ch * 80 + tl * 2) = (bf16)f2bf(bsv[j]); *(LAS bf16*)(H + S1_KST + ch * 80 + tl * 2) = (bf16)f2bf(ksv[j]); }
      if (tl == CH_T - 1) { float* gc = (float*)(A.ws + WS_CHGC) + cid * 64 + oc * 8;
          *(f32x4*)gc = (f32x4){__expf(LC[0]), __expf(LC[1]), __expf(LC[2]), __expf(LC[3])}; *(f32x4*)(gc + 4) = (f32x4){__expf(LC[4]), __expf(LC[5]), __expf(LC[6]), __expf(LC[7])}; } }
    if (more) prep_load(R, C, t + 2 * CH_T, oc);
    __syncthreads();
#ifdef S1_SEC
    { const unsigned long long t_ = __builtin_amdgcn_s_memrealtime(); s1ts[1] += t_ - s1tl; s1tl = t_; }
#endif
    { f32x16 acc = (f32x16){0.f};
      acc = mm32(H + ((hw & 2) ? S1_RP : S1_KKP), 144, H + ((hw & 1) ? S1_KM : S1_BM), 144, 4, r32, hi, acc);
      const bool strict = hw < 2;
#pragma unroll
      for (int r = 0; r < 16; ++r) { const int tt = (r & 3) + 8 * (r >> 2) + 4 * hi; acc[r] = (r32 < tt + (strict ? 0 : 1)) ? acc[r] : 0.f; }
      if (hw == 0) {
#pragma unroll
          for (int g = 0; g < 4; ++g) *(LAS f32x4*)(H + S1_AAB + r32 * 144 + (8 * g + 4 * hi) * 4) = (f32x4){acc[4 * g], acc[4 * g + 1], acc[4 * g + 2], acc[4 * g + 3]}; }
      else {
#pragma unroll
          for (int r = 0; r < 16; ++r) { const int tt = (r & 3) + 8 * (r >> 2) + 4 * hi; *(LAS bf16*)(H + (hw == 1 ? S1_AKK : hw == 2 ? S1_ARB : S1_ARK) + tt * 80 + r32 * 2) = (bf16)f2bf(acc[r]); } } }
    __syncthreads();
#ifdef S1_SEC
    { const unsigned long long t_ = __builtin_amdgcn_s_memrealtime(); s1ts[2] += t_ - s1tl; s1tl = t_; }
#endif
    if (hw < 2) { f32x16 acc = (f32x16){0.f};
      acc = mm32(H + S1_AKK, 80, H + S1_VT + hw * 32 * 80, 80, 2, r32, hi, acc);
#pragma unroll
      for (int r = 0; r < 16; ++r) { const int tt = (r & 3) + 8 * (r >> 2) + 4 * hi; *(LAS float*)(H + S1_U + tt * 272 + (hw * 32 + r32) * 4) = acc[r]; } }
    __syncthreads();
#ifdef S1_SEC
    { const unsigned long long t_ = __builtin_amdgcn_s_memrealtime(); s1ts[3] += t_ - s1tl; s1tl = t_; }
#endif
#if defined(S1_CUT) && S1_CUT == 2
    return;
#endif
    if (hw < 2) s1_subst(H, lane, hw);
    __syncthreads();
#ifdef S1_SEC
    { const unsigned long long t_ = __builtin_amdgcn_s_memrealtime(); s1ts[4] += t_ - s1tl; s1tl = t_; }
#endif
#if defined(S1_CUT) && S1_CUT == 3
    return;
#endif
    { const int mb = hw >> 1, nb = hw & 1;
      { f32x16 acc = (f32x16){0.f};
        acc = mm32(H + S1_BST + mb * 32 * 80, 80, H + S1_P1T + nb * 32 * 80, 80, 2, r32, hi, acc);
        bf16* o = (bf16*)(A.ws + WS_CHMCT) + cid * 4096;
#pragma unroll
        for (int r = 0; r < 16; ++r) o[(mb * 32 + (r & 3) + 8 * (r >> 2) + 4 * hi) * 64 + nb * 32 + r32] = (bf16)f2bf(acc[r]); }
      { f32x16 acc = (f32x16){0.f}, acc2 = (f32x16){0.f};
        acc = mm32(H + S1_VT + mb * 32 * 80, 80, H + S1_KST + nb * 32 * 80, 80, 2, r32, hi, acc);
        acc2 = mm32(H + S1_P2T + mb * 32 * 80, 80, H + S1_BST + nb * 32 * 80, 80, 2, r32, hi, acc2);
        u32x4* o = (u32x4*)((bf16*)(A.ws + WS_CHNN) + cid * 4096 + (size_t)((mb * 2 + nb) * 64 + lane) * 16);
        o[0] = (u32x4){cvt_pk_bf16(acc[0] - acc2[0], acc[1] - acc2[1]), cvt_pk_bf16(acc[2] - acc2[2], acc[3] - acc2[3]), cvt_pk_bf16(acc[4] - acc2[4], acc[5] - acc2[5]), cvt_pk_bf16(acc[6] - acc2[6], acc[7] - acc2[7])};
        o[1] = (u32x4){cvt_pk_bf16(acc[8] - acc2[8], acc[9] - acc2[9]), cvt_pk_bf16(acc[10] - acc2[10], acc[11] - acc2[11]), cvt_pk_bf16(acc[12] - acc2[12], acc[13] - acc2[13]), cvt_pk_bf16(acc[14] - acc2[14], acc[15] - acc2[15])}; }
      if (hw < 2) { f32x16 acc = (f32x16){0.f};
        acc = mm32(H + S1_ARB, 80, H + S1_P1T + hw * 32 * 80, 80, 2, r32, hi, acc);
        bf16* o = (bf16*)(A.ws + WS_CHQ1) + cid * 2048;
#pragma unroll
        for (int r = 0; r < 16; ++r) { const int tt = (r & 3) + 8 * (r >> 2) + 4 * hi; o[tt * 64 + hw * 32 + r32] = (bf16)f2bf(bf1(*(const LAS bf16*)(H + S1_RP + tt * 144 + (hw * 32 + r32) * 2)) - acc[r]); } }
      else { const int vb = hw - 2; f32x16 acc = (f32x16){0.f}, acc2 = (f32x16){0.f};
        acc = mm32(H + S1_ARK, 80, H + S1_VT + vb * 32 * 80, 80, 2, r32, hi, acc);
        acc2 = mm32(H + S1_ARB, 80, H + S1_P2T + vb * 32 * 80, 80, 2, r32, hi, acc2);
        f32x4* o = (f32x4*)((float*)(A.ws + WS_CHQ2) + cid * 2048 + (size_t)(vb * 64 + lane) * 16);
#pragma unroll
        for (int q = 0; q < 4; ++q) o[q] = (f32x4){acc[4 * q] - acc2[4 * q], acc[4 * q + 1] - acc2[4 * q + 1], acc[4 * q + 2] - acc2[4 * q + 2], acc[4 * q + 3] - acc2[4 * q + 3]}; } }
    __syncthreads();
#ifdef S1_SEC
    { const unsigned long long t_ = __builtin_amdgcn_s_memrealtime(); s1ts[5] += t_ - s1tl; s1tl = t_; }
#endif
}
__device__ __forceinline__ void s2_put(const f32x16& S, LAS unsigned char* buf, int vb, int kb, int r32, int hi) {
#pragma unroll
    for (int r = 0; r < 16; r += 2) { const unsigned ph = cvt_pk_bf16(S[r], S[r + 1]);
        const float r0 = S[r] - __builtin_bit_cast(float, ph << 16), r1 = S[r + 1] - __builtin_bit_cast(float, ph & 0xffff0000u);
        const unsigned pl = cvt_pk_bf16(r0, r1);
        const int v0 = vb * 32 + (r & 3) + 8 * (r >> 2) + 4 * hi; LAS unsigned char* p = buf + v0 * 144 + (kb * 32 + r32) * 2;
        *(LAS bf16*)p = (bf16)(ph & 0xffffu); *(LAS bf16*)(p + 144) = (bf16)(ph >> 16); *(LAS bf16*)(p + 9216) = (bf16)(pl & 0xffffu); *(LAS bf16*)(p + 9216 + 144) = (bf16)(pl >> 16); }
}
constexpr int S2_BUF = 18432;
typedef __attribute__((address_space(1))) float gfloat_t;
__device__ __forceinline__ void s2_unit(const Args& A, LAS unsigned char* lds, int seq, int hd, int wave, int lane) {
    const bool prompt = seq < NBP; const int bs = prompt ? seq : seq - NBP;
    const int mbase = prompt ? bs * SEQ : MP + bs * DSQ, nchunk = prompt ? SEQ / CH_T : DSQ / CH_T;
    const size_t cid0 = prompt ? (size_t)(bs * 16 + hd) * (SEQ / CH_T) : (size_t)NBP * 16 * (SEQ / CH_T) + (size_t)(bs * 16 + hd) * (DSQ / CH_T);
    const int r32 = lane & 31, hi = lane >> 5;
    const int vb = wave >> 1, kb = wave & 1;
    f32x16 S = (f32x16){0.f};
    if (wave < 4) {
        if (!prompt) {
#pragma unroll
            for (int r = 0; r < 16; ++r) S[r] = A.in[I_WKV][((size_t)(bs * 16 + hd) * 64 + vb * 32 + (r & 3) + 8 * (r >> 2) + 4 * hi) * 64 + kb * 32 + r32]; }
        s2_put(S, lds, vb, kb, r32, hi);
    }
    __syncthreads();
#define S2_BAR() do { asm volatile("s_waitcnt lgkmcnt(0)" ::: "memory"); __builtin_amdgcn_s_barrier(); } while (0)
    struct S2Ops { bf16x8 fr[4]; float gc; float blk[16]; u32x4 nb0, nb1; };
#ifdef S2_AMP
    const unsigned long long tamp0 = __builtin_amdgcn_s_memrealtime();
#endif
#ifdef S2_SEC
    unsigned long long tsec[5] = {0, 0, 0, 0, 0}; unsigned long long tlast = __builtin_amdgcn_s_memrealtime();
#endif
    if (wave < 4) {
#define S2_LOAD(O_, n_) do { const size_t cid_ = cid0 + (n_); const bf16* mct = (const bf16*)(A.ws + WS_CHMCT) + cid_ * 4096 + (size_t)(kb * 32 + r32) * 64 + 8 * hi; \
            _Pragma("unroll") for (int ks = 0; ks < 4; ++ks) O_.fr[ks] = *(const bf16x8*)(mct + 16 * ks); \
            O_.gc = ((const float*)(A.ws + WS_CHGC))[cid_ * 64 + kb * 32 + r32]; \
            const u32x4* nn = (const u32x4*)((const bf16*)(A.ws + WS_CHNN) + cid_ * 4096 + (size_t)((vb * 2 + kb) * 64 + lane) * 16); \
            O_.nb0 = nn[0]; O_.nb1 = nn[1]; } while (0)
#ifdef S2_SEC
#define S2_TS(k) do { const unsigned long long t_ = __builtin_amdgcn_s_memrealtime(); tsec[k] += t_ - tlast; tlast = t_; } while (0)
#else
#define S2_TS(k) do {} while (0)
#endif
#define S2_STEP(O_, n_) do { const LAS unsigned char* sb = lds + ((n_) & 1) * S2_BUF; f32x16 acc = (f32x16){0.f}, acc2 = (f32x16){0.f}; \
            asm volatile("" : "+v"(O_.nb0), "+v"(O_.nb1), "+v"(O_.gc), "+v"(O_.fr[0]), "+v"(O_.fr[1]), "+v"(O_.fr[2]), "+v"(O_.fr[3])); S2_TS(0);     \
            _Pragma("unroll") for (int ks = 0; ks < 4; ++ks) { acc = __builtin_amdgcn_mfma_f32_32x32x16_bf16(*(const LAS bf16x8*)(sb + (vb * 32 + r32) * 144 + (16 * ks + 8 * hi) * 2), O_.fr[ks], acc, 0, 0, 0); \
                acc2 = __builtin_amdgcn_mfma_f32_32x32x16_bf16(*(const LAS bf16x8*)(sb + 9216 + (vb * 32 + r32) * 144 + (16 * ks + 8 * hi) * 2), O_.fr[ks], acc2, 0, 0, 0); } \
            asm volatile("" :: "v"(acc[0]), "v"(acc2[0])); S2_TS(1); \
            { float nv_[16]; unpack8(O_.nb0, *(float(*)[8])&nv_[0]); unpack8(O_.nb1, *(float(*)[8])&nv_[8]); \
              _Pragma("unroll") for (int r = 0; r < 16; ++r) S[r] = S[r] * O_.gc - (acc[r] + acc2[r]) + nv_[r]; } \
            s2_put(S, lds + (((n_) + 1) & 1) * S2_BUF, vb, kb, r32, hi); asm volatile("s_waitcnt lgkmcnt(0)" ::: "memory"); S2_TS(2); } while (0)
        S2Ops OA_, OB_;
        S2_LOAD(OA_, 0); S2_LOAD(OB_, 1);
        __builtin_amdgcn_s_setprio(3);
        for (int n = 0; n < nchunk; n += 2) {
            S2_STEP(OA_, n); S2_LOAD(OA_, min(n + 2, nchunk - 1)); S2_TS(3); S2_BAR(); S2_TS(4);
            S2_STEP(OB_, n + 1); S2_LOAD(OB_, min(n + 3, nchunk - 1)); S2_TS(3); S2_BAR(); S2_TS(4); }
        __builtin_amdgcn_s_setprio(0);
#undef S2_LOAD
#undef S2_STEP
    } else if (wave < 6) {
        const int yb = wave & 1;
#define S2_LOAD(O_, n_) do { const size_t cid_ = cid0 + (n_); const bf16* q1 = (const bf16*)(A.ws + WS_CHQ1) + cid_ * 2048 + (size_t)r32 * 64 + 8 * hi; \
            _Pragma("unroll") for (int ks = 0; ks < 4; ++ks) O_.fr[ks] = *(const bf16x8*)(q1 + 16 * ks); \
            const f32x4* q2 = (const f32x4*)((const float*)(A.ws + WS_CHQ2) + cid_ * 2048 + (size_t)(yb * 64 + lane) * 16); \
            _Pragma("unroll") for (int q = 0; q < 4; ++q) { const f32x4 t_ = q2[q]; O_.blk[4 * q] = t_[0]; O_.blk[4 * q + 1] = t_[1]; O_.blk[4 * q + 2] = t_[2]; O_.blk[4 * q + 3] = t_[3]; } } while (0)
#define S2_STEP(O_, n_) do { const LAS unsigned char* sb = lds + ((n_) & 1) * S2_BUF; f32x16 acc, acc2 = (f32x16){0.f}; \
            _Pragma("unroll") for (int r = 0; r < 16; ++r) acc[r] = O_.blk[r]; \
            _Pragma("unroll") for (int ks = 0; ks < 4; ++ks) { acc = __builtin_amdgcn_mfma_f32_32x32x16_bf16(O_.fr[ks], *(const LAS bf16x8*)(sb + (yb * 32 + r32) * 144 + (16 * ks + 8 * hi) * 2), acc, 0, 0, 0); \
                acc2 = __builtin_amdgcn_mfma_f32_32x32x16_bf16(O_.fr[ks], *(const LAS bf16x8*)(sb + 9216 + (yb * 32 + r32) * 144 + (16 * ks + 8 * hi) * 2), acc2, 0, 0, 0); } \
            acc += acc2; \
            LAS float* yt = (LAS float*)(lds + 2 * S2_BUF) + (((n_) & 1) * 2 + yb) * 1056 + r32; \
            _Pragma("unroll") for (int r = 0; r < 16; ++r) yt[((r & 3) + 8 * (r >> 2) + 4 * hi) * 33] = acc[r]; } while (0)
        S2Ops OA_, OB_;
        S2_LOAD(OA_, 0); S2_LOAD(OB_, 1);
        for (int n = 0; n < nchunk; n += 2) {
            S2_STEP(OA_, n); S2_LOAD(OA_, min(n + 2, nchunk - 1)); S2_BAR();
            S2_STEP(OB_, n + 1); S2_LOAD(OB_, min(n + 3, nchunk - 1)); S2_BAR(); }
#undef S2_LOAD
#undef S2_STEP
    } else {
        const int yb = wave & 1;
#define S2_YST(n_) do { const LAS float* yt = (const LAS float*)(lds + 2 * S2_BUF) + (((n_) & 1) * 2 + yb) * 1056 + r32; \
            gfloat_t* Y = (gfloat_t*)((float*)(A.ws + WS_Y) + (size_t)(mbase + (n_) * CH_T) * 1024 + hd * 64 + yb * 32 + r32);   \
            Y += hi * 1024; yt += hi * 33; float yv_[16]; _Pragma("unroll") for (int i = 0; i < 16; ++i) yv_[i] = yt[i * 66]; \
            _Pragma("unroll") for (int i = 0; i < 16; ++i) { *Y = yv_[i]; Y += 2048; asm volatile("" : "+v"(Y)); } } while (0)
        for (int n = 0; n < nchunk; n += 2) { if (n > 0) S2_YST(n - 1); S2_BAR(); S2_YST(n); S2_BAR(); }
        S2_YST(nchunk - 1);
#undef S2_YST
    }
#undef S2_BAR
#ifdef S2_SEC
    if (seq == 0 && wave == 0) { const unsigned long long tamp1 = __builtin_amdgcn_s_memrealtime(); while (__builtin_amdgcn_s_memrealtime() - tamp1 < 8 * tsec[S2_SEC]) __builtin_amdgcn_s_sleep(8); }
    __syncthreads();
#endif
#ifdef S2_AMP
    if (seq == 0 && wave == 0) { const unsigned long long tamp1 = __builtin_amdgcn_s_memrealtime(); while (__builtin_amdgcn_s_memrealtime() - tamp1 < S2_AMP * (tamp1 - tamp0)) __builtin_amdgcn_s_sleep(8); }
    __syncthreads();
#endif
    if (wave < 4) { float* o = A.out + (prompt ? O3 : O5) + ((size_t)(bs * 16 + hd) * 64 + vb * 32) * 64 + kb * 32 + r32;
#pragma unroll
        for (int r = 0; r < 16; ++r) o[(size_t)((r & 3) + 8 * (r >> 2) + 4 * hi) * 64] = S[r]; }
    __syncthreads();
}

struct P2cIn { f32x4 y0, y1; u32x4 cur, prv, gb; float bon; };
__device__ __forceinline__ void p2c_load(const Args& A, int m, int half, int lane, P2cIn& I) {
    const bf16* PROJ = (const bf16*)(A.ws + WS_PROJ);
    const int C = half * 512 + lane * 8;
    const float* yp = (const float*)(A.ws + WS_Y) + (size_t)m * 1024 + C;
    I.y0 = *(const f32x4*)yp; I.y1 = *(const f32x4*)(yp + 4);
    const bf16* cur = PROJ + (size_t)m * PABP + COL_HB + 2048 + C;
    I.cur = *(const u32x4*)cur; I.prv = *(const u32x4*)(cur - (m > 0 ? PABP : 0));
    I.bon = ((const float*)(A.ws + WS_SCANIN))[(size_t)m * 16 + (C >> 6)];
    I.gb = *(const u32x4*)(PROJ + (size_t)m * PABP + COL_GB + C);
}
__device__ __forceinline__ void p2c_task(const Args& A, int m, int half, int lane, const P2cIn& I, const f32x4 (&cst)[6]) {
    const bool prompt = m < MP; const int bs = prompt ? (m >> 12) : ((m - MP) >> 6), t = prompt ? (m & 4095) : ((m - MP) & 63);
    const int C = half * 512 + lane * 8;
    float y[8];
#pragma unroll
    for (int j = 0; j < 4; ++j) { y[j] = I.y0[j]; y[4 + j] = I.y1[j]; }
    float s = 0.f;
#pragma unroll
    for (int j = 0; j < 8; ++j) s += y[j];
    s += __shfl_xor(s, 1); s += __shfl_xor(s, 2); s += __shfl_xor(s, 4);
    const float mean = s * (1.f / 64.f); float q = 0.f;
#pragma unroll
    for (int j = 0; j < 8; ++j) { y[j] -= mean; q += y[j] * y[j]; }
    q += __shfl_xor(q, 1); q += __shfl_xor(q, 2); q += __shfl_xor(q, 4);
    const float rstd = 1.0f / sqrtf(q * (1.f / 64.f) + 64e-5f);
    float hv[8]; lerp8(I.cur, I.prv, t == 0, prompt ? nullptr : A.in[I_SHIFT] + (size_t)bs * DSH + 2048 + C, cst[4], cst[5], hv);
    float gb[8]; unpack8(I.gb, gb);
    float r[8];
#pragma unroll
    for (int j = 0; j < 8; ++j) { const float gg = j < 4 ? cst[0][j & 3] : cst[1][j & 3], bb = j < 4 ? cst[2][j & 3] : cst[3][j & 3]; r[j] = (y[j] * rstd * gg + bb + I.bon * hv[j]) * siluf_(gb[j]); }
    u32x4 w; w.x = pk2(r[0], r[1]); w.y = pk2(r[2], r[3]); w.z = pk2(r[4], r[5]); w.w = pk2(r[6], r[7]);
    *(u32x4*)((bf16*)(A.ws + WS_XB) + (size_t)m * DM + 1024 + C) = w;
}
constexpr int AT_KROW = 272, AT_VROW = 576, AT_KMAP = 32 * AT_KROW, AT_STAGE = 2 * AT_KMAP + 32 * AT_VROW, AT_Q = 2 * AT_STAGE, AT_QMAP = 128 * AT_KROW, AT_SCR = AT_Q + 2 * AT_QMAP;
constexpr float ATT_THR = 6.0f;
constexpr int AT_XROW = 132;
struct AttnJob { const bf16* Q; const bf16* K; const bf16* V; const float* Kc; const float* Vc; const float* Kn; const float* Vn; int ntiles, tile0, sample; float* Op; float* ML; bf16* OC; const bf16* G; };
struct AtSet { u32x4 k[2], v[2]; };
__device__ __forceinline__ void at_ld(AtSet& S, const bf16* K, const bf16* V, int tile, unsigned goff) {
    const char* Kt = (const char*)K + (size_t)tile * 32 * DM * 2; const char* Vt = (const char*)V + (size_t)tile * 32 * DM * 2;
#pragma unroll
    for (int i = 0; i < 2; ++i) { S.k[i] = *(const u32x4*)(Kt + (size_t)i * 16 * DM * 2 + goff); S.v[i] = *(const u32x4*)(Vt + (size_t)i * 16 * DM * 2 + goff); }
}
__device__ __forceinline__ void at_st(const AtSet& S, LAS unsigned char* st, int kdst, int vdst) {
#pragma unroll
    for (int i = 0; i < 2; ++i) { *(LAS u32x4*)(st + kdst + i * 16 * AT_KROW) = S.k[i]; *(LAS u32x4*)(st + vdst + i * 16 * AT_VROW) = S.v[i]; }
}
struct AtSetF { f32x4 k[2][2], v[2][2]; };
__device__ __forceinline__ void at_ldf(AtSetF& S, const AttnJob& J, int j, unsigned goff) {
    const int T = J.tile0 + j;
    const char* Kt = (const char*)(T < 128 ? J.Kc + (size_t)T * 32 * DM : J.Kn + (size_t)(T - 128) * 32 * DM); const char* Vt = (const char*)(T < 128 ? J.Vc + (size_t)T * 32 * DM : J.Vn + (size_t)(T - 128) * 32 * DM);
#pragma unroll
    for (int i = 0; i < 2; ++i) { S.k[i][0] = *(const f32x4*)(Kt + (size_t)i * 16 * DM * 4 + 2 * goff); S.k[i][1] = *(const f32x4*)(Kt + (size_t)i * 16 * DM * 4 + 2 * goff + 16);
        S.v[i][0] = *(const f32x4*)(Vt + (size_t)i * 16 * DM * 4 + 2 * goff); S.v[i][1] = *(const f32x4*)(Vt + (size_t)i * 16 * DM * 4 + 2 * goff + 16); }
}
__device__ __forceinline__ void at_stf(const AtSetF& S, LAS unsigned char* st, int kdst, int vdst) {
#pragma unroll
    for (int i = 0; i < 2; ++i) { const f32x4 a = S.k[i][0], b = S.k[i][1], c = S.v[i][0], d = S.v[i][1];
        *(LAS u32x4*)(st + kdst + i * 16 * AT_KROW) = (u32x4){cvt_pk_bf16(a[0], a[1]), cvt_pk_bf16(a[2], a[3]), cvt_pk_bf16(b[0], b[1]), cvt_pk_bf16(b[2], b[3])};
        *(LAS u32x4*)(st + vdst + i * 16 * AT_VROW) = (u32x4){cvt_pk_bf16(c[0], c[1]), cvt_pk_bf16(c[2], c[3]), cvt_pk_bf16(d[0], d[1]), cvt_pk_bf16(d[2], d[3])}; }
}
__device__ __forceinline__ float at_max32(float x) { auto rr = __builtin_amdgcn_permlane32_swap(__float_as_uint(x), __float_as_uint(x), false, false); return fmaxf(__uint_as_float(rr[0]), __uint_as_float(rr[1])); }
__device__ __forceinline__ float at_sum32(float x) { auto rr = __builtin_amdgcn_permlane32_swap(__float_as_uint(x), __float_as_uint(x), false, false); return __uint_as_float(rr[0]) + __uint_as_float(rr[1]); }
__device__ __forceinline__ float at_rowsum32(float x) {
    x = dpp_add16(x);
    return x + __builtin_bit_cast(float, __builtin_amdgcn_ds_swizzle(__builtin_bit_cast(int, x), 0x401F)); }
struct AtState { f32x16 o[8]; float m_run, l_run;
#ifdef AT_SEC
    unsigned long long ts[6], tl;
#endif
};
#ifdef AT_SEC
#define AT_TS(Z_, k) do { const unsigned long long t_ = __builtin_amdgcn_s_memrealtime(); Z_.ts[k] += t_ - Z_.tl; Z_.tl = t_; } while (0)
#else
#define AT_TS(Z_, k) do {} while (0)
#endif
__device__ __forceinline__ void at_compute(AtState& Z, const LAS unsigned char* st, const LAS unsigned char* lds, int koff, int qoff, int voff, LAS float* scr, int r32, int hi) {
    AT_TS(Z, 0);
    f32x16 p = (f32x16){0.f};
    __builtin_amdgcn_s_setprio(1);
    {
        const unsigned ka = (unsigned)(size_t)(st + koff), qa = (unsigned)(size_t)(lds + qoff);
        bf16x8 kf0, kf1, kf2, qf0, qf1;
#define AT_KRD(KF, ds_) asm volatile("ds_read_b128 %0, %1 offset:%c2" : "=&v"(KF) : "v"(ka), "i"((ds_) * 32))
#define AT_QRD(QF, ds_) asm volatile("ds_read_b128 %0, %1 offset:%c2" : "=&v"(QF) : "v"(qa), "i"((ds_) * 32))
#define AT_QKW(KF, QF, n_) asm volatile("s_waitcnt lgkmcnt(" #n_ ")" : "+v"(KF), "+v"(QF))
#define AT_QKM(KF, QF) p = __builtin_amdgcn_mfma_f32_32x32x16_bf16(KF, QF, p, 0, 0, 0)
        AT_KRD(kf0, 0); AT_QRD(qf0, 0); AT_KRD(kf1, 1); AT_QRD(qf1, 1); AT_KRD(kf2, 2);
        AT_QKW(kf0, qf0, 3); AT_QKM(kf0, qf0); AT_QRD(qf0, 2); AT_KRD(kf0, 3);
        AT_QKW(kf1, qf1, 3); AT_QKM(kf1, qf1); AT_QRD(qf1, 3); AT_KRD(kf1, 4);
        AT_QKW(kf2, qf0, 3); AT_QKM(kf2, qf0); AT_QRD(qf0, 4); AT_KRD(kf2, 5);
        AT_QKW(kf0, qf1, 3); AT_QKM(kf0, qf1); AT_QRD(qf1, 5); AT_KRD(kf0, 6);
        AT_QKW(kf1, qf0, 3); AT_QKM(kf1, qf0); AT_QRD(qf0, 6); AT_KRD(kf1, 7);
        AT_QKW(kf2, qf1, 3); AT_QKM(kf2, qf1); AT_QRD(qf1, 7);
        AT_QKW(kf0, qf0, 2); AT_QKM(kf0, qf0);
        AT_QKW(kf1, qf1, 0); AT_QKM(kf1, qf1);
#undef AT_KRD
#undef AT_QRD
#define AT_QKRD(a,b,c)
#undef AT_QKRD
#undef AT_QKW
#undef AT_QKM
    }
    __builtin_amdgcn_s_setprio(0);
#ifdef AT_SEC
    asm volatile("" :: "v"(p[0])); AT_TS(Z, 1);
#endif
    float mx = fmaxf(p[0], p[1]);
#pragma unroll
    for (int r = 2; r < 16; ++r) mx = fmaxf(mx, p[r]);
    mx = at_max32(mx);
    if (__any(mx > Z.m_run + ATT_THR)) {
        const float mn = fmaxf(Z.m_run, mx), alpha = __builtin_amdgcn_exp2f(Z.m_run - mn);
        Z.m_run = mn; Z.l_run *= alpha;
        if (hi == 0) scr[r32] = alpha;
#pragma unroll
        for (int r = 0; r < 16; ++r) { const float al = scr[(r & 3) + 8 * (r >> 2) + 4 * hi];
#pragma unroll
            for (int d = 0; d < 8; ++d) Z.o[d][r] *= al; }
    }
    float ls = 0.f;
#pragma unroll
    for (int r = 0; r < 16; ++r) { p[r] = __builtin_amdgcn_exp2f(p[r] - Z.m_run); ls += p[r]; }
    Z.l_run += ls;
    u32x4 pw[2];
#pragma unroll
    for (int s = 0; s < 2; ++s) pw[s] = (u32x4){cvt_pk_bf16(p[8 * s], p[8 * s + 1]), cvt_pk_bf16(p[8 * s + 2], p[8 * s + 3]), cvt_pk_bf16(p[8 * s + 4], p[8 * s + 5]), cvt_pk_bf16(p[8 * s + 6], p[8 * s + 7])};
#ifdef AT_SEC
    asm volatile("" :: "v"(pw[1])); AT_TS(Z, 2);
#endif
    {
        const unsigned va = (unsigned)(size_t)(st + voff);
        s16x4 lo0, lo1, lo2, lo3, hh0, hh1, hh2, hh3;
#define AT_VRD(LO, HH, i_) asm volatile("ds_read_b64_tr_b16 %0, %2 offset:%c3\n\tds_read_b64_tr_b16 %1, %2 offset:%c4" : "=&v"(LO), "=&v"(HH) : "v"(va), "i"((16 * ((i_) >> 3)) * AT_VROW + ((i_) & 7) * 64), "i"((16 * ((i_) >> 3) + 8) * AT_VROW + ((i_) & 7) * 64))
#define AT_VW(LO, HH, n_) asm volatile("s_waitcnt lgkmcnt(" #n_ ")" : "+v"(LO), "+v"(HH))
#define AT_PVM(LO, HH, i_) do { const bf16x8 vf_ = (bf16x8){LO[0], LO[1], LO[2], LO[3], HH[0], HH[1], HH[2], HH[3]}; \
                                 Z.o[(i_) & 7] = __builtin_amdgcn_mfma_f32_32x32x16_bf16(__builtin_bit_cast(bf16x8, pw[(i_) >> 3]), vf_, Z.o[(i_) & 7], 0, 0, 0); } while (0)
        AT_VRD(lo0, hh0, 0); AT_VRD(lo1, hh1, 1); AT_VRD(lo2, hh2, 2); AT_VRD(lo3, hh3, 3);
#pragma unroll
        for (int i = 0; i < 12; i += 4) {
            AT_VW(lo0, hh0, 6); AT_PVM(lo0, hh0, i); AT_VRD(lo0, hh0, i + 4);
            AT_VW(lo1, hh1, 6); AT_PVM(lo1, hh1, i + 1); AT_VRD(lo1, hh1, i + 5);
            AT_VW(lo2, hh2, 6); AT_PVM(lo2, hh2, i + 2); AT_VRD(lo2, hh2, i + 6);
            AT_VW(lo3, hh3, 6); AT_PVM(lo3, hh3, i + 3); AT_VRD(lo3, hh3, i + 7); }
        AT_VW(lo0, hh0, 6); AT_PVM(lo0, hh0, 12);
        AT_VW(lo1, hh1, 4); AT_PVM(lo1, hh1, 13);
        AT_VW(lo2, hh2, 2); AT_PVM(lo2, hh2, 14);
        AT_VW(lo3, hh3, 0); AT_PVM(lo3, hh3, 15);
#undef AT_VRD
#undef AT_VW
#undef AT_PVM
    }
#ifdef AT_SEC
    asm volatile("" :: "v"(Z.o[7][0])); AT_TS(Z, 3);
#endif
}
__device__ __forceinline__ void attn_job(const AttnJob& J, const Args& A, LAS unsigned char* lds, float lam, int wave, int lane, int tid) {
    const int r32 = lane & 31, hi = lane >> 5, map = wave & 1;
    const int qg = J.sample ? ((wave >> 1) & 1) : (wave >> 1), khalf = wave >> 2;
    AtState Z;
#pragma unroll
    for (int d = 0; d < 8; ++d) Z.o[d] = (f32x16){0.f};
    Z.m_run = -1e30f; Z.l_run = 0.f;
#ifdef AT_SEC
    for (int i = 0; i < 6; ++i) Z.ts[i] = 0; Z.tl = __builtin_amdgcn_s_memrealtime();
#endif
    LAS float* scr = (LAS float*)(lds + AT_SCR) + wave * 64;
    const unsigned goff = (unsigned)(((tid >> 5) * DM + (tid & 31) * 8) * 2);
    const int kdst = ((tid & 31) >> 4) * AT_KMAP + (tid >> 5) * AT_KROW + (tid & 15) * 16, vdst = 2 * AT_KMAP + (tid >> 5) * AT_VROW + (tid & 31) * 16;
    const int koff = map * AT_KMAP + r32 * AT_KROW + hi * 16, qoff = koff + __builtin_amdgcn_readfirstlane(AT_Q + map * (AT_QMAP - AT_KMAP) + qg * 32 * AT_KROW);
    const int voff = 2 * AT_KMAP + (4 * hi + ((lane & 15) >> 2)) * AT_VROW + (((lane >> 4) & 1) * 16 + (lane & 3) * 4) * 2;
    { const int nq = J.sample ? 4 : 8;
      for (int i = 0; i < nq; ++i) { const int c = tid + 512 * i, row = c >> 5, cc = c & 31;
          *(LAS u32x4*)(lds + AT_Q + (cc >> 4) * AT_QMAP + row * AT_KROW + (cc & 15) * 16) = *(const u32x4*)(J.Q + (size_t)row * DM + cc * 8); } }
    const int NT = J.ntiles;
    if (!J.sample) {
        const int ntw = NT - ((qg < 2) ? 2 : 0);
        AtSet S;
        at_ld(S, J.K, J.V, 0, goff); at_st(S, lds, kdst, vdst); at_ld(S, J.K, J.V, 1, goff);
        __syncthreads();
        for (int j = 0; j < NT; ++j) {
            if (j < ntw) at_compute(Z, lds + (j & 1) * AT_STAGE, lds, koff, qoff, voff, scr, r32, hi);
            if (j + 1 < NT) { at_st(S, lds + ((j + 1) & 1) * AT_STAGE, kdst, vdst); if (j + 2 < NT) at_ld(S, J.K, J.V, j + 2, goff); }
            __syncthreads();
        }
    } else {
        AtSetF SF;
        at_ldf(SF, J, 0, goff); at_stf(SF, lds, kdst, vdst);
        __syncthreads();
        for (int j = 0; j < NT; ++j) {
            if (j + 1 < NT) at_ldf(SF, J, j + 1, goff);
            if ((j & 1) == khalf) at_compute(Z, lds + (j & 1) * AT_STAGE, lds, koff, qoff, voff, scr, r32, hi);
            if (j + 1 < NT) at_stf(SF, lds + ((j + 1) & 1) * AT_STAGE, kdst, vdst);
            __syncthreads();
        }
    }
    Z.l_run = at_sum32(Z.l_run);
    if (J.sample) {
        float* Op = J.Op + (size_t)khalf * 32768; float* ML = J.ML + khalf * 256;
        if (hi == 0) { ML[(map * 64 + qg * 32 + r32) * 2] = Z.m_run; ML[(map * 64 + qg * 32 + r32) * 2 + 1] = Z.l_run; }
#pragma unroll
        for (int d = 0; d < 8; ++d)
#pragma unroll
            for (int r = 0; r < 16; ++r) Op[(size_t)(map * 64 + qg * 32 + (r & 3) + 8 * (r >> 2) + 4 * hi) * 256 + d * 32 + r32] = Z.o[d][r];
        return;
    }
#ifdef NOEPI
    J.OC[tid] = (bf16)f2bf(Z.o[0][0] + Z.o[7][15] + Z.l_run); return;
#endif
    if (hi == 0) scr[r32] = 1.0f / Z.l_run;
    float il[16];
#pragma unroll
    for (int r = 0; r < 16; ++r) il[r] = scr[(r & 3) + 8 * (r >> 2) + 4 * hi];
    LAS float* xme = (LAS float*)lds + wave * (32 * AT_XROW);
#pragma unroll
    for (int d = 0; d < 4; ++d)
#pragma unroll
        for (int r = 0; r < 16; ++r) xme[((r & 3) + 8 * (r >> 2) + 4 * hi) * AT_XROW + d * 32 + r32] = (map ? Z.o[d][r] : Z.o[4 + d][r]) * il[r];
    __syncthreads();
    const float ca = map ? -lam : 1.f, cb = map ? 1.f : -lam;
    LAS float* xw = (LAS float*)lds + (wave ^ 1) * (32 * AT_XROW);
    LAS float* sx = (LAS float*)(lds + 8 * 32 * AT_XROW * 4);
#pragma unroll
    for (int r = 0; r < 16; ++r) { float s = 0.f; const int q = (r & 3) + 8 * (r >> 2) + 4 * hi;
#pragma unroll
        for (int d = 0; d < 4; ++d) { const float x = xw[q * AT_XROW + d * 32 + r32]; const float v = ca * il[r] * (map ? Z.o[4 + d][r] : Z.o[d][r]) + cb * x; xw[q * AT_XROW + d * 32 + r32] = v; s += v * v; }
        s = at_rowsum32(s);
        if (r32 == 0) sx[wave * 32 + q] = s;
        if (r & 1) __builtin_amdgcn_sched_barrier(0); }
    __syncthreads();
    { const int dvb = map * 128, oc = lane & 15;
      const f32x4 sg0 = *(const f32x4*)(A.in[I_SUBG] + dvb + oc * 8), sg1 = *(const f32x4*)(A.in[I_SUBG] + dvb + oc * 8 + 4);
      u32x4 gpre[8];
#pragma unroll
      for (int it = 0; it < 8; ++it) gpre[it] = *(const u32x4*)(J.G + (size_t)(qg * 32 + it * 4 + (lane >> 4)) * DM + dvb + oc * 8);
#pragma unroll
      for (int it = 0; it < 8; ++it) { const int q = it * 4 + (lane >> 4); const size_t o = (size_t)(qg * 32 + q) * DM + dvb + oc * 8;
          const float sc = (1.0f / sqrtf((sx[wave * 32 + q] + sx[(wave ^ 1) * 32 + q]) * (1.f / 256.f) + 1e-5f)) * (1.f - LAM_INIT);
          const f32x4 x0 = *(const LAS f32x4*)(xw + q * AT_XROW + oc * 8) * sc, x1 = *(const LAS f32x4*)(xw + q * AT_XROW + oc * 8 + 4) * sc;
          float g[8]; unpack8(gpre[it], g);
          u32x4 w; w.x = cvt_pk_bf16(x0[0] * sg0[0] * g[0], x0[1] * sg0[1] * g[1]); w.y = cvt_pk_bf16(x0[2] * sg0[2] * g[2], x0[3] * sg0[3] * g[3]);
          w.z = cvt_pk_bf16(x1[0] * sg1[0] * g[4], x1[1] * sg1[1] * g[5]); w.w = cvt_pk_bf16(x1[2] * sg1[2] * g[6], x1[3] * sg1[3] * g[7]);
          *(u32x4*)(J.OC + o) = w; } }
#ifdef AT_SEC
    if (wave == 0) { const unsigned long long t1 = __builtin_amdgcn_s_memrealtime(); while (__builtin_amdgcn_s_memrealtime() - t1 < 2 * Z.ts[AT_SEC]) __builtin_amdgcn_s_sleep(8); }
#endif
    __syncthreads();
}

__device__ __forceinline__ void p6_task(const Args& A, int ms, int h, float lam, int lane) {
    const int b = ms >> 6, q = ms & 63; const int m = MP + ms;
    f32x4 on[2];
#pragma unroll
    for (int j = 0; j < 2; ++j) { float mm[8], ll[8], M = -1e30f;
#pragma unroll
        for (int s = 0; s < 8; ++s) { const size_t base = (size_t)((b * 8 + h) * 8 + s); const float* ml = (const float*)(A.ws + WS_MLS) + ((base * 2 + j) * 64 + q) * 2; mm[s] = ml[0]; ll[s] = ml[1]; M = fmaxf(M, mm[s]); }
        f32x4 acc = (f32x4){0.f, 0.f, 0.f, 0.f}; float L = 0.f;
#pragma unroll
        for (int s = 0; s < 8; ++s) { const size_t base = (size_t)((b * 8 + h) * 8 + s); const float w = __builtin_amdgcn_exp2f(mm[s] - M); L += w * ll[s];
            acc += ((const f32x4*)((const float*)(A.ws + WS_PARTS) + ((base * 2 + j) * 64 + q) * 256))[lane] * w; }
        on[j] = acc * (1.0f / L); }
    const f32x4 of = on[0] - on[1] * lam;
    const float ss = wave_sum(of[0] * of[0] + of[1] * of[1] + of[2] * of[2] + of[3] * of[3]);
    const float rms = 1.0f / sqrtf(ss * (1.f / 256.f) + 1e-5f);
    const f32x4 sg = ((const f32x4*)A.in[I_SUBG])[lane];
    const u32x2 gw = *(const u32x2*)((const bf16*)(A.ws + WS_GB) + (size_t)m * DM + h * 256 + lane * 4);
    const float sc = rms * (1.f - LAM_INIT);
    u32x2 w; w.x = pk2(of[0] * sc * sg[0] * bflo(gw.x), of[1] * sc * sg[1] * bfhi(gw.x)); w.y = pk2(of[2] * sc * sg[2] * bflo(gw.y), of[3] * sc * sg[3] * bfhi(gw.y));
    *(u32x2*)((bf16*)(A.ws + WS_XB) + (size_t)m * DM + h * 256 + lane * 4) = w;
}
__device__ __forceinline__ void p8_row(const Args& A, int m, int m_next, u32x2 (&pre)[8], int lane) {
    float* y = A.out + (m < MP ? O0 + (size_t)m * DM : O1 + (size_t)(m - MP) * DM);
    f32x4 v[8]; float s = 0.f;
    u32x2 cur[8];
#pragma unroll
    for (int j = 0; j < 8; ++j) cur[j] = pre[j];
    if (m_next < MP) {
#pragma unroll
        for (int j = 0; j < 8; ++j) pre[j] = ((const u32x2*)((const bf16*)(A.ws + WS_QB) + (size_t)m_next * DM))[lane + 64 * j]; }
#pragma unroll
    for (int j = 0; j < 8; ++j) {
        if (m < MP) { const u32x2 zw = cur[j]; v[j] = (f32x4){bflo(zw.x), bfhi(zw.x), bflo(zw.y), bfhi(zw.y)}; }
        else {
            const int ms = m - MP; const float* st = (const float*)(A.ws + OFF_STATS1) + 2 * m;
            const float mean = st[0] * (1.f / 2048.f), var = st[1] * (1.f / 2048.f) - mean * mean, rstd = 1.0f / sqrtf(var + 1e-5f);
            const u32x2 zw = ((const u32x2*)((const bf16*)(A.ws + WS_Z1) + (size_t)m * DM))[lane + 64 * j];
            const f32x4 z = (f32x4){bflo(zw.x), bfhi(zw.x), bflo(zw.y), bfhi(zw.y)};
            f32x4 a = ((z - mean) * rstd * ((const f32x4*)A.in[I_LNG])[lane + 64 * j] + ((const f32x4*)A.in[I_LNB])[lane + 64 * j]) * ALPHA;
#pragma unroll
            for (int k2 = 0; k2 < 8; ++k2) a += ((const f32x4*)((const float*)(A.ws + WS_SLAB) + ((size_t)k2 * MS + ms) * DM))[lane + 64 * j];
            v[j] = a; }
        s += (v[j][0] + v[j][1]) + (v[j][2] + v[j][3]); }
    const float mean = wave_sum(s) * (1.f / 2048.f); float q = 0.f;
#pragma unroll
    for (int j = 0; j < 8; ++j) { v[j] = v[j] - mean; q += (v[j][0] * v[j][0] + v[j][1] * v[j][1]) + (v[j][2] * v[j][2] + v[j][3] * v[j][3]); }
    const float rstd = 1.0f / sqrtf(wave_sum(q) * (1.f / 2048.f) + 1e-5f);
#pragma unroll
    for (int j = 0; j < 8; ++j) { const f32x4 g = ((const f32x4*)A.in[I_CLNG])[lane + 64 * j], b = ((const f32x4*)A.in[I_CLNB])[lane + 64 * j];
        ((f32x4*)y)[lane + 64 * j] = v[j] * rstd * g + b; }
}
constexpr int N_PHASES = 11;
__global__ void __launch_bounds__(512, 2) mega_fwd(Args A) {
    extern __shared__ __attribute__((aligned(16))) unsigned char lds_raw[];
    LAS unsigned char* lds = (LAS unsigned char*)lds_raw;
    const int tid = threadIdx.x, lane = tid & 63, wave = __builtin_amdgcn_readfirstlane(tid >> 6);
    const int G = gridDim.x, bx = blockIdx.x, vcu = (G % 8 == 0) ? (bx % 8) * (G / 8) + bx / 8 : bx;
    unsigned char* ws = A.ws;
    unsigned* ctl = (unsigned*)(ws + WS_CTL);
    for (int u = tid; u < (LDS_BYTES - LDSCTL_OFF) / 4; u += 512) ((LAS unsigned*)(lds + LDSCTL_OFF))[u] = 0u;
    __syncthreads();
    XcdBarrier bar = xcd_barrier_post(ctl + CW_BAR, (volatile LAS unsigned*)(lds + MISC_OFF) + 8);
    const int lo = A.ph_lo, hi = A.ph_hi;
#ifndef PH_MASK
#define PH_MASK 0x7ff
#endif
#define IN(k) (((PH_MASK >> (k)) & 1) && lo <= (k) && (k) < hi)
#define SEAM(k) do { if (IN(k) && IN((k) + 1)) xcd_barrier(bar); } while (0)
#ifndef REPEAT_PH
#define REPEAT_PH -1
#endif
#define NREP(k) ((REPEAT_PH == (k)) ? 2 : 1)
#ifdef AMP_PH
    unsigned long long amp_t0 = 0;
#define AMP_BEGIN(k) do { if ((k) == AMP_PH || ((k) == 2 && (AMP_PH == 3 || AMP_PH == 31)) || ((k) == 4 && AMP_PH == 5)) amp_t0 = __builtin_amdgcn_s_memrealtime(); } while (0)
#define AMP_END(k) do { if ((k) == AMP_PH || ((k) == 3 && AMP_PH == 32)) { __syncthreads(); if (wave == 0) { const unsigned long long t1_ = __builtin_amdgcn_s_memrealtime(); while (__builtin_amdgcn_s_memrealtime() - t1_ < t1_ - amp_t0) __builtin_amdgcn_s_sleep(8); } __syncthreads(); } } while (0)
#else
#define AMP_BEGIN(k) do {} while (0)
#define AMP_END(k) do {} while (0)
#endif
    float* const dummyf = (float*)(ws + 5 * MiB);
    const int gw = vcu * 8 + wave, NGW = G * 8;

    if (IN(0)) for (int rep = 0; rep < NREP(0); ++rep) { if (rep) xcd_barrier(bar); p0_prologue(A, lds, vcu, G, wave, lane, tid, rep ? dummyf : (float*)(ws + OFF_COLSUM), rep ? dummyf + 8192 : (float*)(ws + OFF_BW)); }
    AMP_END(0);
    SEAM(0);
    AMP_BEGIN(1);
    if (IN(1)) for (int rep = 0; rep < NREP(1); ++rep) { if (rep) xcd_barrier(bar);
        pg8::Gemm g{(const bf16*)(ws + WS_XB), (const bf16*)(ws + WS_WTIN), MT, PABP, DM, DM}; pg8::StaticOrder S; S.init(MT, PABP, G, bx);
        pg8::EpiPlainBf16 E{(bf16*)(ws + WS_PROJ), PABP};
        pg8::gemm_phase<pg8::EpiPlainBf16, pg8::StaticOrder, true, true>(lds, g, S, E);
        { const int nun = (MT / 256) * (PABP / 256), tail = nun % G;
          if (rep == 0 && tail != 0 && bx >= tail) { __syncthreads(); late_transposes(A, lds, (bx - tail) * 8 + wave, (G - tail) * 8, wave, lane, (float*)(ws + OFF_COLSUM), (float*)(ws + OFF_BW)); } }
    }
    AMP_END(1);
    SEAM(1);
    AMP_BEGIN(2);
    if (IN(2)) for (int rep = 0; rep < NREP(2); ++rep) { if (rep) xcd_barrier(bar);
        const bf16* PROJ = (const bf16*)(ws + WS_PROJ);
        for (int idx = vcu * 512 + tid; idx < 12 * DSH; idx += G * 512) { const int s = idx / DSH, c = idx % DSH;
            const int m = s < 4 ? s * SEQ + SEQ - 1 : MP + (s - 4) * DSQ + DSQ - 1;
            float v = bf1(PROJ[(size_t)m * PABP + COL_HB + c]);
#if STAGE == 1
            v *= 3.f;
#endif
            A.out[(s < 4 ? O2 + (size_t)s * DSH : O4 + (size_t)(s - 4) * DSH) + c] = v; }
    }
    if (IN(3)) for (int rep = 0; rep < NREP(3); ++rep) { if (rep) xcd_barrier(bar);
#ifndef REP_S1
#define REP_S1 1
#endif
#ifndef REP_S2
#define REP_S2 1
#endif
        for (int rr = 0; rr < REP_S1; ++rr) { if (rr) xcd_barrier(bar);
        for (int v0 = vcu; v0 < 256; v0 += G) { PrepRegs R; int cur_hd = -1;
#ifdef S1_SEC
            unsigned long long s1ts[8] = {0,0,0,0,0,0,0,0}; unsigned long long s1tl = __builtin_amdgcn_s_memrealtime();
#endif
            const int nu = v0 < 128 ? 17 : 16;
            for (int i = 0; i < nu; ++i) { const int sh = v0 >> 2; const int sq = i < 16 ? (sh >> 4) : NBP + (v0 >> 4), hd = i < 16 ? (sh & 15) : (v0 & 15), cp = i < 16 ? (v0 & 3) * 16 + i : 0;
                if (hd != cur_hd) { s1_consts(A, lds, hd, tid); __syncthreads(); cur_hd = hd; }
                s1_unit(A, lds, sq, hd, cp, R, S1_PF && i > 0 && i < 16, S1_PF && i < 15, wave, lane, tid
#ifdef S1_SEC
                    , s1ts, s1tl
#endif
                    ); }
#ifdef S1_SEC
            if (wave == 0) { const unsigned long long t1 = __builtin_amdgcn_s_memrealtime(); while (__builtin_amdgcn_s_memrealtime() - t1 < 2 * s1ts[S1_SEC]) __builtin_amdgcn_s_sleep(8); }
            __syncthreads();
#endif
            } }
        AMP_END(31);
        xcd_barrier(bar);
        AMP_BEGIN(32);
        for (int rr = 0; rr < REP_S2; ++rr) { if (rr) xcd_barrier(bar);
        for (int v0 = vcu; v0 < 256; v0 += G) {
            if ((v0 & 3) == 0) s2_unit(A, lds, v0 >> 6, (v0 >> 2) & 15, wave, lane);
            else { const int su = (v0 >> 2) * 3 + (v0 & 3) - 1; if (su < 128) s2_unit(A, lds, NBP + (su >> 4), su & 15, wave, lane); } } }
        for (int v0 = vcu; v0 < 256; v0 += G) if ((v0 & 3) != 0)
            for (int u = (v0 >> 2) * 3 + (v0 & 3) - 1; u < 136 * 4; u += 192) mixer_a_unit(A, lds, u >> 2, u & 3, wave, lane, tid);

    }
    AMP_END(3);
    SEAM(3);
    AMP_BEGIN(4);
    if (IN(4)) for (int rep = 0; rep < NREP(4); ++rep) { if (rep) xcd_barrier(bar);
        const int half = gw & 1, C = half * 512 + lane * 8;
        f32x4 cst[6]; cst[0] = *(const f32x4*)(A.in[I_LNXG] + C); cst[1] = *(const f32x4*)(A.in[I_LNXG] + C + 4); cst[2] = *(const f32x4*)(A.in[I_LNXB] + C); cst[3] = *(const f32x4*)(A.in[I_LNXB] + C + 4);
        cst[4] = *(const f32x4*)(A.in[I_MU] + 2048 + C); cst[5] = *(const f32x4*)(A.in[I_MU] + 2048 + C + 4);
        P2cIn nx; p2c_load(A, min(gw >> 1, MT - 1), half, lane, nx);
        for (int wt = gw; wt < MT * 2; wt += NGW) { const P2cIn cu = nx; p2c_load(A, min((wt + NGW) >> 1, MT - 1), half, lane, nx); p2c_task(A, wt >> 1, half, lane, cu, cst); } }
    if (IN(4) && IN(5)) xcd_barrier(bar);
    if (IN(5)) for (int rep = 0; rep < NREP(5); ++rep) { if (rep) xcd_barrier(bar);
        pg8::Gemm g{(const bf16*)(ws + WS_XB), (const bf16*)(ws + WS_WTOUT), MP, DM, DM, DM}; pg8::StaticOrder S; S.init(MP, DM, G, bx);
        pg8::EpiZ1 E{A.in[I_XP], A.in[I_XS], (bf16*)(ws + WS_Z1), rep ? dummyf : (float*)(ws + OFF_STATS1)};
        pg8::gemm_phase<pg8::EpiZ1, pg8::StaticOrder, true, true>(lds, g, S, E);
        { pg8::Gemm g2{(const bf16*)(ws + WS_XB), (const bf16*)(ws + WS_WTOUT), MT, DM, 256, DM}; pg8::SliceOrder S2; S2.init(DM, 8, 256, G, bx);
          pg8::EpiSlab E2{(float*)(ws + WS_SLAB), DM, 256};
          pg8::gemm_phase<pg8::EpiSlab, pg8::SliceOrder, false, true>(lds, g2, S2, E2); }
        xcd_barrier(bar);
        for (int ms = gw; ms < MS; ms += NGW) {
            const float* xr = A.in[I_XS] + (size_t)ms * DM; const float* sl = (const float*)(ws + WS_SLAB) + (size_t)ms * DM; bf16* zr = (bf16*)(ws + WS_Z1) + (size_t)(MP + ms) * DM; float s_ = 0.f, ss_ = 0.f;
#pragma unroll
            for (int jb = 0; jb < 8; jb += 4) { f32x4 xv[4], sv[4][8];
#pragma unroll
                for (int j = 0; j < 4; ++j) { xv[j] = ((const f32x4*)xr)[lane + 64 * (jb + j)];
#pragma unroll
                    for (int k2 = 0; k2 < 8; ++k2) sv[j][k2] = ((const f32x4*)(sl + (size_t)k2 * MS * DM))[lane + 64 * (jb + j)]; }
#pragma unroll
                for (int j = 0; j < 4; ++j) { f32x4 v = xv[j] * ALPHA;
#pragma unroll
                    for (int k2 = 0; k2 < 8; ++k2) v += sv[j][k2];
                    u32x2 w; w.x = cvt_pk_bf16(v[0], v[1]); w.y = cvt_pk_bf16(v[2], v[3]); ((u32x2*)zr)[lane + 64 * (jb + j)] = w;
                    const float f0 = bflo(w.x), f1 = bfhi(w.x), f2 = bflo(w.y), f3 = bfhi(w.y); s_ += (f0 + f1) + (f2 + f3); ss_ += (f0 * f0 + f1 * f1) + (f2 * f2 + f3 * f3); } }
            s_ = wave_sum(s_); ss_ = wave_sum(ss_);
            if (lane == 0 && !rep) { ((float*)(ws + OFF_STATS1))[2 * (MP + ms)] = s_; ((float*)(ws + OFF_STATS1))[2 * (MP + ms) + 1] = ss_; } }
    }
    AMP_END(5);
    SEAM(5);
    AMP_BEGIN(6);
    if (IN(6)) for (int rep = 0; rep < NREP(6); ++rep) { if (rep) xcd_barrier(bar);
        pg8::Gemm g{(const bf16*)(ws + WS_Z1), (const bf16*)(ws + WS_WTCIN), MP, PCN, DM, DM}; pg8::StaticOrder S; S.init(MP, PCN, G, bx);
        pg8::EpiQKVG E{(const float*)(ws + OFF_STATS1), (const float*)(ws + OFF_COLSUM), (const float*)(ws + OFF_BW), (bf16*)(ws + WS_QB), (bf16*)(ws + WS_GB), (bf16*)(ws + WS_KBP), (bf16*)(ws + WS_VBP), A.out};
        pg8::gemm_phase<pg8::EpiQKVG, pg8::StaticOrder, true, true>(lds, g, S, E);
        { pg8::Gemm g2{(const bf16*)(ws + WS_Z1), (const bf16*)(ws + WS_WTCIN), MT, PCN, 512, DM}; pg8::SliceOrder S2; S2.init(PCN, 4, 512, G, bx);
          pg8::EpiSlab E2{(float*)(ws + WS_SLAB3), PCN, 512};
          pg8::gemm_phase<pg8::EpiSlab, pg8::SliceOrder, false, true>(lds, g2, S2, E2); }
        xcd_barrier(bar);
        for (int wt = gw; wt < MS * 4; wt += NGW) {
            const int ms = wt >> 2, kind = wt & 3, row = MP + ms;
            const float* st = (const float*)(ws + OFF_STATS1) + 2 * row;
            const float mean = st[0] * (1.f / 2048.f), var = st[1] * (1.f / 2048.f) - mean * mean, rstd = 1.0f / sqrtf(var + 1e-5f);
            const float* sl = (const float*)(ws + WS_SLAB3) + (size_t)ms * PCN + kind * DM;
#pragma unroll
            for (int jb = 0; jb < 8; jb += 4) { f32x4 av[4][4], cv[4], bv[4];
#pragma unroll
                for (int j = 0; j < 4; ++j) { const int c = (lane + 64 * (jb + j)) * 4;
#pragma unroll
                    for (int k2 = 0; k2 < 4; ++k2) av[j][k2] = *(const f32x4*)(sl + (size_t)k2 * MS * PCN + c);
                    cv[j] = *(const f32x4*)((const float*)(ws + OFF_COLSUM) + kind * DM + c); bv[j] = *(const f32x4*)((const float*)(ws + OFF_BW) + kind * DM + c); }
#pragma unroll
                for (int j = 0; j < 4; ++j) { const int c = (lane + 64 * (jb + j)) * 4;
                    const f32x4 a = (av[j][0] + av[j][1]) + (av[j][2] + av[j][3]);
                    f32x4 v = (a - cv[j] * mean) * rstd + bv[j];
                    if (kind == 0) { v = v * QSCALE; u32x2 w; w.x = cvt_pk_bf16(v[0], v[1]); w.y = cvt_pk_bf16(v[2], v[3]); *(u32x2*)((bf16*)(ws + WS_QB) + (size_t)row * DM + c) = w; }
                    else if (kind == 3) { u32x2 w; w.x = cvt_pk_bf16(siluf_(v[0]), siluf_(v[1])); w.y = cvt_pk_bf16(siluf_(v[2]), siluf_(v[3])); *(u32x2*)((bf16*)(ws + WS_GB) + (size_t)row * DM + c) = w; }
                    else *(f32x4*)(A.out + (kind == 1 ? O9 : O10) + (size_t)ms * DM + c) = v; } } }
    }
    AMP_END(6);
    SEAM(6);
    AMP_BEGIN(7);
    if (IN(7)) for (int rep = 0; rep < NREP(7); ++rep) { if (rep) xcd_barrier(bar);
        float lam;
        { const float s1 = A.in[I_LQ1][lane] * A.in[I_LK1][lane] + A.in[I_LQ1][lane + 64] * A.in[I_LK1][lane + 64], s2 = A.in[I_LQ2][lane] * A.in[I_LK2][lane] + A.in[I_LQ2][lane + 64] * A.in[I_LK2][lane + 64];
          lam = __expf(wave_sum(s1)) - __expf(wave_sum(s2)) + LAM_INIT; lam = __builtin_bit_cast(float, __builtin_amdgcn_readfirstlane(__builtin_bit_cast(int, lam))); }
        if (wave >= 4) __builtin_amdgcn_s_setprio(2);
        for (int v0 = vcu; v0 < 256; v0 += G) {
            const int rot = (v0 >> 3) % 5;
            for (int i0 = 0; i0 < 5; ++i0) { const int i = (i0 + rot) % 5;
                AttnJob J;
                if (i < 4) { const int bh = v0 >> 3, s = v0 & 7, b = bh >> 3, h = bh & 7; const int qb = (i & 1) ? (16 * (i >> 1) + 15 - s) : (16 * (i >> 1) + s);
                    J.Q = (const bf16*)(ws + WS_QB) + (size_t)(b * SEQ + qb * 128) * DM + h * 256; J.K = (const bf16*)(ws + WS_KBP) + (size_t)(b * SEQ) * DM + h * 256; J.V = (const bf16*)(ws + WS_VBP) + (size_t)(b * SEQ) * DM + h * 256;
                    J.Kc = J.Vc = J.Kn = J.Vn = nullptr; J.ntiles = 4 * qb + 4; J.tile0 = 0; J.sample = 0; J.Op = nullptr; J.ML = nullptr;
                    J.OC = (bf16*)(ws + WS_XB) + (size_t)(b * SEQ + qb * 128) * DM + h * 256; J.G = (const bf16*)(ws + WS_GB) + (size_t)(b * SEQ + qb * 128) * DM + h * 256;
                } else { const int bh2 = v0 >> 2, sp = v0 & 3, b2 = bh2 >> 3, h2 = bh2 & 7, start = sp < 2 ? 33 * sp : 66 + 32 * (sp - 2);
                    const size_t base = (size_t)((b2 * 8 + h2) * 8 + sp * 2);
                    J.Q = (const bf16*)(ws + WS_QB) + (size_t)(MP + b2 * DSQ) * DM + h2 * 256; J.K = J.V = nullptr;
                    J.Kc = A.in[I_CK] + (size_t)b2 * PAST * DM + h2 * 256; J.Vc = A.in[I_CV] + (size_t)b2 * PAST * DM + h2 * 256;
                    J.Kn = A.out + O9 + (size_t)b2 * DSQ * DM + h2 * 256; J.Vn = A.out + O10 + (size_t)b2 * DSQ * DM + h2 * 256;
                    J.ntiles = sp < 2 ? 33 : 32; J.tile0 = start; J.sample = 1; J.Op = (float*)(ws + WS_PARTS) + base * 32768; J.ML = (float*)(ws + WS_MLS) + base * 256; J.OC = nullptr; J.G = nullptr; }
                attn_job(J, A, lds, lam, wave, lane, tid); }
        }
        __builtin_amdgcn_s_setprio(0);
    }
    AMP_END(7);
    SEAM(7);
    AMP_BEGIN(8);
    if (IN(8)) for (int rep = 0; rep < NREP(8); ++rep) { if (rep) xcd_barrier(bar);
        float lam;
        { const float s1 = A.in[I_LQ1][lane] * A.in[I_LK1][lane] + A.in[I_LQ1][lane + 64] * A.in[I_LK1][lane + 64], s2 = A.in[I_LQ2][lane] * A.in[I_LK2][lane] + A.in[I_LQ2][lane + 64] * A.in[I_LK2][lane + 64];
          lam = __expf(wave_sum(s1)) - __expf(wave_sum(s2)) + LAM_INIT; }
        for (int wt = gw; wt < MS * 8; wt += NGW) p6_task(A, wt >> 3, wt & 7, lam, lane);
    }
    AMP_END(8);
    SEAM(8);
    AMP_BEGIN(9);
    if (IN(9)) for (int rep = 0; rep < NREP(9); ++rep) { if (rep) xcd_barrier(bar);
        pg8::Gemm g{(const bf16*)(ws + WS_XB), (const bf16*)(ws + WS_WTCOUT), MP, DM, DM, DM}; pg8::StaticOrder S; S.init(MP, DM, G, bx);
        pg8::EpiZ2 E{(const float*)(ws + OFF_STATS1), (const bf16*)(ws + WS_Z1), A.in[I_LNG], A.in[I_LNB], (bf16*)(ws + WS_QB)};
        pg8::gemm_phase<pg8::EpiZ2, pg8::StaticOrder, true, true>(lds, g, S, E);
        { pg8::Gemm g2{(const bf16*)(ws + WS_XB), (const bf16*)(ws + WS_WTCOUT), MT, DM, 256, DM}; pg8::SliceOrder S2; S2.init(DM, 8, 256, G, bx);
          pg8::EpiSlab E2{(float*)(ws + WS_SLAB), DM, 256};
          pg8::gemm_phase<pg8::EpiSlab, pg8::SliceOrder, false, true>(lds, g2, S2, E2); }
    }
    AMP_END(9);
    SEAM(9);
    AMP_BEGIN(10);
    if (IN(10)) { u32x2 pre[8];
#pragma unroll
        for (int j = 0; j < 8; ++j) pre[j] = (gw < MP) ? ((const u32x2*)((const bf16*)(ws + WS_QB) + (size_t)gw * DM))[lane + 64 * j] : (u32x2){0u, 0u};
        for (int m = gw; m < MT; m += NGW) p8_row(A, m, m + NGW, pre, lane); }
    AMP_END(10);
#undef IN
#undef SEAM
}

extern "C" void kernel_launch(void* const* d_in, const int* in_sizes, int n_in, void* d_out, int out_size, void* d_ws, size_t ws_size, hipStream_t stream) {
    static int grid = 0;
    if (grid == 0) {
        if (n_in != 33 || (size_t)out_size != OUT_TOTAL || ws_size < WS_END) { fprintf(stderr, "kernel_launch: unexpected shapes: n_in %d out %d ws %zu (need %zu)\n", n_in, out_size, ws_size, (size_t)WS_END); grid = -1; return; }
        int dev = 0, cus = 0;
        if (hipGetDevice(&dev) != hipSuccess || hipDeviceGetAttribute(&cus, hipDeviceAttributeMultiprocessorCount, dev) != hipSuccess) { grid = -1; return; }
        if (hipFuncSetAttribute((const void*)mega_fwd, hipFuncAttributeMaxDynamicSharedMemorySize, LDS_BYTES) != hipSuccess) { fprintf(stderr, "kernel_launch: hipFuncSetAttribute failed\n"); grid = -1; return; }
        (void)hipGetLastError();
        grid = cus;
        if (grid != 256) fprintf(stderr, "kernel_launch: %d CUs; this kernel is laid out for 256\n", grid);
    }
    if (grid < 0) return;
    (void)hipMemsetAsync((char*)d_ws + WS_CTL, 0, CTL_ZERO_BYTES, stream);
    Args a{};
    for (int i = 0; i < 33; ++i) a.in[i] = (const float*)d_in[i];
    a.out = (float*)d_out; a.ws = (unsigned char*)d_ws;
#if STAGE == 1
    const int nph = 3;
#elif STAGE == 2
    const int nph = 4;
#elif STAGE == 3
    const int nph = 7;
#else
    const int nph = N_PHASES;
#endif
#if STAGE < 9
    (void)hipMemsetAsync(d_out, 0, (size_t)out_size * 4, stream);
#endif
#ifdef MULTI_LAUNCH
    for (int p = 0; p < nph; ++p) { a.ph_lo = p; a.ph_hi = p + 1; hipLaunchKernelGGL(mega_fwd, dim3(grid), dim3(512), LDS_BYTES, stream, a); }
#else
    a.ph_lo = 0; a.ph_hi = nph;
    hipLaunchKernelGGL(mega_fwd, dim3(grid), dim3(512), LDS_BYTES, stream, a);
#endif
}
```
